# Optimizing an MI355X kernel written in HIP

```python
import math
import functools
import jax, jax.numpy as jnp
from jax import lax
import numpy as np

D_MODEL = 1024
BATCH = 8
SEQ = 2048
DEPTH = 1
DEC_BATCH = 128
DEC_SEQ = 1
PAST_LEN = 8192
PAGE_SIZE = 128

MLA_HEADS = 16
Q_LORA = 384
KV_LORA = 256
NOPE_DIM = 64
ROPE_DIM = 32
V_DIM = 64
ROPE_THETA = 10000.0
Q_BLOCK = 128
SM_SCALE = 1.0 / math.sqrt(NOPE_DIM + ROPE_DIM)
SSM_EXPAND = 2
D_INNER = SSM_EXPAND * D_MODEL
SSM_HEAD_DIM = 64
SSM_HEADS = D_INNER // SSM_HEAD_DIM
SSM_GROUPS = 8
HEADS_PER_GROUP = SSM_HEADS // SSM_GROUPS
D_STATE = 128
CONV_W = 4
CONV_DIM = D_INNER + 2 * SSM_GROUPS * D_STATE
SSD_CHUNK = 128
D_FF = 4 * D_MODEL
EPS = 1e-6
IN_SPLITS = (Q_LORA, KV_LORA, ROPE_DIM, D_INNER, CONV_DIM, SSM_HEADS, D_MODEL, D_MODEL)
D_IN_PROJ = sum(IN_SPLITS)

kernel_name = "hybrid_mla_ssd_gated_decode_step"


def _rms_scale(x):
    xf = x.astype(jnp.float32)
    return xf * lax.rsqrt(jnp.mean(xf * xf, axis=-1, keepdims=True) + EPS)


def _rmsnorm(x, g):
    return (_rms_scale(x) * g.astype(jnp.float32)).astype(x.dtype)


def _split_in(p):
    bounds = [int(v) for v in np.cumsum(IN_SPLITS)[:-1]]
    return jnp.split(p, bounds, axis=-1)


def _rope(x, pos):
    half = ROPE_DIM // 2
    inv_freq = ROPE_THETA ** (-jnp.arange(half, dtype=jnp.float32) / half)
    ang = pos.astype(jnp.float32)[:, None] * inv_freq[None, :]
    cos = jnp.cos(ang)[None, :, None, :]
    sin = jnp.sin(ang)[None, :, None, :]
    xf = x.astype(jnp.float32)
    x1, x2 = xf[..., :half], xf[..., half:]
    return jnp.concatenate([x1 * cos - x2 * sin, x1 * sin + x2 * cos], axis=-1).astype(x.dtype)


def _mla_project(h_q, h_kv, h_pe, pos, g_q, w_uq, g_kv):
    cq = _rmsnorm(h_q, g_q)
    q = jnp.einsum("bsr,rhd->bshd", cq, w_uq)
    q_nope = q[..., :NOPE_DIM]
    q_pe = _rope(q[..., NOPE_DIM:], pos)
    c_kv = _rmsnorm(h_kv, g_kv)
    k_pe = _rope(h_pe[:, :, None, :], pos)[:, :, 0, :]
    return q_nope, q_pe, c_kv, k_pe


def _mla_attend_prompt(q_nope, q_pe, c_kv, k_pe, w_uk, w_uv):
    b, s = q_nope.shape[:2]
    n_blk = s // Q_BLOCK
    k_nope = jnp.einsum("bkr,rhd->bkhd", c_kv, w_uk)
    v = jnp.einsum("bkr,rhd->bkhd", c_kv, w_uv)
    key_pos = jnp.arange(s)
    qn = jnp.moveaxis(q_nope.reshape(b, n_blk, Q_BLOCK, MLA_HEADS, NOPE_DIM), 1, 0)
    qp = jnp.moveaxis(q_pe.reshape(b, n_blk, Q_BLOCK, MLA_HEADS, ROPE_DIM), 1, 0)

    def one_block(args):
        qn_b, qp_b, blk = args
        sc = jnp.einsum("bqhd,bkhd->bhqk", qn_b, k_nope) + jnp.einsum("bqhd,bkd->bhqk", qp_b, k_pe)
        q_pos = blk * Q_BLOCK + jnp.arange(Q_BLOCK)
        sc = jnp.where(key_pos[None, :] <= q_pos[:, None], sc.astype(jnp.float32) * SM_SCALE, -jnp.inf)
        p = jax.nn.softmax(sc, axis=-1).astype(v.dtype)
        return jnp.einsum("bhqk,bkhd->bqhd", p, v)

    o = lax.map(one_block, (qn, qp, jnp.arange(n_blk)))
    return jnp.moveaxis(o, 0, 1).reshape(b, s, MLA_HEADS * V_DIM)


def _mla_attend_sample(q_nope, q_pe, c_kv, k_pe, cache_kv, cache_pe, page_table, w_uk, w_uv):
    b, s = q_nope.shape[:2]
    past_kv = cache_kv[page_table].reshape(b, -1, KV_LORA)
    past_pe = cache_pe[page_table].reshape(b, -1, ROPE_DIM)
    past_len = past_kv.shape[1]
    q_lat = jnp.einsum("bshd,rhd->bshr", q_nope, w_uk)
    sc_past = jnp.einsum("bshr,btr->bhst", q_lat, past_kv) + jnp.einsum("bshd,btd->bhst", q_pe, past_pe)
    sc_new = jnp.einsum("bshr,btr->bhst", q_lat, c_kv) + jnp.einsum("bshd,btd->bhst", q_pe, k_pe)
    causal = jnp.arange(s)[None, :] <= jnp.arange(s)[:, None]
    sc_new = jnp.where(causal, sc_new.astype(jnp.float32) * SM_SCALE, -jnp.inf)
    sc = jnp.concatenate([sc_past.astype(jnp.float32) * SM_SCALE, sc_new], axis=-1)
    p = jax.nn.softmax(sc, axis=-1).astype(c_kv.dtype)
    o_lat = (jnp.einsum("bhst,btr->bshr", p[..., :past_len], past_kv)
             + jnp.einsum("bhst,btr->bshr", p[..., past_len:], c_kv))
    return jnp.einsum("bshr,rhd->bshd", o_lat, w_uv).reshape(b, s, MLA_HEADS * V_DIM)


def _causal_conv(xbc, conv_prev, w_conv, b_conv):
    s = xbc.shape[1]
    full = jnp.concatenate([conv_prev.astype(xbc.dtype), xbc], axis=1)
    acc = b_conv
    for k in range(CONV_W):
        acc = acc + full[:, k:k + s] * w_conv[k]
    return jax.nn.silu(acc), full[:, s:]


def _ssd(x, dt, a, bm, cm, init_state):
    b, s = x.shape[:2]
    t = SSD_CHUNK if s % SSD_CHUNK == 0 else s
    nc = s // t
    G, HG, P, N = SSM_GROUPS, HEADS_PER_GROUP, SSM_HEAD_DIM, D_STATE
    la = (dt * a).reshape(b, nc, t, SSM_HEADS)
    xdt = (x.astype(jnp.float32) * dt[..., None]).reshape(b, nc, t, G, HG, P)
    bc = bm.astype(jnp.float32).reshape(b, nc, t, G, N)
    cc = cm.astype(jnp.float32).reshape(b, nc, t, G, N)
    cs = jnp.cumsum(la, axis=2)
    seg = cs[:, :, :, None, :] - cs[:, :, None, :, :]
    tri = jnp.arange(t)[:, None] >= jnp.arange(t)[None, :]
    decay = jnp.exp(jnp.where(tri[:, :, None], seg, -jnp.inf)).reshape(b, nc, t, t, G, HG)
    cb = jnp.einsum("bclgn,bcsgn->bclsg", cc, bc)
    y_diag = jnp.einsum("bclsgh,bcsghp->bclghp", cb[..., None] * decay, xdt)
    to_end = jnp.exp(cs[:, :, -1:, :] - cs).reshape(b, nc, t, G, HG)
    local = jnp.einsum("bcsgn,bcsgh,bcsghp->bcghpn", bc, to_end, xdt)
    chunk_decay = jnp.exp(cs[:, :, -1, :]).reshape(b, nc, G, HG)

    def step(state, inp):
        dec, loc = inp
        return state * dec[..., None, None] + loc, state

    init = init_state.astype(jnp.float32).reshape(b, G, HG, P, N)
    final, prev = lax.scan(step, init, (jnp.moveaxis(chunk_decay, 1, 0), jnp.moveaxis(local, 1, 0)))
    prev = jnp.moveaxis(prev, 0, 1)
    y_off = jnp.einsum("bclgn,bcghpn,bclgh->bclghp", cc, prev, jnp.exp(cs).reshape(b, nc, t, G, HG))
    y = (y_diag + y_off).reshape(b, s, SSM_HEADS, P)
    return y, final.reshape(b, SSM_HEADS, P, N)


def _ssm_branch(z, xbc_raw, dt_raw, conv_prev, ssm_prev, w_conv, b_conv, dt_bias, a_log, d_skip, g_ssm):
    b, s = z.shape[:2]
    xbc, conv_new = _causal_conv(xbc_raw, conv_prev, w_conv, b_conv)
    xs, bm, cm = jnp.split(xbc, [D_INNER, D_INNER + SSM_GROUPS * D_STATE], axis=-1)
    xs = xs.reshape(b, s, SSM_HEADS, SSM_HEAD_DIM)
    bm = bm.reshape(b, s, SSM_GROUPS, D_STATE)
    cm = cm.reshape(b, s, SSM_GROUPS, D_STATE)
    dt = jax.nn.softplus(dt_raw.astype(jnp.float32) + dt_bias.astype(jnp.float32))
    a = -jnp.exp(a_log.astype(jnp.float32))
    y, ssm_new = _ssd(xs, dt, a, bm, cm, ssm_prev)
    y = y + d_skip.astype(jnp.float32)[:, None] * xs.astype(jnp.float32)
    y = y.reshape(b, s, D_INNER) * jax.nn.silu(z.astype(jnp.float32))
    y = _rms_scale(y.reshape(b, s, SSM_GROUPS, D_INNER // SSM_GROUPS)).reshape(b, s, D_INNER)
    return (y * g_ssm.astype(jnp.float32)).astype(z.dtype), conv_new, ssm_new


def _trunk_layer(x, pos, conv_prev, ssm_prev, attend, p):
    h = _rmsnorm(x, p["g_pre_mix"])
    h_q, h_kv, h_pe, z, xbc_raw, dt_raw, gate_a, gate_b = _split_in(h @ p["w_in"])
    q_nope, q_pe, c_kv, k_pe = _mla_project(h_q, h_kv, h_pe, pos, p["g_q"], p["w_uq"], p["g_kv"])
    o_attn = attend(q_nope, q_pe, c_kv, k_pe)
    o_ssm, conv_new, ssm_new = _ssm_branch(z, xbc_raw, dt_raw, conv_prev, ssm_prev, p["w_conv"], p["b_conv"],
                                           p["dt_bias"], p["a_log"], p["d_skip"], p["g_ssm"])
    merged = jax.nn.sigmoid(gate_a) * (o_attn @ p["w_br_attn"]) + jax.nn.sigmoid(gate_b) * (o_ssm @ p["w_br_ssm"])
    x = x + _rmsnorm(merged @ p["w_out"], p["g_post_mix"])
    h2 = _rmsnorm(x, p["g_pre_mlp"])
    f = jnp.square(jax.nn.relu(h2 @ p["w_up"])) @ p["w_down"]
    x = x + _rmsnorm(f, p["g_post_mlp"])
    return x, c_kv, k_pe, conv_new, ssm_new


def setup_inputs(seed: int = 0) -> dict:
    key = jax.random.key(seed)
    ks = jax.random.split(key, 32)
    f32 = jnp.float32
    n_pages = PAST_LEN // PAGE_SIZE
    n_used = DEC_BATCH * n_pages
    n_phys = n_used + n_used // 4

    def nrm(k, shape, scale):
        return jax.random.normal(k, shape, f32) * scale

    def gain(k, shape):
        return 1.0 + 0.05 * jax.random.normal(k, shape, f32)

    dt0 = jnp.exp(jax.random.uniform(ks[20], (DEPTH, SSM_HEADS), f32, math.log(1e-3), math.log(1e-1)))
    return {
        "x_prompt": nrm(ks[0], (BATCH, SEQ, D_MODEL), 1.0),
        "x_sample": nrm(ks[1], (DEC_BATCH, DEC_SEQ, D_MODEL), 1.0),
        "cache_kv_latent": nrm(ks[2], (DEPTH, n_phys, PAGE_SIZE, KV_LORA), 1.0),
        "cache_k_rope": nrm(ks[3], (DEPTH, n_phys, PAGE_SIZE, ROPE_DIM), 1.0),
        "state_ssm": nrm(ks[4], (DEPTH, DEC_BATCH, SSM_HEADS, SSM_HEAD_DIM, D_STATE), 0.1),
        "state_conv": nrm(ks[5], (DEPTH, DEC_BATCH, CONV_W - 1, CONV_DIM), 1.0),
        "page_table": jax.random.permutation(ks[6], n_phys)[:n_used].reshape(DEC_BATCH, n_pages).astype(jnp.int32),
        "w_in": nrm(ks[7], (DEPTH, D_MODEL, D_IN_PROJ), D_MODEL ** -0.5),
        "g_pre_mix": gain(ks[8], (DEPTH, D_MODEL)),
        "g_q": gain(ks[9], (DEPTH, Q_LORA)),
        "w_uq": nrm(ks[10], (DEPTH, Q_LORA, MLA_HEADS, NOPE_DIM + ROPE_DIM), Q_LORA ** -0.5),
        "g_kv": gain(ks[11], (DEPTH, KV_LORA)),
        "w_uk": nrm(ks[12], (DEPTH, KV_LORA, MLA_HEADS, NOPE_DIM), KV_LORA ** -0.5),
        "w_uv": nrm(ks[13], (DEPTH, KV_LORA, MLA_HEADS, V_DIM), KV_LORA ** -0.5),
        "w_conv": nrm(ks[14], (DEPTH, CONV_W, CONV_DIM), CONV_W ** -0.5),
        "b_conv": nrm(ks[15], (DEPTH, CONV_DIM), 0.02),
        "dt_bias": dt0 + jnp.log(-jnp.expm1(-dt0)),
        "a_log": jnp.log(jax.random.uniform(ks[16], (DEPTH, SSM_HEADS), f32, 1.0, 16.0)),
        "d_skip": gain(ks[17], (DEPTH, SSM_HEADS)),
        "g_ssm": gain(ks[18], (DEPTH, D_INNER)),
        "w_br_attn": nrm(ks[19], (DEPTH, MLA_HEADS * V_DIM, D_MODEL), (MLA_HEADS * V_DIM) ** -0.5),
        "w_br_ssm": nrm(ks[21], (DEPTH, D_INNER, D_MODEL), D_INNER ** -0.5),
        "w_out": nrm(ks[22], (DEPTH, D_MODEL, D_MODEL), D_MODEL ** -0.5),
        "g_post_mix": gain(ks[23], (DEPTH, D_MODEL)),
        "g_pre_mlp": gain(ks[24], (DEPTH, D_MODEL)),
        "w_up": nrm(ks[25], (DEPTH, D_MODEL, D_FF), D_MODEL ** -0.5),
        "w_down": nrm(ks[26], (DEPTH, D_FF, D_MODEL), D_FF ** -0.5),
        "g_post_mlp": gain(ks[27], (DEPTH, D_MODEL)),
    }


def reference(x_prompt, x_sample, cache_kv_latent, cache_k_rope, state_ssm, state_conv, page_table,
              w_in, g_pre_mix, g_q, w_uq, g_kv, w_uk, w_uv, w_conv, b_conv, dt_bias, a_log, d_skip, g_ssm,
              w_br_attn, w_br_ssm, w_out, g_post_mix, g_pre_mlp, w_up, w_down, g_post_mlp):
    b_p, s_p = x_prompt.shape[:2]
    b_s, s_s = x_sample.shape[:2]
    past_len = page_table.shape[1] * PAGE_SIZE
    pos_prompt = jnp.arange(s_p, dtype=jnp.int32)
    pos_sample = past_len + jnp.arange(s_s, dtype=jnp.int32)
    conv_zero = jnp.zeros((b_p, CONV_W - 1, CONV_DIM), x_prompt.dtype)
    ssm_zero = jnp.zeros((b_p, SSM_HEADS, SSM_HEAD_DIM, D_STATE), jnp.float32)

    kvp, kpp, ssp, cvp, kvs, kps, sss, cvs = [], [], [], [], [], [], [], []
    xp, xs = x_prompt, x_sample
    for l in range(DEPTH):
        p = dict(w_in=w_in[l], g_pre_mix=g_pre_mix[l], g_q=g_q[l], w_uq=w_uq[l], g_kv=g_kv[l],
                 w_conv=w_conv[l], b_conv=b_conv[l], dt_bias=dt_bias[l], a_log=a_log[l], d_skip=d_skip[l],
                 g_ssm=g_ssm[l], w_br_attn=w_br_attn[l], w_br_ssm=w_br_ssm[l], w_out=w_out[l],
                 g_post_mix=g_post_mix[l], g_pre_mlp=g_pre_mlp[l], w_up=w_up[l], w_down=w_down[l],
                 g_post_mlp=g_post_mlp[l])
        attend_p = functools.partial(_mla_attend_prompt, w_uk=w_uk[l], w_uv=w_uv[l])
        attend_s = functools.partial(_mla_attend_sample, cache_kv=cache_kv_latent[l], cache_pe=cache_k_rope[l],
                                     page_table=page_table, w_uk=w_uk[l], w_uv=w_uv[l])
        xp, ckv_p, kpe_p, conv_p, ssm_p = _trunk_layer(xp, pos_prompt, conv_zero, ssm_zero, attend_p, p)
        xs, ckv_s, kpe_s, conv_s, ssm_s = _trunk_layer(xs, pos_sample, state_conv[l], state_ssm[l], attend_s, p)
        kvp.append(ckv_p); kpp.append(kpe_p); ssp.append(ssm_p); cvp.append(conv_p)
        kvs.append(ckv_s); kps.append(kpe_s); sss.append(ssm_s); cvs.append(conv_s)

    return (xp, xs,
            jnp.stack(kvp), jnp.stack(kpp), jnp.stack(ssp), jnp.stack(cvp),
            jnp.stack(kvs), jnp.stack(kps), jnp.stack(sss), jnp.stack(cvs))
```

```cpp
#define MK_N_LAUNCHES 1
#include <hip/hip_runtime.h>
#include <hip/hip_bf16.h>
#include <cstdio>
#include <cstdint>
#include <cmath>

namespace pg8 {
#define PG8_LAS __attribute__((address_space(3)))
typedef unsigned short bf16_t;
typedef short bf16x8 __attribute__((ext_vector_type(8)));
typedef float f32x4 __attribute__((ext_vector_type(4)));
typedef unsigned u32x4 __attribute__((ext_vector_type(4)));
typedef unsigned u32x2 __attribute__((ext_vector_type(2)));
constexpr int BM = 256, BK = 64, HALF = 128, HTB = HALF * BK * 2  , STAGE_BYTES = 8 * HTB, NXCD = 8, WGM = 8;

__host__ __device__ __forceinline__ int lds_byte(int r, int c) { const int st = (r >> 4) * 2 + (c >> 5), rr = r & 15, cc = c & 31, ob = rr * 64 + cc * 2; return st * 1024 + (ob ^ (((ob >> 9) & 1) << 5)); }
__host__ __device__ __forceinline__ void stage_rc(int b, int& R, int& C) { const int st = b / 1024, sb = b % 1024, swz = sb ^ (((sb >> 9) & 1) << 5); R = (st >> 1) * 16 + swz / 64; C = (st & 1) * 32 + (swz % 64) / 2; }
__host__ __device__ __forceinline__ int perm32(int rho) { const int n = rho >> 4, i = rho & 15; return 8 * (i >> 2) + 4 * n + (i & 3); }

struct Unit { int pm, pn; };
struct Gemm { const bf16_t* A; const bf16_t* Bt; int M, N, K, lda, ldb; };

struct StaticOrder {
    int nM, nN, nwg, G, c;
    __host__ __device__ void init(int M, int N, int G_, int c_) { nM = M / BM; nN = N / BM; nwg = nM * nN; G = G_; c = c_; }
    __host__ __device__ bool next(int i, Unit& u) const {
        const long L = (long)i * G + c; if (L >= nwg) return false;
        int wgid = (int)L; { const int q = nwg / NXCD, r = nwg % NXCD, xcd = wgid % NXCD, off = wgid / NXCD; wgid = (xcd < r ? xcd * (q + 1) : r * (q + 1) + (xcd - r) * q) + off; }
        const int nig = WGM * nN, gid = wgid / nig, fm = gid * WGM, gsz = (nM - fm) < WGM ? (nM - fm) : WGM;
        u.pm = fm + ((wgid % nig) % gsz); u.pn = (wgid % nig) / gsz; return true;
    }
    __device__ __forceinline__ void a_ready(const Unit&) const {}
    __device__ __forceinline__ void done(const Unit&) const {}
};

__device__ __forceinline__ unsigned cvt_pk_bf16(float lo, float hi) { unsigned r; asm volatile("v_cvt_pk_bf16_f32 %0, %1, %2" : "=v"(r) : "v"(lo), "v"(hi)); return r; }
__device__ __forceinline__ float bflo(unsigned w) { return __uint_as_float(w << 16); }
__device__ __forceinline__ float bfhi(unsigned w) { return __uint_as_float(w & 0xffff0000u); }
__device__ __forceinline__ float sigm(float x) { return __builtin_amdgcn_rcpf(1.0f + __expf(-x)); }

enum { EM_P1 = 0, EM_Q = 1, EM_BF16 = 2, EM_G1 = 3, EM_G2 = 4, EM_F32 = 5, EM_UP = 6 };
constexpr float QSCALE = 0.10540925533894598f * 1.4426950408889634f;
template <int MODE> struct Epi {
    static constexpr bool PERM = true, AFTER_DRAIN = false;
    void* o0; int ld0;
    void* o1; int ld1;
    const bf16_t* gate; int ldg;
    const float* tab;
    __device__ __forceinline__ void operator()(const f32x4 (&acc)[2][2][4][2], const Unit& u, int wr, int wc, int fr, int fq) const {
        const int row0 = u.pm * BM + wr * 64 + fr;
#pragma unroll
        for (int ai = 0; ai < 2; ++ai) {
            u32x4 gq[4][2], mq[4][2]; f32x4 tq[4][2];
            if constexpr (MODE == EM_G1 || MODE == EM_G2) {
#pragma unroll
                for (int m = 0; m < 4; ++m)
#pragma unroll
                    for (int bj = 0; bj < 2; ++bj) { const size_t go = (size_t)(row0 + ai * HALF + m * 16) * ldg + u.pn * BM + bj * HALF + wc * 32 + 8 * fq;
                        gq[m][bj] = *(const u32x4*)(gate + go);
                        if constexpr (MODE == EM_G2) mq[m][bj] = *(const u32x4*)((const bf16_t*)o1 + (size_t)(row0 + ai * HALF + m * 16) * ld1 + u.pn * BM + bj * HALF + wc * 32 + 8 * fq); }
            }
            if constexpr (MODE == EM_Q) {
#pragma unroll
                for (int m = 0; m < 4; ++m) { const int row = row0 + ai * HALF + m * 16; const int pidx = row < 16384 ? (row & 2047) : 2048;
                    const float* tp = tab + ((size_t)pidx * 16 + 4 * fq) * 2; tq[m][0] = *(const f32x4*)tp; tq[m][1] = *(const f32x4*)(tp + 4); }
            }
#pragma unroll
            for (int m = 0; m < 4; ++m) {
                const int row = row0 + ai * HALF + m * 16;
#pragma unroll
                for (int bj = 0; bj < 2; ++bj) {
                    const int col = u.pn * BM + bj * HALF + wc * 32 + 8 * fq;
                    f32x4 v0 = acc[ai][bj][m][0], v1 = acc[ai][bj][m][1];
                    if constexpr (MODE == EM_P1) {
                        if (u.pn < 3) { u32x4 w; w.x = cvt_pk_bf16(v0[0], v0[1]); w.y = cvt_pk_bf16(v0[2], v0[3]); w.z = cvt_pk_bf16(v1[0], v1[1]); w.w = cvt_pk_bf16(v1[2], v1[3]);
                               *(u32x4*)((bf16_t*)o0 + (size_t)row * ld0 + col) = w; }
                        else { if (u.pn >= 27) {
#pragma unroll
                                   for (int j = 0; j < 4; ++j) { v0[j] = sigm(v0[j]); v1[j] = sigm(v1[j]); } }
                               u32x4 w; w.x = cvt_pk_bf16(v0[0], v0[1]); w.y = cvt_pk_bf16(v0[2], v0[3]); w.z = cvt_pk_bf16(v1[0], v1[1]); w.w = cvt_pk_bf16(v1[2], v1[3]);
                               *(u32x4*)((bf16_t*)o1 + (size_t)row * ld1 + (col - 768)) = w; }
                    } else if constexpr (MODE == EM_Q) {
                        const int g32 = col >> 5;
                        if ((g32 % 3) == 2) {
                            const f32x4 t0 = tq[m][0], t1 = tq[m][1];
                            f32x4 r0, r1;
                            r0[0] = v0[0] * t0[0] - v0[1] * t0[1]; r0[1] = v0[0] * t0[1] + v0[1] * t0[0];
                            r0[2] = v0[2] * t0[2] - v0[3] * t0[3]; r0[3] = v0[2] * t0[3] + v0[3] * t0[2];
                            r1[0] = v1[0] * t1[0] - v1[1] * t1[1]; r1[1] = v1[0] * t1[1] + v1[1] * t1[0];
                            r1[2] = v1[2] * t1[2] - v1[3] * t1[3]; r1[3] = v1[2] * t1[3] + v1[3] * t1[2];
                            v0 = r0; v1 = r1;
                        }
                        v0 = v0 * QSCALE; v1 = v1 * QSCALE;
                        u32x4 w; w.x = cvt_pk_bf16(v0[0], v0[1]); w.y = cvt_pk_bf16(v0[2], v0[3]); w.z = cvt_pk_bf16(v1[0], v1[1]); w.w = cvt_pk_bf16(v1[2], v1[3]);
                        *(u32x4*)((bf16_t*)o0 + (size_t)row * ld0 + col) = w;
                    } else if constexpr (MODE == EM_BF16) {
                        u32x4 w; w.x = cvt_pk_bf16(v0[0], v0[1]); w.y = cvt_pk_bf16(v0[2], v0[3]); w.z = cvt_pk_bf16(v1[0], v1[1]); w.w = cvt_pk_bf16(v1[2], v1[3]);
                        *(u32x4*)((bf16_t*)o0 + (size_t)row * ld0 + col) = w;
                    } else if constexpr (MODE == EM_G1) {
                        const u32x4 gw = gq[m][bj];
                        v0[0] *= bflo(gw.x); v0[1] *= bfhi(gw.x); v0[2] *= bflo(gw.y); v0[3] *= bfhi(gw.y);
                        v1[0] *= bflo(gw.z); v1[1] *= bfhi(gw.z); v1[2] *= bflo(gw.w); v1[3] *= bfhi(gw.w);
                        u32x4 w; w.x = cvt_pk_bf16(v0[0], v0[1]); w.y = cvt_pk_bf16(v0[2], v0[3]); w.z = cvt_pk_bf16(v1[0], v1[1]); w.w = cvt_pk_bf16(v1[2], v1[3]);
                        *(u32x4*)((bf16_t*)o0 + (size_t)row * ld0 + col) = w;
                    } else if constexpr (MODE == EM_G2) {
                        const u32x4 gw = gq[m][bj];
                        const u32x4 mw = mq[m][bj];
                        const f32x4 a0 = (f32x4){bflo(mw.x), bfhi(mw.x), bflo(mw.y), bfhi(mw.y)}, a1 = (f32x4){bflo(mw.z), bfhi(mw.z), bflo(mw.w), bfhi(mw.w)};
                        v0[0] = a0[0] + v0[0] * bflo(gw.x); v0[1] = a0[1] + v0[1] * bfhi(gw.x); v0[2] = a0[2] + v0[2] * bflo(gw.y); v0[3] = a0[3] + v0[3] * bfhi(gw.y);
                        v1[0] = a1[0] + v1[0] * bflo(gw.z); v1[1] = a1[1] + v1[1] * bfhi(gw.z); v1[2] = a1[2] + v1[2] * bflo(gw.w); v1[3] = a1[3] + v1[3] * bfhi(gw.w);
                        u32x4 w; w.x = cvt_pk_bf16(v0[0], v0[1]); w.y = cvt_pk_bf16(v0[2], v0[3]); w.z = cvt_pk_bf16(v1[0], v1[1]); w.w = cvt_pk_bf16(v1[2], v1[3]);
                        *(u32x4*)((bf16_t*)o0 + (size_t)row * ld0 + col) = w;
                    } else if constexpr (MODE == EM_F32) {
                        float* p = (float*)o0 + (size_t)row * ld0 + col; *(f32x4*)p = v0; *(f32x4*)(p + 4) = v1;
                    } else {
#pragma unroll
                        for (int j = 0; j < 4; ++j) { float a, b; asm("v_max_f32 %0, 0, %1" : "=v"(a) : "v"(v0[j])); asm("v_max_f32 %0, 0, %1" : "=v"(b) : "v"(v1[j])); v0[j] = a * a; v1[j] = b * b; }
                        u32x4 w; w.x = cvt_pk_bf16(v0[0], v0[1]); w.y = cvt_pk_bf16(v0[2], v0[3]); w.z = cvt_pk_bf16(v1[0], v1[1]); w.w = cvt_pk_bf16(v1[2], v1[3]);
                        *(u32x4*)((bf16_t*)o0 + (size_t)row * ld0 + col) = w;
                    }
                }
            }
        }
    }
};

template <class Epi, class Sched, bool ALIGN_EPI = false, bool SP2 = false>
__device__ __forceinline__ void gemm_phase(PG8_LAS unsigned char* lds, const Gemm g, const Sched& S, const Epi& E) {
    const int tid = threadIdx.x, wid = __builtin_amdgcn_readfirstlane(tid >> 6), lane = tid & 63, wr = wid >> 2, wc = wid & 3, fr = lane & 15, fq = lane >> 4;
    int K = g.K; asm volatile("" : "+s"(K)); const int nt = K / BK;
    unsigned voffA[2], voffB[2];
#pragma unroll
    for (int i = 0; i < 2; ++i) { int R, C; stage_rc(tid * 16 + i * 8192, R, C); const int Rb = Epi::PERM ? ((R & ~31) + perm32(R & 31)) : R;
        voffA[i] = (unsigned)(R * g.lda + C) * 2u; voffB[i] = (unsigned)(Rb * g.ldb + C) * 2u; }
    const size_t kstep = (size_t)(BK * 2);
    const size_t hstepA = (size_t)HALF * g.lda * 2, hstepB = (size_t)HALF * g.ldb * 2;
    const size_t tstepA = 2 * hstepA, tstepB = 2 * hstepB;
    const unsigned ldsw = (unsigned)wid * 1024u;
    const int aoff = lds_byte(wr * 64 + fr, fq * 8), boff = lds_byte(wc * 32 + fr, fq * 8);
#define PG8_SA(b, h) (((b) * 2 + (h)) * HTB)
#define PG8_SB(b, h) ((4 + (b) * 2 + (h)) * HTB)
#define PG8_STAGE(bufoff, gbase, voff) do { _Pragma("unroll") for (int _i = 0; _i < 2; ++_i) \
        __builtin_amdgcn_global_load_lds((const unsigned*)((const char*)(gbase) + (voff)[_i]), (PG8_LAS unsigned*)(lds + (bufoff) + ldsw + _i * 8192), 16, 0, 0); } while (0)
#define PG8_LDA(dst, b, h) do { _Pragma("unroll") for (int m = 0; m < 4; ++m) _Pragma("unroll") for (int k = 0; k < 2; ++k) dst[m][k] = *(const PG8_LAS bf16x8*)(lds + PG8_SA(b, h) + aoff + m * 2048 + k * 1024); } while (0)
#define PG8_LDB(dst, b, h) do { _Pragma("unroll") for (int n = 0; n < 2; ++n) _Pragma("unroll") for (int k = 0; k < 2; ++k) dst[n][k] = *(const PG8_LAS bf16x8*)(lds + PG8_SB(b, h) + boff + n * 2048 + k * 1024); } while (0)
#define PG8_MMA(ai, bj, At, Bt) do { __builtin_amdgcn_s_setprio(1); _Pragma("unroll") for (int m = 0; m < 4; ++m) _Pragma("unroll") for (int n = 0; n < 2; ++n) _Pragma("unroll") for (int k = 0; k < 2; ++k) \
        acc[ai][bj][m][n] = __builtin_amdgcn_mfma_f32_16x16x32_bf16(Bt[n][k], At[m][k], acc[ai][bj][m][n], 0, 0, 0); __builtin_amdgcn_s_setprio(0); } while (0)
#define PG8_WAIT_V(n) asm volatile("s_waitcnt vmcnt(" #n ")" ::: "memory")
#define PG8_WAIT_L(n) asm volatile("s_waitcnt lgkmcnt(" #n ")" ::: "memory")
#define PG8_BAR __builtin_amdgcn_s_barrier()
#define PG8_SCHED __builtin_amdgcn_sched_barrier(0)
    Unit cur, nxt; int ui = 0;
    if (!S.next(0, cur)) return;
    f32x4 acc[2][2][4][2];
#pragma unroll
    for (int a = 0; a < 2; ++a)
#pragma unroll
        for (int b = 0; b < 2; ++b)
#pragma unroll
            for (int m = 0; m < 4; ++m)
#pragma unroll
                for (int n = 0; n < 2; ++n) acc[a][b][m][n] = (f32x4){0.f, 0.f, 0.f, 0.f};
    bf16x8 At[4][2], B0[2][2], B1[2][2];
    const char* cA = (const char*)g.A + (size_t)cur.pm * tstepA; const char* cB = (const char*)g.Bt + (size_t)cur.pn * tstepB;
    S.a_ready(cur);
    if constexpr (SP2) {
        PG8_STAGE(PG8_SB(0, 0), cB, voffB); PG8_STAGE(PG8_SB(0, 1), cB + hstepB, voffB); PG8_STAGE(PG8_SA(0, 0), cA, voffA); PG8_STAGE(PG8_SA(0, 1), cA + hstepA, voffA);
        if (wr == 1) PG8_BAR;
        PG8_WAIT_V(2); PG8_BAR;
        PG8_STAGE(PG8_SB(1, 0), cB + kstep, voffB); PG8_STAGE(PG8_SA(1, 0), cA + kstep, voffA); PG8_STAGE(PG8_SB(1, 1), cB + hstepB + kstep, voffB);
        PG8_WAIT_V(6); PG8_BAR;
    } else {
        PG8_STAGE(PG8_SB(0, 0), cB, voffB); PG8_STAGE(PG8_SA(0, 0), cA, voffA); PG8_STAGE(PG8_SB(0, 1), cB + hstepB, voffB); PG8_STAGE(PG8_SA(0, 1), cA + hstepA, voffA);
        if (wr == 1) PG8_BAR;
        PG8_WAIT_V(4); PG8_BAR;
        PG8_STAGE(PG8_SB(1, 0), cB + kstep, voffB); PG8_STAGE(PG8_SA(1, 0), cA + kstep, voffA); PG8_STAGE(PG8_SB(1, 1), cB + hstepB + kstep, voffB);
        PG8_WAIT_V(6); PG8_BAR;
    }
    for (;;) {
        const bool has_next = S.next(ui + 1, nxt);
        const char* nA = has_next ? (const char*)g.A + (size_t)nxt.pm * tstepA : cA; const char* nB = has_next ? (const char*)g.Bt + (size_t)nxt.pn * tstepB : cB;
        for (int t = 0; t < nt; t += 2) {
            const bool last = (t == nt - 2);
            const char* a1 = cA + (size_t)(t + 1) * kstep;
            const char* a2 = last ? nA : cA + (size_t)(t + 2) * kstep; const char* b2 = last ? nB : cB + (size_t)(t + 2) * kstep;
            const char* a3 = a2 + kstep; const char* b3 = b2 + kstep;
            if (last && has_next) S.a_ready(nxt);
            if constexpr (SP2) {
            PG8_LDB(B0, 0, 0); PG8_LDB(B1, 0, 1); PG8_SCHED; PG8_LDA(At, 0, 0); PG8_STAGE(PG8_SA(1, 1), a1 + hstepA, voffA);
            PG8_WAIT_V(8); PG8_WAIT_L(0); PG8_BAR; PG8_MMA(0, 0, At, B0); PG8_MMA(0, 1, At, B1); PG8_BAR; PG8_SCHED;
            PG8_LDA(At, 0, 1); PG8_STAGE(PG8_SB(0, 0), b2, voffB); PG8_STAGE(PG8_SB(0, 1), b2 + hstepB, voffB); PG8_STAGE(PG8_SA(0, 0), a2, voffA);
            PG8_WAIT_V(8); PG8_WAIT_L(0); PG8_BAR; PG8_MMA(1, 0, At, B0); PG8_MMA(1, 1, At, B1); PG8_BAR; PG8_SCHED;
            PG8_LDB(B0, 1, 0); PG8_LDB(B1, 1, 1); PG8_SCHED; PG8_LDA(At, 1, 0); PG8_STAGE(PG8_SA(0, 1), a2 + hstepA, voffA);
            PG8_WAIT_V(8); PG8_WAIT_L(0); PG8_BAR; PG8_MMA(0, 0, At, B0); PG8_MMA(0, 1, At, B1); PG8_BAR; PG8_SCHED;
            PG8_LDA(At, 1, 1); PG8_STAGE(PG8_SB(1, 0), b3, voffB); PG8_STAGE(PG8_SB(1, 1), b3 + hstepB, voffB); PG8_STAGE(PG8_SA(1, 0), a3, voffA);
            PG8_WAIT_V(8); PG8_WAIT_L(0); PG8_BAR; PG8_MMA(1, 0, At, B0); PG8_MMA(1, 1, At, B1); PG8_BAR; PG8_SCHED;
            } else {
            PG8_LDB(B0, 0, 0); PG8_SCHED; PG8_LDA(At, 0, 0); PG8_STAGE(PG8_SA(1, 1), a1 + hstepA, voffA);
            PG8_WAIT_L(8); PG8_BAR; PG8_WAIT_L(0); PG8_MMA(0, 0, At, B0); PG8_BAR; PG8_SCHED;
            PG8_LDB(B1, 0, 1); PG8_STAGE(PG8_SB(0, 0), b2, voffB);
            PG8_BAR; PG8_WAIT_L(0); PG8_MMA(0, 1, At, B1); PG8_BAR;
            PG8_LDA(At, 0, 1); PG8_STAGE(PG8_SA(0, 0), a2, voffA);
            PG8_BAR; PG8_WAIT_L(0); PG8_MMA(1, 0, At, B0); PG8_BAR; PG8_SCHED;
            PG8_STAGE(PG8_SB(0, 1), b2 + hstepB, voffB);
            PG8_WAIT_V(6); PG8_BAR; PG8_MMA(1, 1, At, B1); PG8_BAR;
            PG8_LDB(B0, 1, 0); PG8_SCHED; PG8_LDA(At, 1, 0); PG8_STAGE(PG8_SA(0, 1), a2 + hstepA, voffA);
            PG8_WAIT_L(8); PG8_BAR; PG8_WAIT_L(0); PG8_MMA(0, 0, At, B0); PG8_BAR; PG8_SCHED;
            PG8_LDB(B1, 1, 1); PG8_STAGE(PG8_SB(1, 0), b3, voffB);
            PG8_BAR; PG8_WAIT_L(0); PG8_MMA(0, 1, At, B1); PG8_BAR;
            PG8_LDA(At, 1, 1); PG8_STAGE(PG8_SA(1, 0), a3, voffA);
            PG8_BAR; PG8_WAIT_L(0); PG8_MMA(1, 0, At, B0); PG8_BAR; PG8_SCHED;
            PG8_STAGE(PG8_SB(1, 1), b3 + hstepB, voffB);
            PG8_WAIT_V(6); PG8_BAR; PG8_MMA(1, 1, At, B1); PG8_BAR;
            }
        }
        if constexpr (ALIGN_EPI) { if (wr == 0) PG8_BAR; }
        if constexpr (!Epi::AFTER_DRAIN) { E(acc, cur, wr, wc, fr, fq); S.done(cur); }
        if (!has_next) break;
#pragma unroll
        for (int a = 0; a < 2; ++a)
#pragma unroll
            for (int b = 0; b < 2; ++b)
#pragma unroll
                for (int m = 0; m < 4; ++m)
#pragma unroll
                    for (int n = 0; n < 2; ++n) acc[a][b][m][n] = (f32x4){0.f, 0.f, 0.f, 0.f};
        cur = nxt; cA = nA; cB = nB; ++ui;
        if constexpr (ALIGN_EPI) { if (wr == 1) PG8_BAR; }
    }
    PG8_WAIT_V(0);
    if constexpr (!ALIGN_EPI) { if (wr == 0) PG8_BAR; }
    PG8_BAR;
    if constexpr (Epi::AFTER_DRAIN) { E.fused(acc, cur, wr, wc, fr, fq, lds, wid, lane); S.done(cur); }
#undef PG8_SA
#undef PG8_SB
#undef PG8_STAGE
#undef PG8_LDA
#undef PG8_LDB
#undef PG8_MMA
#undef PG8_WAIT_V
#undef PG8_WAIT_L
#undef PG8_BAR
#undef PG8_SCHED
}

template <int MODE> __device__ __forceinline__ void epi4(const Epi<MODE>& E, int row, int col, f32x4 v) {
    if constexpr (MODE == EM_G1) {
        const u32x2 gw = *(const u32x2*)(E.gate + (size_t)row * E.ldg + col);
        v[0] *= bflo(gw.x); v[1] *= bfhi(gw.x); v[2] *= bflo(gw.y); v[3] *= bfhi(gw.y);
        { u32x2 w; w.x = cvt_pk_bf16(v[0], v[1]); w.y = cvt_pk_bf16(v[2], v[3]); *(u32x2*)((bf16_t*)E.o0 + (size_t)row * E.ld0 + col) = w; }
    } else if constexpr (MODE == EM_G2) {
        const u32x2 gw = *(const u32x2*)(E.gate + (size_t)row * E.ldg + col);
        const u32x2 mw = *(const u32x2*)((const bf16_t*)E.o1 + (size_t)row * E.ld1 + col);
        const f32x4 a = (f32x4){bflo(mw.x), bfhi(mw.x), bflo(mw.y), bfhi(mw.y)};
        v[0] = a[0] + v[0] * bflo(gw.x); v[1] = a[1] + v[1] * bfhi(gw.x); v[2] = a[2] + v[2] * bflo(gw.y); v[3] = a[3] + v[3] * bfhi(gw.y);
        u32x2 w; w.x = cvt_pk_bf16(v[0], v[1]); w.y = cvt_pk_bf16(v[2], v[3]);
        *(u32x2*)((bf16_t*)E.o0 + (size_t)row * E.ld0 + col) = w;
    } else if constexpr (MODE == EM_F32) {
        *(f32x4*)((float*)E.o0 + (size_t)row * E.ld0 + col) = v;
    } else if constexpr (MODE == EM_BF16) {
        u32x2 w; w.x = cvt_pk_bf16(v[0], v[1]); w.y = cvt_pk_bf16(v[2], v[3]);
        *(u32x2*)((bf16_t*)E.o0 + (size_t)row * E.ld0 + col) = w;
    } else {
#pragma unroll
        for (int j = 0; j < 4; ++j) { const float a = fmaxf(v[j], 0.f); v[j] = a * a; }
        u32x2 w; w.x = cvt_pk_bf16(v[0], v[1]); w.y = cvt_pk_bf16(v[2], v[3]);
        *(u32x2*)((bf16_t*)E.o0 + (size_t)row * E.ld0 + col) = w;
    }
}
template <int MODE> __device__ __forceinline__ void skinny_unit(PG8_LAS unsigned char* lds, const bf16_t* A, int lda, const bf16_t* Bt, int ldb, int K, int n0, const Epi<MODE>& E, int rbase) {
    const int tid = threadIdx.x, wid = __builtin_amdgcn_readfirstlane(tid >> 6), lane = tid & 63, fr = lane & 15, fq = lane >> 4;
    const int klen = K >> 3, k0 = wid * klen;
    f32x4 acc[2][2];
#pragma unroll
    for (int mt = 0; mt < 2; ++mt) { acc[mt][0] = (f32x4){0.f, 0.f, 0.f, 0.f}; acc[mt][1] = (f32x4){0.f, 0.f, 0.f, 0.f}; }
    const bf16_t* ap = A + (size_t)(rbase + fr) * lda + k0 + 8 * fq;
    const bf16_t* bp = Bt + (size_t)(n0 + fr) * ldb + k0 + 8 * fq;
    bf16x8 bq[2][4][2], aq[2][4][2];
#define SK_LOAD(buf_, kk_) do { _Pragma("unroll") for (int u = 0; u < 4; ++u) { bq[buf_][u][0] = *(const bf16x8*)(bp + (kk_) + 32 * u); bq[buf_][u][1] = *(const bf16x8*)(bp + (size_t)16 * ldb + (kk_) + 32 * u); \
            aq[buf_][u][0] = *(const bf16x8*)(ap + (kk_) + 32 * u); aq[buf_][u][1] = *(const bf16x8*)(ap + (size_t)16 * lda + (kk_) + 32 * u); } } while (0)
    SK_LOAD(0, 0);
#pragma unroll
    for (int kk = 0; kk < klen; kk += 128) {
        const int cb = (kk >> 7) & 1;
        if (kk + 128 < klen) SK_LOAD(cb ^ 1, kk + 128);
#pragma unroll
        for (int u = 0; u < 4; ++u) asm volatile("" : "+v"(bq[cb][u][0]), "+v"(bq[cb][u][1]), "+v"(aq[cb][u][0]), "+v"(aq[cb][u][1]) :: "memory");
#pragma unroll
        for (int u = 0; u < 4; ++u)
#pragma unroll
            for (int mt = 0; mt < 2; ++mt) {
                acc[mt][0] = __builtin_amdgcn_mfma_f32_16x16x32_bf16(bq[cb][u][0], aq[cb][u][mt], acc[mt][0], 0, 0, 0);
                acc[mt][1] = __builtin_amdgcn_mfma_f32_16x16x32_bf16(bq[cb][u][1], aq[cb][u][mt], acc[mt][1], 0, 0, 0);
            }
    }
#undef SK_LOAD
    PG8_LAS float* P = (PG8_LAS float*)lds + wid * 1024;
#pragma unroll
    for (int mt = 0; mt < 2; ++mt) { *(PG8_LAS f32x4*)(P + (16 * mt + fr) * 32 + 4 * fq) = acc[mt][0]; *(PG8_LAS f32x4*)(P + (16 * mt + fr) * 32 + 16 + 4 * fq) = acc[mt][1]; }
    __syncthreads();
    if (tid < 256) {
        const int e = tid * 4, m = e >> 5, c4 = e & 31;
        f32x4 s = *(PG8_LAS f32x4*)((PG8_LAS float*)lds + e);
#pragma unroll
        for (int w = 1; w < 8; ++w) s += *(PG8_LAS f32x4*)((PG8_LAS float*)lds + w * 1024 + e);
        epi4<MODE>(E, rbase + m, n0 + c4, s);
    }
    __syncthreads();
}
}

constexpr int NWAVES = 8;
constexpr int DM = 1024, SEQ = 2048, NBAT = 8, MPR = NBAT * SEQ  , NSB = 128  , MR = MPR + NSB  , MP = 16640  ;
constexpr int NIN = 8960;
constexpr int NPF = 768, NPB = 8192;
constexpr int PB_Z = 0, PB_XBC = 2048, PB_GA = 6144, PB_GB = 7168;
constexpr int QW = 1536;
constexpr int PAST = 8192, PAGE = 128, NPAGES = 64;
constexpr float EPS = 1e-6f;
enum { I_XP = 0, I_XS, I_CKV, I_CPE, I_SSM, I_CONV, I_PT, I_WIN, I_GPRE, I_GQ, I_WUQ, I_GKV, I_WUK, I_WUV, I_WCONV, I_BCONV, I_DTB, I_ALOG, I_DSKIP, I_GSSM,
       I_WBRA, I_WBRS, I_WOUT, I_GPOSTMIX, I_GPREMLP, I_WUP, I_WDN, I_GPOSTMLP, N_IN };
constexpr size_t O_YP = 0, O_YS = 16777216, O_KVP = 16908288, O_KRP = 21102592, O_SSP = 21626880, O_CVP = 23724032, O_KVS = 23822336, O_KRS = 23855104, O_SSS = 23859200, O_CVS = 57413632, O_END = 58986496;

constexpr size_t MiB = 1u << 20;
constexpr size_t WS_CTL = 0, CTL_ZERO_BYTES = 64 * 1024;
constexpr size_t WS_WIN = 2 * MiB, WS_WUQ = 20 * MiB, WS_WUKV = 22 * MiB, WS_WBRA = 24 * MiB, WS_WBRS = 26 * MiB, WS_WOUT = 30 * MiB, WS_WUP = 32 * MiB, WS_WDN = 40 * MiB;
constexpr size_t WS_TAB = 48 * MiB, WS_CD = 49 * MiB, WS_PART = 50 * MiB, WS_QL = 56 * MiB, WS_CS = 60 * MiB  ;
constexpr size_t WS_XN = 64 * MiB, WS_PF = 98 * MiB, WS_PB = 148 * MiB, WS_CQ = 408 * MiB, WS_CKV = 422 * MiB, WS_KPE = 432 * MiB, WS_DT = 434 * MiB, WS_XBC = 438 * MiB;
constexpr size_t WS_Q = 568 * MiB, WS_KNV = 618 * MiB, WS_OA = 682 * MiB, WS_OS = 716 * MiB, WS_LOC = 782 * MiB, WS_PREV = 910 * MiB, WS_MG1 = 974 * MiB, WS_MG = 1040 * MiB;
constexpr size_t WS_MIX = 1074 * MiB, WS_X1 = 1140 * MiB, WS_U = 1206 * MiB, WS_F = 1336 * MiB, WS_END = 1402 * MiB;
static_assert(WS_WIN + (size_t)NIN * 1024 * 2 <= WS_WUQ && WS_XN + (size_t)MP * 1024 * 2 <= WS_PF && WS_PF + (size_t)MP * NPF * 4 <= WS_PB && WS_PB + (size_t)MP * NPB * 2 <= WS_CQ, "ws map 1");
static_assert(WS_CQ + (size_t)MP * 384 * 2 <= WS_CKV && WS_CKV + (size_t)MP * 256 * 2 <= WS_KPE && WS_KPE + (size_t)MP * 32 * 2 <= WS_DT && WS_DT + (size_t)MP * 32 * 4 <= WS_XBC && WS_XBC + (size_t)MP * 4096 * 2 <= WS_Q, "ws map 2");
static_assert(WS_Q + (size_t)MP * QW * 2 <= WS_KNV && WS_KNV + (size_t)MPR * 2048 * 2 <= WS_OA && WS_OA + (size_t)MP * 1024 * 2 <= WS_OS && WS_OS + (size_t)MP * 2048 * 2 <= WS_LOC, "ws map 3");
static_assert(WS_LOC + (size_t)MPR / 128 * 32 * 8192 * 4 <= WS_PREV && WS_PREV + (size_t)MPR / 128 * 32 * 8192 * 2 <= WS_MG1 && WS_MG1 + (size_t)MP * 1024 * 4 <= WS_MG && WS_MG + (size_t)MP * 1024 * 2 <= WS_MIX, "ws map 4");
static_assert(WS_MIX + (size_t)MP * 1024 * 4 <= WS_X1 && WS_X1 + (size_t)MP * 1024 * 4 <= WS_U && WS_U + (size_t)MP * 4096 * 2 <= WS_F && WS_F + (size_t)MP * 1024 * 4 <= WS_END, "ws map 5");
constexpr int CW_TMO = 0, CW_CODE = 1, CW_BAR = 4096;
constexpr int RING_OFF = 0, RING_BYTES = 131072, EXTRA_OFF = 131072  , LDSCTL_OFF = 139264, MISC_OFF = LDSCTL_OFF + 320;
constexpr int LDS_BYTES = 147456;
static_assert(MISC_OFF + 128 <= LDS_BYTES, "LDS map");

#define GAS __attribute__((address_space(1)))
#define LAS __attribute__((address_space(3)))
typedef unsigned short bf16;
typedef unsigned v4u __attribute__((ext_vector_type(4)));
typedef unsigned v2u __attribute__((ext_vector_type(2)));
typedef float f32x4 __attribute__((ext_vector_type(4)));
typedef float f32x2 __attribute__((ext_vector_type(2)));
typedef float f32x16 __attribute__((ext_vector_type(16)));
typedef short bf16x8 __attribute__((ext_vector_type(8)));
typedef short bf16x4 __attribute__((ext_vector_type(4)));
typedef short v4i16_t __attribute__((ext_vector_type(4)));
typedef GAS unsigned gu32;
#define RLX_AGENT __ATOMIC_RELAXED, __HIP_MEMORY_SCOPE_AGENT
#define LDS_WAIT() asm volatile("s_waitcnt lgkmcnt(0)" ::: "memory")
#define VM_WAIT() asm volatile("s_waitcnt vmcnt(0)" ::: "memory")
__device__ __forceinline__ unsigned pk2(float lo, float hi) { return pg8::cvt_pk_bf16(lo, hi); }
__device__ __forceinline__ float bflo(unsigned w) { return __uint_as_float(w << 16); }
__device__ __forceinline__ float bfhi(unsigned w) { return __uint_as_float(w & 0xffff0000u); }
__device__ __forceinline__ float bf1(bf16 b) { return __uint_as_float((unsigned)b << 16); }
__device__ __forceinline__ float wave_sum(float v) {
#pragma unroll
    for (int o = 1; o < 64; o <<= 1) v += __shfl_xor(v, o);
    return v;
}
__device__ __forceinline__ int crow(int r, int hi) { return (r & 3) + 8 * (r >> 2) + 4 * hi; }
__device__ __forceinline__ void unpack8(const v4u w, float (&f)[8]) { f[0] = bflo(w.x); f[1] = bfhi(w.x); f[2] = bflo(w.y); f[3] = bfhi(w.y); f[4] = bflo(w.z); f[5] = bfhi(w.z); f[6] = bflo(w.w); f[7] = bfhi(w.w); }
__device__ __forceinline__ v4u pack8(const float (&f)[8]) { v4u w; w.x = pk2(f[0], f[1]); w.y = pk2(f[2], f[3]); w.z = pk2(f[4], f[5]); w.w = pk2(f[6], f[7]); return w; }
__device__ __forceinline__ void glds16(const void* gsrc, unsigned lds_dst) { unsigned keep;
    asm volatile("s_mov_b32 %0, m0\n\ts_mov_b32 m0, %2\n\ts_nop 0\n\tglobal_load_lds_dwordx4 %1, off\n\ts_mov_b32 m0, %0" : "=&s"(keep) : "v"(gsrc), "s"(lds_dst) : "memory"); }
__device__ __forceinline__ bf16x4 vtr(const LAS unsigned char* p) { return __builtin_bit_cast(bf16x4, __builtin_amdgcn_ds_read_tr16_b64_v4i16((LAS v4i16_t*)p)); }
#define JOIN8(lo, hi) (bf16x8){lo[0], lo[1], lo[2], lo[3], hi[0], hi[1], hi[2], hi[3]}
__constant__ float INV_FREQ[16] = {1.000000000e+00f, 5.623413324e-01f, 3.162277639e-01f, 1.778279394e-01f, 1.000000015e-01f, 5.623413250e-02f, 3.162277490e-02f, 1.778279431e-02f,
                                   9.999999776e-03f, 5.623413250e-03f, 3.162277630e-03f, 1.778279431e-03f, 1.000000047e-03f, 5.623413017e-04f, 3.162277571e-04f, 1.778279402e-04f};

#define XB_TMO      128
#define XB_XCNT(j)  (256  + 64 * (j))
#define XB_XSUB(j)  (1280 + 64 * (j))
#define XB_XGEN(j)  (2304 + 64 * (j))
#define XB_TOP      3328
#define XB_TOPGEN   3392
#define XCD_BAR_WORDS 3456
#define XB_SPIN_CAP (1u << 18)

__device__ __forceinline__ unsigned xb_ld(unsigned* p)              { return __hip_atomic_load(p, __ATOMIC_RELAXED, __HIP_MEMORY_SCOPE_AGENT); }
__device__ __forceinline__ unsigned xb_add(unsigned* p, unsigned v) { return __hip_atomic_fetch_add(p, v, __ATOMIC_RELAXED, __HIP_MEMORY_SCOPE_AGENT); }
__device__ __forceinline__ unsigned xb_xcc_id() { return (unsigned)__builtin_amdgcn_s_getreg((3 << 11) | 20) & 0xFu; }
#define XB_SPIN(cond, bar) do { unsigned _sp = 0; while (cond) { __builtin_amdgcn_s_sleep(1); \
    if ((++_sp & 255u) == 0u) { if (xb_ld(&(bar)[XB_TMO])) break; if (_sp > XB_SPIN_CAP) { atomicAdd(&(bar)[XB_TMO], 1u); break; } } } } while (0)

struct XcdBarrier {
    unsigned* bar; unsigned x;
    volatile LAS unsigned* st;
};

__device__ __forceinline__ XcdBarrier xcd_barrier_post(unsigned* bar, volatile LAS unsigned* st) {
    XcdBarrier b; b.bar = bar; b.x = xb_xcc_id(); b.st = st;
    if (threadIdx.x == 0) (void)xb_add(&bar[XB_XCNT(b.x)], 1u);
    return b;
}
__device__ __forceinline__ void xcd_barrier_complete(unsigned* bar, unsigned x, unsigned& nloc, unsigned& nx) {
    const unsigned G = gridDim.x * gridDim.y * gridDim.z;
    unsigned sum, cnt, mine, sp = 0u;
    for (;;) {
        sum = 0u; cnt = 0u; mine = 0u;
#pragma unroll
        for (unsigned j = 0; j < 16; ++j) { const unsigned c = xb_ld(&bar[XB_XCNT(j)]); sum += c; cnt += (c > 0u) ? 1u : 0u; mine = (j == x) ? c : mine; }
        if (sum == G) break;
        __builtin_amdgcn_s_sleep(1);
        if ((++sp & 255u) == 0u) { if (xb_ld(&bar[XB_TMO])) break; if (sp > XB_SPIN_CAP) { atomicAdd(&bar[XB_TMO], 1u); break; } }
    }
    nloc = mine > 0u ? mine : 1u; nx = cnt > 0u ? cnt : 1u;
}

__device__ __forceinline__ void xcd_barrier(const XcdBarrier& b) {
    asm volatile("s_waitcnt vmcnt(0)" ::: "memory");
    __syncthreads();
    if (threadIdx.x == 0) {
        unsigned* bar = b.bar;
        __builtin_amdgcn_s_waitcnt(0);
        unsigned nloc = b.st[0], nx = b.st[1];
        if (nloc == 0u) { xcd_barrier_complete(bar, b.x, nloc, nx); b.st[0] = nloc; b.st[1] = nx; }
        const unsigned old = xb_add(&bar[XB_XSUB(b.x)], 1u);
        const unsigned gen = old / nloc;
        if (old + 1u == (gen + 1u) * nloc) {
            __builtin_amdgcn_fence(__ATOMIC_RELEASE, "agent");
            asm volatile("s_waitcnt vmcnt(0)" ::: "memory");
            const unsigned og = xb_add(&bar[XB_TOP], 1u);
            const unsigned tg = og / nx;
            if (og + 1u == (tg + 1u) * nx) xb_add(&bar[XB_TOPGEN], 1u);
            else XB_SPIN(xb_ld(&bar[XB_TOPGEN]) == tg, bar);
            __builtin_amdgcn_fence(__ATOMIC_ACQUIRE, "agent");
            xb_add(&bar[XB_XGEN(b.x)], 1u);
            asm volatile("s_waitcnt vmcnt(0)" ::: "memory");
        } else {
            XB_SPIN(xb_ld(&bar[XB_XGEN(b.x)]) == gen, bar);
            __builtin_amdgcn_fence(__ATOMIC_ACQUIRE, "agent");
            asm volatile("s_waitcnt vmcnt(0)" ::: "memory");
        }
    }
    __syncthreads();
}

struct Args { const void* in[N_IN]; float* out; unsigned char* ws; int ph_lo, ph_hi, li, pad; };
struct Ctx {
    LAS unsigned char* lds; int tid, lane, wave, vcu, G, gw, NGW;
    unsigned char* ws; float* out;
};

template <class FN> __device__ __forceinline__ void tr_item(const float* W, int srcN, bf16* WT, int K, int k0, int n0, LAS float* scr, int lane, FN srccol) {
    const int sc = srccol(n0 + (lane & 31));
    float tv[32];
#pragma unroll
    for (int i = 0; i < 32; ++i) { const int kk = 2 * i + (lane >> 5); tv[i] = sc >= 0 ? W[(size_t)(k0 + kk) * srcN + sc] : 0.f; }
#pragma unroll
    for (int i = 0; i < 32; ++i) { const int kk = 2 * i + (lane >> 5); scr[kk * 33 + (lane & 31)] = tv[i]; }
    LDS_WAIT(); asm volatile("" ::: "memory");
    const int c = lane & 7;
#pragma unroll
    for (int j = 0; j < 4; ++j) { const int n = (lane >> 3) + 8 * j; const LAS float* s = scr + (8 * c) * 33 + n;
        v4u o; o.x = pk2(s[0 * 33], s[1 * 33]); o.y = pk2(s[2 * 33], s[3 * 33]); o.z = pk2(s[4 * 33], s[5 * 33]); o.w = pk2(s[6 * 33], s[7 * 33]);
        *(GAS v4u*)(WT + (size_t)(n0 + n) * K + k0 + 8 * c) = o; }
    LDS_WAIT(); asm volatile("" ::: "memory");
}
__device__ __forceinline__ int win_src(int n) { return n < 384 ? n : n < 416 ? n + 256 : n < 448 ? n + 6400 : n < 512 ? -1 : n < 768 ? n - 128 : n < 6912 ? n - 96 : n - 64; }
__device__ __forceinline__ int wuq_src(int n) { const int h = n / 96, j = n - h * 96; if (j < 64) return n; const int jj = j - 64; return h * 96 + 64 + (jj >> 1) + 16 * (jj & 1); }
__device__ __forceinline__ int id_src(int n) { return n; }

__device__ __forceinline__ void ph0_prologue(const Ctx& X, const Args& a, const int part) {
    unsigned char* ws = X.ws;
    LAS float* scr = (LAS float*)(X.lds + RING_OFF + X.wave * 16384);
    constexpr int I0 = 16 * 280, I1 = 6 * 48, I2 = 4 * 32, I3 = 4 * 32, I4 = 16 * 32, I5 = 32 * 32, I6 = 16 * 32, I7 = 16 * 128, I8 = 64 * 32;
    constexpr int NITEMS = I0 + I1 + I2 + I3 + I4 + I5 + I6 + I7 + I8;
    constexpr int NEARLY = I0 + I1 + I2 + I3;
    for (int it = (part == 0 ? 0 : NEARLY) + X.gw; it < (part == 0 ? NEARLY : NITEMS); it += X.NGW) {
        int r = it;
        if (r < I0) { tr_item((const float*)a.in[I_WIN], 8896, (bf16*)(ws + WS_WIN), 1024, 64 * (r / 280), 32 * (r % 280), scr, X.lane, win_src); continue; } r -= I0;
        if (r < I1) { tr_item((const float*)a.in[I_WUQ], 1536, (bf16*)(ws + WS_WUQ), 384, 64 * (r / 48), 32 * (r % 48), scr, X.lane, wuq_src); continue; } r -= I1;
        if (r < I2) { tr_item((const float*)a.in[I_WUK], 1024, (bf16*)(ws + WS_WUKV), 256, 64 * (r / 32), 32 * (r % 32), scr, X.lane, id_src); continue; } r -= I2;
        if (r < I3) { tr_item((const float*)a.in[I_WUV], 1024, (bf16*)(ws + WS_WUKV) + (size_t)1024 * 256, 256, 64 * (r / 32), 32 * (r % 32), scr, X.lane, id_src); continue; } r -= I3;
        if (r < I4) { tr_item((const float*)a.in[I_WBRA], 1024, (bf16*)(ws + WS_WBRA), 1024, 64 * (r / 32), 32 * (r % 32), scr, X.lane, id_src); continue; } r -= I4;
        if (r < I5) { tr_item((const float*)a.in[I_WBRS], 1024, (bf16*)(ws + WS_WBRS), 2048, 64 * (r / 32), 32 * (r % 32), scr, X.lane, id_src); continue; } r -= I5;
        if (r < I6) { tr_item((const float*)a.in[I_WOUT], 1024, (bf16*)(ws + WS_WOUT), 1024, 64 * (r / 32), 32 * (r % 32), scr, X.lane, id_src); continue; } r -= I6;
        if (r < I7) { tr_item((const float*)a.in[I_WUP], 4096, (bf16*)(ws + WS_WUP), 1024, 64 * (r / 128), 32 * (r % 128), scr, X.lane, id_src); continue; } r -= I7;
        tr_item((const float*)a.in[I_WDN], 1024, (bf16*)(ws + WS_WDN), 4096, 64 * (r / 32), 32 * (r % 32), scr, X.lane, id_src);
    }
    if (part != 0) return;
    {
        const GAS f32x4* gp = (const GAS f32x4*)a.in[I_GPRE] + X.lane; f32x4 g[4];
#pragma unroll
        for (int j = 0; j < 4; ++j) g[j] = gp[64 * j];
        bf16* XN = (bf16*)(ws + WS_XN);
        for (int m0 = X.gw; m0 < MP; m0 += 2 * X.NGW) {
            int mm[2]; mm[0] = m0; mm[1] = m0 + X.NGW < MP ? m0 + X.NGW : m0;
            f32x4 v[2][4];
#pragma unroll
            for (int q = 0; q < 2; ++q) { const int m = mm[q];
                if (m < MR) { const float* xrow = m < MPR ? (const float*)a.in[I_XP] + (size_t)m * DM : (const float*)a.in[I_XS] + (size_t)(m - MPR) * DM;
                    const GAS f32x4* xr = (const GAS f32x4*)xrow + X.lane;
#pragma unroll
                    for (int j = 0; j < 4; ++j) v[q][j] = xr[64 * j]; }
                else {
#pragma unroll
                    for (int j = 0; j < 4; ++j) v[q][j] = (f32x4){0.f, 0.f, 0.f, 0.f}; } }
#pragma unroll
            for (int q = 0; q < 2; ++q) { const int m = mm[q]; float s = 0.f;
#pragma unroll
                for (int j = 0; j < 4; ++j) s += (v[q][j].x * v[q][j].x + v[q][j].y * v[q][j].y) + (v[q][j].z * v[q][j].z + v[q][j].w * v[q][j].w);
                const float rs = rsqrtf(wave_sum(s) * (1.f / DM) + EPS);
                GAS unsigned long long* o8 = (GAS unsigned long long*)(XN + (size_t)m * DM) + X.lane;
#pragma unroll
                for (int j = 0; j < 4; ++j) { const f32x4 t = v[q][j] * rs * g[j]; o8[64 * j] = (unsigned long long)pk2(t.x, t.y) | ((unsigned long long)pk2(t.z, t.w) << 32); } }
        }
    }
    {
        float* tab = (float*)(ws + WS_TAB);
        for (int e = X.gw * 64 + X.lane; e < 2049 * 16; e += X.NGW * 64) {
            const int pidx = e >> 4, i = e & 15; const float pos = (float)(pidx < 2048 ? pidx : PAST);
            float s, c; sincosf(pos * INV_FREQ[i], &s, &c);
            tab[2 * e] = c; tab[2 * e + 1] = s;
        }
    }
}

__device__ __forceinline__ float softplus(float x) { return x > 20.f ? x : log1pf(__expf(x)); }
__device__ __forceinline__ float silu(float x) { return x * pg8::sigm(x); }
__device__ __forceinline__ f32x2 silu2(f32x2 x) {
    const f32x2 t = x * (f32x2){-1.4426950408889634f, -1.4426950408889634f};
    const f32x2 d = (f32x2){__builtin_amdgcn_exp2f(t.x), __builtin_amdgcn_exp2f(t.y)} + (f32x2){1.f, 1.f};
    return x * (f32x2){__builtin_amdgcn_rcpf(d.x), __builtin_amdgcn_rcpf(d.y)};
}
__device__ __forceinline__ void ph2_token(const Ctx& X, const Args& a) {
    unsigned char* ws = X.ws; const int lane = X.lane;
    const bf16* PF = (const bf16*)(ws + WS_PF); const bf16* PB = (const bf16*)(ws + WS_PB);
    bf16* CQ = (bf16*)(ws + WS_CQ); bf16* CKV = (bf16*)(ws + WS_CKV); bf16* KPE = (bf16*)(ws + WS_KPE); float* DT = (float*)(ws + WS_DT); bf16* XBC = (bf16*)(ws + WS_XBC);
    const float* tab = (const float*)(ws + WS_TAB);
    {
        const float* gq = (const float*)a.in[I_GQ]; const float* gkv = (const float*)a.in[I_GKV]; const float* dtb = (const float*)a.in[I_DTB];
        f32x2 gqv[3];
#pragma unroll
        for (int j = 0; j < 3; ++j) gqv[j] = *(const f32x2*)(gq + 2 * lane + 128 * j);
        const f32x4 gk = *(const f32x4*)(gkv + 4 * lane);
        const float dbias = dtb[lane & 31];
        for (int row0 = X.gw; row0 < MR; row0 += 4 * X.NGW) {
            unsigned qw[4][3]; v2u kw[4]; bf16 vv[4]; f32x2 cs[4];
#pragma unroll
            for (int r = 0; r < 4; ++r) { const int row = row0 + r * X.NGW < MR ? row0 + r * X.NGW : row0; const bf16* pf = PF + (size_t)row * NPF;
#pragma unroll
                for (int j = 0; j < 3; ++j) qw[r][j] = *(const unsigned*)(pf + 2 * lane + 128 * j);
                kw[r] = *(const v2u*)(pf + 512 + 4 * lane); vv[r] = pf[384 + lane];
                cs[r] = *(const f32x2*)(tab + ((size_t)(row < MPR ? (row & (SEQ - 1)) : 2048) * 16 + (lane & 15)) * 2); }
#pragma unroll
            for (int r = 0; r < 4; ++r) {
                const int row = row0 + r * X.NGW;
                if (row < MR) {
                    f32x2 q[3]; float s = 0.f;
#pragma unroll
                    for (int j = 0; j < 3; ++j) { q[j] = (f32x2){bflo(qw[r][j]), bfhi(qw[r][j])}; s += q[j].x * q[j].x + q[j].y * q[j].y; }
                    const f32x4 k = (f32x4){bflo(kw[r].x), bfhi(kw[r].x), bflo(kw[r].y), bfhi(kw[r].y)};
                    const float v = bf1(vv[r]);
                    float s2 = (k.x * k.x + k.y * k.y) + (k.z * k.z + k.w * k.w);
#pragma unroll
                    for (int o = 1; o < 64; o <<= 1) { s += __shfl_xor(s, o); s2 += __shfl_xor(s2, o); }
                    const float rs = rsqrtf(s * (1.f / 384.f) + EPS), rs2 = rsqrtf(s2 * (1.f / 256.f) + EPS);
#pragma unroll
                    for (int j = 0; j < 3; ++j) *(unsigned*)(CQ + (size_t)row * 384 + 2 * lane + 128 * j) = pk2(q[j].x * rs * gqv[j].x, q[j].y * rs * gqv[j].y);
                    const f32x4 c = k * rs2 * gk;
                    float* okv = row < MPR ? X.out + O_KVP + (size_t)row * 256 : X.out + O_KVS + (size_t)(row - MPR) * 256;
                    *(f32x4*)(okv + 4 * lane) = c;
                    v2u cw; cw.x = pk2(c.x, c.y); cw.y = pk2(c.z, c.w); *(v2u*)(CKV + (size_t)row * 256 + 4 * lane) = cw;
                    const float partner = __shfl_xor(v, 16);
                    if (lane < 32) {
                        const int i = lane & 15;
                        const float o = lane < 16 ? v * cs[r].x - partner * cs[r].y : partner * cs[r].y + v * cs[r].x;
                        float* okr = row < MPR ? X.out + O_KRP + (size_t)row * 32 : X.out + O_KRS + (size_t)(row - MPR) * 32;
                        okr[lane] = o;
                        KPE[(size_t)row * 32 + 2 * i + (lane >> 4)] = (bf16)(pk2(o, 0.f) & 0xffffu);
                    } else {
                        DT[(size_t)row * 32 + (lane - 32)] = softplus(v + dbias);
                    }
                }
            }
        }
    }
    {
        const float* wc = (const float*)a.in[I_WCONV]; const float* bc = (const float*)a.in[I_BCONV];
        for (int item = X.gw; item < 2048 + 1024; item += X.NGW) {
            const bool smp = item >= 2048;
            const int sl = item & 7, ch = sl * 512 + 8 * lane;
            float w[4][8], bias[8];
#pragma unroll
            for (int k = 0; k < 4; ++k) { const f32x4 w0 = *(const f32x4*)(wc + k * 4096 + ch), w1 = *(const f32x4*)(wc + k * 4096 + ch + 4);
                w[k][0] = w0.x; w[k][1] = w0.y; w[k][2] = w0.z; w[k][3] = w0.w; w[k][4] = w1.x; w[k][5] = w1.y; w[k][6] = w1.z; w[k][7] = w1.w; }
            { const f32x4 b0 = *(const f32x4*)(bc + ch), b1 = *(const f32x4*)(bc + ch + 4); bias[0] = b0.x; bias[1] = b0.y; bias[2] = b0.z; bias[3] = b0.w; bias[4] = b1.x; bias[5] = b1.y; bias[6] = b1.z; bias[7] = b1.w; }
            float r3[8], r2[8], r1[8], cur[8], y[8];
            if (!smp) {
                const int row_s = (item >> 3) * 64;
                if ((row_s & (SEQ - 1)) == 0) {
#pragma unroll
                    for (int j = 0; j < 8; ++j) { r3[j] = 0.f; r2[j] = 0.f; r1[j] = 0.f; }
                } else {
                    const v4u h3 = *(const v4u*)(PB + (size_t)(row_s - 3) * NPB + PB_XBC + ch), h2 = *(const v4u*)(PB + (size_t)(row_s - 2) * NPB + PB_XBC + ch), h1 = *(const v4u*)(PB + (size_t)(row_s - 1) * NPB + PB_XBC + ch);
                    unpack8(h3, r3); unpack8(h2, r2); unpack8(h1, r1);
                }
                v4u rawv[2][8];
#pragma unroll
                for (int t = 0; t < 8; ++t) rawv[0][t] = *(const v4u*)(PB + (size_t)(row_s + t) * NPB + PB_XBC + ch);
#pragma unroll
                for (int bt = 0; bt < 8; ++bt) {
                    if (bt < 7) {
#pragma unroll
                        for (int t = 0; t < 8; ++t) rawv[(bt + 1) & 1][t] = *(const v4u*)(PB + (size_t)(row_s + 8 * (bt + 1) + t) * NPB + PB_XBC + ch);
                    }
#pragma unroll
                    for (int t = 0; t < 8; t += 4) asm volatile("" : "+v"(rawv[bt & 1][t]), "+v"(rawv[bt & 1][t + 1]), "+v"(rawv[bt & 1][t + 2]), "+v"(rawv[bt & 1][t + 3]) :: "memory");
#pragma unroll
                    for (int t = 0; t < 8; ++t) {
                        unpack8(rawv[bt & 1][t], cur);
#pragma unroll
                        for (int p = 0; p < 4; ++p) {
                            f32x2 acc = (f32x2){bias[2 * p], bias[2 * p + 1]};
                            acc = __builtin_elementwise_fma((f32x2){w[0][2 * p], w[0][2 * p + 1]}, (f32x2){r3[2 * p], r3[2 * p + 1]}, acc);
                            acc = __builtin_elementwise_fma((f32x2){w[1][2 * p], w[1][2 * p + 1]}, (f32x2){r2[2 * p], r2[2 * p + 1]}, acc);
                            acc = __builtin_elementwise_fma((f32x2){w[2][2 * p], w[2][2 * p + 1]}, (f32x2){r1[2 * p], r1[2 * p + 1]}, acc);
                            acc = __builtin_elementwise_fma((f32x2){w[3][2 * p], w[3][2 * p + 1]}, (f32x2){cur[2 * p], cur[2 * p + 1]}, acc);
                            const f32x2 tt = acc * (f32x2){-1.4426950408889634f, -1.4426950408889634f};
                            const f32x2 dd = (f32x2){__builtin_amdgcn_exp2f(tt.x), __builtin_amdgcn_exp2f(tt.y)} + (f32x2){1.f, 1.f};
                            const f32x2 yy = acc * (f32x2){__builtin_amdgcn_rcpf(dd.x), __builtin_amdgcn_rcpf(dd.y)};
                            y[2 * p] = yy.x; y[2 * p + 1] = yy.y;
                        }
#pragma unroll
                        for (int j = 0; j < 8; ++j) { r3[j] = r2[j]; r2[j] = r1[j]; r1[j] = cur[j]; }
                        *(v4u*)(XBC + (size_t)(row_s + 8 * bt + t) * 4096 + ch) = pack8(y);
                    }
                }
            } else {
                const int b = (item - 2048) >> 3, row = MPR + b;
                const float* sc = (const float*)a.in[I_CONV] + (size_t)b * 3 * 4096 + ch;
                float* oc = X.out + O_CVS + (size_t)b * 3 * 4096 + ch;
#pragma unroll
                for (int j = 0; j < 8; ++j) { r3[j] = sc[j]; r2[j] = sc[4096 + j]; r1[j] = sc[8192 + j]; }
                unpack8(*(const v4u*)(PB + (size_t)row * NPB + PB_XBC + ch), cur);
#pragma unroll
                for (int j = 0; j < 8; ++j) { const float acc = bias[j] + w[0][j] * r3[j] + w[1][j] * r2[j] + w[2][j] * r1[j] + w[3][j] * cur[j]; y[j] = silu(acc); oc[j] = r2[j]; oc[4096 + j] = r1[j]; oc[8192 + j] = cur[j]; }
                *(v4u*)(XBC + (size_t)row * 4096 + ch) = pack8(y);
            }
        }
        for (int item = X.gw; item < NBAT * 3 * 8; item += X.NGW) {
            const int sl = item & 7, k = (item >> 3) % 3, b = item / 24, ch = sl * 512 + 8 * lane;
            float cur[8]; unpack8(*(const v4u*)(PB + (size_t)(b * SEQ + SEQ - 3 + k) * NPB + PB_XBC + ch), cur);
            float* oc = X.out + O_CVP + (size_t)(b * 3 + k) * 4096 + ch;
            *(f32x4*)oc = (f32x4){cur[0], cur[1], cur[2], cur[3]}; *(f32x4*)(oc + 4) = (f32x4){cur[4], cur[5], cur[6], cur[7]};
        }
    }
}

__device__ __forceinline__ int tr_lane_off(int lane) { return (4 * (lane >> 5) + ((lane & 15) >> 2)) * 64 + ((lane >> 4) & 1) * 32 + (lane & 3) * 8; }
__device__ __forceinline__ bf16x8 tr_frag(const LAS unsigned char* piece, int lo) { const bf16x4 a = vtr(piece + lo), b = vtr(piece + lo + 512); return JOIN8(a, b); }
__device__ __forceinline__ void scan128(float v0, float v1, int lane, float& c0, float& c1, float& tot) {
    const float s = v0 + v1; float incl = s;
#pragma unroll
    for (int o = 1; o < 64; o <<= 1) { const float t = __shfl_up(incl, o); if (lane >= o) incl += t; }
    const float excl = incl - s; c0 = excl + v0; c1 = excl + s; tot = __shfl(incl, 63);
}

__device__ __forceinline__ void ssd_passA_all(const Ctx& X, const Args& a) {
    unsigned char* ws = X.ws; const int lane = X.lane, tid = X.tid, wave = X.wave;
    const bf16* XBC = (const bf16*)(ws + WS_XBC); const float* DT = (const float*)(ws + WS_DT); float* CS = (float*)(ws + WS_CS);
    LAS unsigned char* L = X.lds;
    LAS float* sc = (LAS float*)(X.lds + EXTRA_OFF);
    const int hh = wave >> 1, nh = wave & 1, lo = tr_lane_off(lane), hi = lane >> 5, r32 = lane & 31;
    unsigned voB = (unsigned)((tid >> 4) * 8192 + (tid & 15) * 16), voX = (unsigned)((tid >> 5) * 8192 + (tid & 31) * 16), voD = (unsigned)((2 * lane * 32 + (wave & 3)) * 4);
    v4u bv[4], xv[8]; float d0, d1, al;
#define PA_PREFETCH(item_) do { const int g_ = (item_) & 7, c_ = ((item_) >> 3) & 15, b_ = (item_) >> 7, row0_ = b_ * SEQ + c_ * 128; \
        const char* sb_ = (const char*)XBC + ((size_t)row0_ * 4096 + 2048 + g_ * 128) * 2; const char* sx_ = (const char*)XBC + ((size_t)row0_ * 4096 + g_ * 256) * 2; \
        _Pragma("unroll") for (int i = 0; i < 4; ++i) bv[i] = *(const v4u*)(sb_ + (size_t)i * 262144 + voB); \
        _Pragma("unroll") for (int i = 0; i < 8; ++i) xv[i] = *(const v4u*)(sx_ + (size_t)i * 131072 + voX); \
        const char* sd_ = (const char*)DT + ((size_t)row0_ * 32 + 4 * g_) * 4; d0 = *(const float*)(sd_ + voD); d1 = *(const float*)(sd_ + voD + 128); al = ((const float*)a.in[I_ALOG])[4 * g_ + (wave & 3)]; } while (0)
    { const int first = X.vcu < 1024 ? X.vcu : 0; PA_PREFETCH(first); }
    for (int item = X.vcu; item < 1024; item += X.G) {
        const int g = item & 7, c = (item >> 3) & 15, b = item >> 7, row0 = b * SEQ + c * 128;
        asm volatile("" : "+v"(voB), "+v"(voX), "+v"(voD));
        if (wave < 4) {
            const int h = 4 * g + wave; const float av = -__expf(al);
            float c0, c1, tot; scan128(d0 * av, d1 * av, lane, c0, c1, tot);
            sc[wave * 128 + 2 * lane] = __expf(tot - c0) * d0; sc[wave * 128 + 2 * lane + 1] = __expf(tot - c1) * d1;
            CS[(size_t)(row0 + 2 * lane) * 32 + h] = c0; CS[(size_t)(row0 + 2 * lane + 1) * 32 + h] = c1;
            if (lane == 0) ((float*)(ws + WS_CD))[(b * 16 + c) * 32 + h] = __expf(tot);
        }
        int tl = tid; asm volatile("" : "+v"(tl));
#pragma unroll
        for (int i = 0; i < 4; ++i) {
            const int q = tl + 512 * i, s_ = q >> 4, n = (q & 15) * 8;
            *(LAS v4u*)(L + ((n >> 5) * 8 + (s_ >> 4)) * 1024 + (s_ & 15) * 64 + (n & 31) * 2) = bv[i];
        }
        __syncthreads();
#pragma unroll
        for (int i = 0; i < 8; ++i) {
            const int q = tl + 512 * i, s_ = q >> 5, col = (q & 31) * 8, h_ = col >> 6, p = col & 63;
            float f[8]; unpack8(xv[i], f);
            const float scale = sc[h_ * 128 + s_];
#pragma unroll
            for (int j = 0; j < 8; ++j) f[j] *= scale;
            *(LAS v4u*)(L + 32768 + h_ * 16384 + ((p >> 5) * 8 + (s_ >> 4)) * 1024 + (s_ & 15) * 64 + (p & 31) * 2) = pack8(f);
        }
        __syncthreads();
        { const int nxt = item + X.G < 1024 ? item + X.G : item; PA_PREFETCH(nxt); }
        f32x16 acc[2][2];
#pragma unroll
        for (int i = 0; i < 2; ++i)
#pragma unroll
            for (int j = 0; j < 2; ++j)
#pragma unroll
                for (int r = 0; r < 16; ++r) acc[i][j][r] = 0.f;
#pragma unroll
        for (int ks = 0; ks < 8; ++ks) {
            const bf16x8 a0 = tr_frag(L + 32768 + hh * 16384 + (0 * 8 + ks) * 1024, lo), a1 = tr_frag(L + 32768 + hh * 16384 + (1 * 8 + ks) * 1024, lo);
            const bf16x8 b0 = tr_frag(L + ((2 * nh + 0) * 8 + ks) * 1024, lo), b1 = tr_frag(L + ((2 * nh + 1) * 8 + ks) * 1024, lo);
            acc[0][0] = __builtin_amdgcn_mfma_f32_32x32x16_bf16(a0, b0, acc[0][0], 0, 0, 0); acc[0][1] = __builtin_amdgcn_mfma_f32_32x32x16_bf16(a0, b1, acc[0][1], 0, 0, 0);
            acc[1][0] = __builtin_amdgcn_mfma_f32_32x32x16_bf16(a1, b0, acc[1][0], 0, 0, 0); acc[1][1] = __builtin_amdgcn_mfma_f32_32x32x16_bf16(a1, b1, acc[1][1], 0, 0, 0);
        }
        bf16* dst = (bf16*)(ws + WS_LOC) + (size_t)((b * 16 + c) * 32 + 4 * g + hh) * 8192;
#pragma unroll
        for (int pt = 0; pt < 2; ++pt)
#pragma unroll
            for (int nt = 0; nt < 2; ++nt)
#pragma unroll
                for (int r = 0; r < 16; ++r) dst[(32 * pt + crow(r, hi)) * 128 + 64 * nh + 32 * nt + r32] = (bf16)(pk2(acc[pt][nt][r], 0.f) & 0xffffu);
        __syncthreads();
    }
#undef PA_PREFETCH
}

__device__ __forceinline__ void ssd_passB(const Ctx& X) {
    unsigned char* ws = X.ws;
    const bf16* LOC = (const bf16*)(ws + WS_LOC); const float* CD = (const float*)(ws + WS_CD); bf16* PREV = (bf16*)(ws + WS_PREV);
    const int nthr = X.G * 512;
    const int NE = NBAT * 32 * 64 * 32;
    v2u lw[16]; float cd[16];
#define PB_LOAD(e_) do { const int n4_ = (e_) & 31, p_ = ((e_) >> 5) & 63, h_ = ((e_) >> 11) & 31, b_ = (e_) >> 16; \
        _Pragma("unroll") for (int c = 0; c < 16; ++c) { lw[c] = *(const v2u*)(LOC + (size_t)((b_ * 16 + c) * 32 + h_) * 8192 + p_ * 128 + 4 * n4_); cd[c] = CD[(b_ * 16 + c) * 32 + h_]; } } while (0)
    { const int e0 = X.vcu * 512 + X.tid; PB_LOAD(e0 < NE ? e0 : 0); }
    for (int e = X.vcu * 512 + X.tid; e < NE; e += nthr) {
        const int n4 = e & 31, p = (e >> 5) & 63, h = (e >> 11) & 31, b = e >> 16;
        f32x4 loc[16]; float cdc[16];
#pragma unroll
        for (int c = 0; c < 16; ++c) { loc[c] = (f32x4){bflo(lw[c].x), bfhi(lw[c].x), bflo(lw[c].y), bfhi(lw[c].y)}; cdc[c] = cd[c]; }
#pragma unroll
        for (int c = 0; c < 16; c += 4) asm volatile("" : "+v"(loc[c]), "+v"(loc[c + 1]), "+v"(loc[c + 2]), "+v"(loc[c + 3]), "+v"(cdc[c]), "+v"(cdc[c + 1]), "+v"(cdc[c + 2]), "+v"(cdc[c + 3]) :: "memory");
        { const int en = e + nthr < NE ? e + nthr : e; PB_LOAD(en); }
        f32x4 st = (f32x4){0.f, 0.f, 0.f, 0.f};
#pragma unroll
        for (int c = 0; c < 16; ++c) {
            v2u w; w.x = pk2(st.x, st.y); w.y = pk2(st.z, st.w);
            *(v2u*)(PREV + (size_t)((b * 16 + c) * 32 + h) * 8192 + p * 128 + 4 * n4) = w;
            st = st * cdc[c] + loc[c];
        }
        *(f32x4*)(X.out + O_SSP + (size_t)((b * 32 + h) * 64 + p) * 128 + 4 * n4) = st;
    }
#undef PB_LOAD
}

__device__ __forceinline__ void ssd_passC_all(const Ctx& X, const Args& a) {
    unsigned char* ws = X.ws; const int lane = X.lane, tid = X.tid, wave = X.wave;
    const bf16* XBC = (const bf16*)(ws + WS_XBC); const float* DT = (const float*)(ws + WS_DT); const bf16* PB = (const bf16*)(ws + WS_PB);
    const float* CS = (const float*)(ws + WS_CS); const bf16* PREV = (const bf16*)(ws + WS_PREV); bf16* OS = (bf16*)(ws + WS_OS);
    LAS unsigned char* L = X.lds;
    LAS float* cs = (LAS float*)(X.lds + EXTRA_OFF);
    LAS float* dts = cs + 512;
    const int hh = wave >> 1, wsel = wave & 1, lo = tr_lane_off(lane), hi = lane >> 5, r32 = lane & 31;
    const LAS float* csh = cs + hh * 128; const LAS float* dth = dts + hh * 128;
    const int lt_[2] = {wsel ? 1 : 0, wsel ? 2 : 3};
    v4u cbv[4], bbv[4], xv[8]; float csv, dtv;
    unsigned voCB = (unsigned)((tid >> 4) * 8192 + (tid & 15) * 16), voX = (unsigned)((tid >> 5) * 8192 + (tid & 31) * 16), voS = (unsigned)(((tid & 127) * 32 + (tid >> 7)) * 4), voP = (unsigned)((r32 * 128 + 8 * hi) * 2);
#define PC_PREFETCH(item_) do { const int g_ = (item_) & 7, c_ = ((item_) >> 3) & 15, b_ = (item_) >> 7, row0_ = b_ * SEQ + c_ * 128; \
        const char* sb_ = (const char*)XBC + ((size_t)row0_ * 4096 + g_ * 128) * 2; const char* sx_ = (const char*)XBC + ((size_t)row0_ * 4096 + g_ * 256) * 2; \
        _Pragma("unroll") for (int i = 0; i < 4; ++i) { cbv[i] = *(const v4u*)(sb_ + (size_t)i * 262144 + 6144 + voCB); bbv[i] = *(const v4u*)(sb_ + (size_t)i * 262144 + 4096 + voCB); } \
        _Pragma("unroll") for (int i = 0; i < 8; ++i) xv[i] = *(const v4u*)(sx_ + (size_t)i * 131072 + voX); \
        csv = *(const float*)((const char*)CS + ((size_t)row0_ * 32 + 4 * g_) * 4 + voS); dtv = *(const float*)((const char*)DT + ((size_t)row0_ * 32 + 4 * g_) * 4 + voS); \
        } while (0)
    { const int first = X.vcu < 1024 ? X.vcu : 0; PC_PREFETCH(first); }
    for (int item = X.vcu; item < 1024; item += X.G) {
        const int g = item & 7, c = (item >> 3) & 15, b = item >> 7, row0 = b * SEQ + c * 128;
        asm volatile("" : "+v"(voCB), "+v"(voX), "+v"(voS), "+v"(voP));
        const bf16* prev_ = (const bf16*)((const char*)(PREV + (size_t)((b * 16 + c) * 32 + 4 * g + hh) * 8192) + voP);
        bf16x8 pfa[4], pfb[4];
#pragma unroll
        for (int ks = 0; ks < 4; ++ks) { pfa[ks] = *(const bf16x8*)(prev_ + 16 * ks); pfb[ks] = *(const bf16x8*)(prev_ + 4096 + 16 * ks); }
        int tl = tid; asm volatile("" : "+v"(tl));
        cs[tl] = csv; dts[tl] = dtv;
#pragma unroll
        for (int i = 0; i < 4; ++i) { const int q = tl + 512 * i, s_ = q >> 4, ch = q & 15; *(LAS v4u*)(L + ch * 2048 + s_ * 16) = cbv[i]; *(LAS v4u*)(L + 32768 + ch * 2048 + s_ * 16) = bbv[i]; }
#pragma unroll
        for (int i = 0; i < 8; ++i) { const int q = tl + 512 * i, s_ = q >> 5, col = (q & 31) * 8, h_ = col >> 6, p = col & 63;
            *(LAS v4u*)(L + 65536 + h_ * 16384 + ((p >> 5) * 8 + (s_ >> 4)) * 1024 + (s_ & 15) * 64 + (p & 31) * 2) = xv[i]; }
        bf16x8 pfc[4], pfd[4];
#pragma unroll
        for (int ks = 0; ks < 4; ++ks) { pfc[ks] = *(const bf16x8*)(prev_ + 16 * (ks + 4)); pfd[ks] = *(const bf16x8*)(prev_ + 4096 + 16 * (ks + 4)); }
        __syncthreads();
        f32x16 Z[2][2];
#pragma unroll
        for (int i = 0; i < 2; ++i)
#pragma unroll
            for (int j = 0; j < 2; ++j)
#pragma unroll
                for (int r = 0; r < 16; ++r) Z[i][j][r] = 0.f;
        if (c > 0) {
#pragma unroll
            for (int ks = 0; ks < 8; ++ks) {
                const bf16x8 p0 = ks < 4 ? pfa[ks & 3] : pfc[ks & 3], p1 = ks < 4 ? pfb[ks & 3] : pfd[ks & 3];
#pragma unroll
                for (int li = 0; li < 2; ++li) {
                    const bf16x8 af = *(const LAS bf16x8*)(L + (2 * ks + hi) * 2048 + (32 * lt_[li] + r32) * 16);
                    Z[li][0] = __builtin_amdgcn_mfma_f32_32x32x16_bf16(af, p0, Z[li][0], 0, 0, 0); Z[li][1] = __builtin_amdgcn_mfma_f32_32x32x16_bf16(af, p1, Z[li][1], 0, 0, 0);
                }
            }
#pragma unroll
            for (int li = 0; li < 2; ++li)
#pragma unroll
                for (int q4 = 0; q4 < 4; ++q4) { const f32x4 cv = *(const LAS f32x4*)(csh + 32 * lt_[li] + 8 * q4 + 4 * hi);
#pragma unroll
                    for (int j = 0; j < 4; ++j) { const float e = __expf(cv[j]); Z[li][0][4 * q4 + j] *= e; Z[li][1][4 * q4 + j] *= e; } }
        }
#pragma unroll
        for (int li = 0; li < 2; ++li) {
            const int lt = lt_[li]; const float csl = csh[32 * lt + r32];
            for (int st = 0; st <= lt; ++st) {
                f32x16 Xt;
#pragma unroll
                for (int r = 0; r < 16; ++r) Xt[r] = 0.f;
#pragma unroll
                for (int ks = 0; ks < 8; ++ks) {
                    const bf16x8 af = *(const LAS bf16x8*)(L + 32768 + (2 * ks + hi) * 2048 + (32 * st + r32) * 16);
                    const bf16x8 bf = *(const LAS bf16x8*)(L + (2 * ks + hi) * 2048 + (32 * lt + r32) * 16);
                    Xt = __builtin_amdgcn_mfma_f32_32x32x16_bf16(af, bf, Xt, 0, 0, 0);
                }
#pragma unroll
                for (int q4 = 0; q4 < 4; ++q4) { const f32x4 cv = *(const LAS f32x4*)(csh + 32 * st + 8 * q4 + 4 * hi); const f32x4 dv = *(const LAS f32x4*)(dth + 32 * st + 8 * q4 + 4 * hi);
#pragma unroll
                    for (int j = 0; j < 4; ++j) { const int sl = 8 * q4 + 4 * hi + j; const float wgt = (st < lt || sl <= r32) ? __expf(csl - cv[j]) * dv[j] : 0.f; Xt[4 * q4 + j] *= wgt; } }
                v4u pw0, pw1;
                pw0.x = pk2(Xt[0], Xt[1]); pw0.y = pk2(Xt[2], Xt[3]); pw0.z = pk2(Xt[4], Xt[5]); pw0.w = pk2(Xt[6], Xt[7]);
                pw1.x = pk2(Xt[8], Xt[9]); pw1.y = pk2(Xt[10], Xt[11]); pw1.z = pk2(Xt[12], Xt[13]); pw1.w = pk2(Xt[14], Xt[15]);
                const bf16x8 pa0 = __builtin_bit_cast(bf16x8, pw0), pa1 = __builtin_bit_cast(bf16x8, pw1);
                const LAS unsigned char* xi = L + 65536 + hh * 16384;
#pragma unroll
                for (int pt = 0; pt < 2; ++pt) {
                    const bf16x8 v0 = tr_frag(xi + (pt * 8 + 2 * st) * 1024, lo), v1 = tr_frag(xi + (pt * 8 + 2 * st + 1) * 1024, lo);
                    Z[li][pt] = __builtin_amdgcn_mfma_f32_32x32x16_bf16(pa0, v0, Z[li][pt], 0, 0, 0);
                    Z[li][pt] = __builtin_amdgcn_mfma_f32_32x32x16_bf16(pa1, v1, Z[li][pt], 0, 0, 0);
                }
            }
        }
        __syncthreads();
        { const int nxt = item + X.G < 1024 ? item + X.G : item; PC_PREFETCH(nxt); }
        {
            const float dsk = ((const float*)a.in[I_DSKIP])[4 * g + (lane >> 4)];
            const f32x4 gs = *(const f32x4*)((const float*)a.in[I_GSSM] + g * 256 + 4 * lane);
            LAS float* Y = (LAS float*)L;
            const int xh = lane >> 4, xp = 4 * (lane & 15);
            v2u zv16[2][8];
#pragma unroll
            for (int i = 0; i < 8; ++i) zv16[0][i] = *(const v2u*)(PB + (size_t)(row0 + 8 * wave + i) * NPB + PB_Z + g * 256 + 4 * lane);
#pragma unroll
            for (int hb = 0; hb < 2; ++hb) {
#pragma unroll
                for (int pt = 0; pt < 2; ++pt)
#pragma unroll
                    for (int r = 0; r < 16; ++r) Y[(32 * (lt_[hb] & 1) + crow(r, hi)) * 256 + hh * 64 + 32 * pt + r32] = Z[hb][pt][r];
                if (hb == 0) {
#pragma unroll
                    for (int i = 0; i < 8; ++i) zv16[1][i] = *(const v2u*)(PB + (size_t)(row0 + 64 + 8 * wave + i) * NPB + PB_Z + g * 256 + 4 * lane);
                }
                __syncthreads();
#pragma unroll
                for (int i1 = 0; i1 < 8; ++i1) {
                    const int lr = 8 * wave + i1, l = 64 * hb + lr, row = row0 + l;
                    const v2u zv = zv16[hb][i1];
                    const f32x4 y = *(const LAS f32x4*)(Y + lr * 256 + 4 * lane);
                    const v2u xw = *(const LAS v2u*)(L + 65536 + xh * 16384 + ((xp >> 5) * 8 + (l >> 4)) * 1024 + (l & 15) * 64 + (xp & 31) * 2);
                    f32x4 v;
                    { const f32x2 s01 = silu2((f32x2){bflo(zv.x), bfhi(zv.x)}), s23 = silu2((f32x2){bflo(zv.y), bfhi(zv.y)});
                      v.x = (y.x + dsk * bflo(xw.x)) * s01.x; v.y = (y.y + dsk * bfhi(xw.x)) * s01.y; v.z = (y.z + dsk * bflo(xw.y)) * s23.x; v.w = (y.w + dsk * bfhi(xw.y)) * s23.y; }
                    const float ss = wave_sum((v.x * v.x + v.y * v.y) + (v.z * v.z + v.w * v.w));
                    const float rs = rsqrtf(ss * (1.f / 256.f) + EPS);
                    v2u o; o.x = pk2(v.x * rs * gs.x, v.y * rs * gs.y); o.y = pk2(v.z * rs * gs.z, v.w * rs * gs.w);
                    *(v2u*)(OS + (size_t)row * 2048 + g * 256 + 4 * lane) = o;
                }
                __syncthreads();
            }
        }
    }
#undef PC_PREFETCH
}

constexpr int AT_NSLOT = 4, AT_SLOT = 20480, AT_WS = AT_NSLOT * AT_SLOT  , AT_OST = 86016;
#define AT_WAIT_BAR(N) asm volatile("s_waitcnt vmcnt(" #N ") lgkmcnt(0)\n\ts_barrier" ::: "memory")
#define AT_SB() __builtin_amdgcn_sched_barrier(0)
__device__ __forceinline__ void attn_unit(const Ctx& X, int b, int h, int qb, int nqb, bf16x8 (&qn)[6], bool first) {
    unsigned char* ws = X.ws; int lane = X.lane, wave = X.wave; asm volatile("" : "+v"(lane)); asm volatile("" : "+s"(wave));
    const int r32 = lane & 31, hi = lane >> 5;
    const bf16* Q = (const bf16*)(ws + WS_Q); const bf16* KNV = (const bf16*)(ws + WS_KNV); const bf16* KPE = (const bf16*)(ws + WS_KPE); bf16* OA = (bf16*)(ws + WS_OA);
    const size_t rowbase = (size_t)b * SEQ; const int q0 = qb * 256, NT = 4 * (qb + 1);
    LAS unsigned char* L = X.lds; const unsigned lds0 = (unsigned)(uintptr_t)L;
    LAS float* wsf = (LAS float*)(L + AT_WS) + wave * 64;
    const bf16* ksrc = KNV + (rowbase + lane) * 2048 + h * 64 + wave * 8;
    const bf16* rsrc = KPE + (rowbase + lane) * 32 + (wave & 3) * 8;
    const bf16* vsrc = KNV + (rowbase + 16 * (wave & 3) + (lane >> 2)) * 2048 + 1024 + h * 64 + (wave >> 2) * 32 + (lane & 3) * 8;
    const unsigned kdst = lds0 + wave * 1024, rdst = lds0 + (8 + (wave & 3)) * 1024, vdst = lds0 + 12288 + wave * 1024;
#define AT_DMA(t, slot) do { const unsigned so_ = (unsigned)(slot) * AT_SLOT; \
        glds16(ksrc + (size_t)(t) * 64 * 2048, (unsigned)__builtin_amdgcn_readfirstlane(kdst + so_)); \
        glds16(rsrc + (size_t)(t) * 64 * 32, (unsigned)__builtin_amdgcn_readfirstlane(rdst + so_)); \
        glds16(vsrc + (size_t)(t) * 64 * 2048, (unsigned)__builtin_amdgcn_readfirstlane(vdst + so_)); } while (0)
    if (first) { AT_DMA(0, 0); AT_DMA(1, 1); }
    bf16x8 qr[6];
    { const bf16* qp = Q + (rowbase + q0 + wave * 32 + r32) * QW + h * 96 + hi * 8;
#pragma unroll
      for (int d0 = 0; d0 < 6; ++d0) qr[d0] = first ? *(const bf16x8*)(qp + d0 * 16) : qn[d0];
#pragma unroll
      for (int d0 = 0; d0 < 6; ++d0) asm volatile("" : "+v"(qr[d0])); }
    float mhat = 0.f, l_run = 0.f; f32x16 o[2], pC0, pC1, pP0, pP1, negm;
#pragma unroll
    for (int r = 0; r < 16; ++r) { o[0][r] = 0.f; o[1][r] = 0.f; pP0[r] = 0.f; pP1[r] = 0.f; negm[r] = 0.f; }
    const int qrow = q0 + wave * 32 + r32, qmax_w = q0 + wave * 32 + 31;
    const int Tw = (qmax_w >> 6) < NT - 1 ? (qmax_w >> 6) : NT - 1;
    const int lo = tr_lane_off(lane);
    int slot = 0, pslot = 0;
#define AT_KRD(dst0, dst1, Ks_, d0_) do { dst0 = *(const LAS bf16x8*)((Ks_) + (2 * (d0_) + hi) * 1024 + r32 * 16); dst1 = *(const LAS bf16x8*)((Ks_) + (2 * (d0_) + hi) * 1024 + 512 + r32 * 16); } while (0)
#define AT_MASK(C0, C1, t_) do { if (64 * (t_) + 63 > q0 + wave * 32) { const int kb_ = 64 * (t_) + 4 * hi; \
        _Pragma("unroll") for (int r = 0; r < 16; ++r) { const int kv_ = kb_ + (r & 3) + 8 * (r >> 2); if (kv_ > qrow) C0[r] = -INFINITY; if (kv_ + 32 > qrow) C1[r] = -INFINITY; } } } while (0)
#define AT_ROWMAX(C0, C1, rm_) do { asm("v_max_f32 %0, %1, %2" : "=v"(rm_) : "v"(C0[0]), "v"(C1[0]));   \
        _Pragma("unroll") for (int r = 1; r < 16; ++r) asm("v_max3_f32 %0, %0, %1, %2" : "+v"(rm_) : "v"(C0[r]), "v"(C1[r])); rm_ = fmaxf(rm_, __shfl_xor(rm_, 32)); } while (0)
#define AT_SUM8(P_, B_) ((((f32x2){P_[B_], P_[B_ + 1]} + (f32x2){P_[B_ + 2], P_[B_ + 3]})) + (((f32x2){P_[B_ + 4], P_[B_ + 5]} + (f32x2){P_[B_ + 6], P_[B_ + 7]})))
#define AT_PACK(w_, P_, B_) do { w_.x = pk2(P_[B_], P_[B_ + 1]); w_.y = pk2(P_[B_ + 2], P_[B_ + 3]); w_.z = pk2(P_[B_ + 4], P_[B_ + 5]); w_.w = pk2(P_[B_ + 6], P_[B_ + 7]); } while (0)
    for (int t = 0; t < NT; ++t) {
        if (t + 1 < NT) { AT_WAIT_BAR(3); } else { AT_WAIT_BAR(0); }
        if (t + 2 < NT) { const int s2 = (slot + 2) & 3; AT_DMA(t + 2, s2); }
        if (nqb >= 0 && t == NT - 1) { AT_DMA(0, 0); AT_DMA(1, 1); }
        if (t <= Tw) {
            const LAS unsigned char* Ks = L + slot * AT_SLOT;
            if (t == 0) {
                bf16x8 ka0, ka1;
#pragma unroll
                for (int r = 0; r < 16; ++r) { pP0[r] = 0.f; pP1[r] = 0.f; }
#pragma unroll
                for (int d0 = 0; d0 < 6; ++d0) { AT_KRD(ka0, ka1, Ks, d0); pP0 = __builtin_amdgcn_mfma_f32_32x32x16_bf16(ka0, qr[d0], pP0, 0, 0, 0); pP1 = __builtin_amdgcn_mfma_f32_32x32x16_bf16(ka1, qr[d0], pP1, 0, 0, 0); }
                AT_MASK(pP0, pP1, 0);
                float rm; AT_ROWMAX(pP0, pP1, rm);
                mhat = rm;
#pragma unroll
                for (int r = 0; r < 16; ++r) negm[r] = -rm;
#pragma unroll
                for (int r = 0; r < 16; ++r) { pP0[r] = __builtin_amdgcn_exp2f(pP0[r] - rm); pP1[r] = __builtin_amdgcn_exp2f(pP1[r] - rm); }
            } else {
                const LAS unsigned char* Vp = L + pslot * AT_SLOT + 12288;
                bf16x8 ka0, ka1, kb0, kb1, va0, va1, vb0, vb1; v4u pw0, pw1, pw2, pw3; f32x2 sacc2;
                AT_KRD(ka0, ka1, Ks, 0); AT_KRD(kb0, kb1, Ks, 1); AT_SB();
                pC0 = __builtin_amdgcn_mfma_f32_32x32x16_bf16(ka0, qr[0], negm, 0, 0, 0); pC1 = __builtin_amdgcn_mfma_f32_32x32x16_bf16(ka1, qr[0], negm, 0, 0, 0);
                AT_KRD(ka0, ka1, Ks, 2);
                sacc2 = AT_SUM8(pP0, 0); AT_PACK(pw0, pP0, 0); AT_SB();
                pC0 = __builtin_amdgcn_mfma_f32_32x32x16_bf16(kb0, qr[1], pC0, 0, 0, 0); pC1 = __builtin_amdgcn_mfma_f32_32x32x16_bf16(kb1, qr[1], pC1, 0, 0, 0);
                AT_KRD(kb0, kb1, Ks, 3);
                sacc2 += AT_SUM8(pP0, 8); AT_PACK(pw1, pP0, 8); AT_SB();
                pC0 = __builtin_amdgcn_mfma_f32_32x32x16_bf16(ka0, qr[2], pC0, 0, 0, 0); pC1 = __builtin_amdgcn_mfma_f32_32x32x16_bf16(ka1, qr[2], pC1, 0, 0, 0);
                AT_KRD(ka0, ka1, Ks, 4);
                sacc2 += AT_SUM8(pP1, 0); AT_PACK(pw2, pP1, 0); AT_SB();
                pC0 = __builtin_amdgcn_mfma_f32_32x32x16_bf16(kb0, qr[3], pC0, 0, 0, 0); pC1 = __builtin_amdgcn_mfma_f32_32x32x16_bf16(kb1, qr[3], pC1, 0, 0, 0);
                AT_KRD(kb0, kb1, Ks, 5);
                sacc2 += AT_SUM8(pP1, 8); AT_PACK(pw3, pP1, 8); AT_SB();
                pC0 = __builtin_amdgcn_mfma_f32_32x32x16_bf16(ka0, qr[4], pC0, 0, 0, 0); pC1 = __builtin_amdgcn_mfma_f32_32x32x16_bf16(ka1, qr[4], pC1, 0, 0, 0);
                pC0 = __builtin_amdgcn_mfma_f32_32x32x16_bf16(kb0, qr[5], pC0, 0, 0, 0); pC1 = __builtin_amdgcn_mfma_f32_32x32x16_bf16(kb1, qr[5], pC1, 0, 0, 0);
                l_run += sacc2.x + sacc2.y;
                AT_MASK(pC0, pC1, t);
                float rm; AT_ROWMAX(pC0, pC1, rm);
                bool resc = false;
                if (__any(rm > 0.f)) {
                    const float dl = fmaxf(rm, 0.f); mhat += dl;
#pragma unroll
                    for (int r = 0; r < 16; ++r) negm[r] -= dl;
#pragma unroll
                    for (int r = 0; r < 16; ++r) { pC0[r] -= dl; pC1[r] -= dl; }
                    const float f = __builtin_amdgcn_exp2f(-dl); l_run *= f; if (hi == 0) wsf[r32] = f; resc = true;
                }
                AT_SB();
#define AT_EX4(C_, B_) do { C_[B_] = __builtin_amdgcn_exp2f(C_[B_]); C_[B_ + 1] = __builtin_amdgcn_exp2f(C_[B_ + 1]); C_[B_ + 2] = __builtin_amdgcn_exp2f(C_[B_ + 2]); C_[B_ + 3] = __builtin_amdgcn_exp2f(C_[B_ + 3]); } while (0)
                va0 = tr_frag(Vp, lo); va1 = tr_frag(Vp + 4096, lo); vb0 = tr_frag(Vp + 1024, lo); vb1 = tr_frag(Vp + 4096 + 1024, lo); AT_SB();
                o[0] = __builtin_amdgcn_mfma_f32_32x32x16_bf16(__builtin_bit_cast(bf16x8, pw0), va0, o[0], 0, 0, 0); AT_EX4(pC0, 0); AT_SB();
                o[1] = __builtin_amdgcn_mfma_f32_32x32x16_bf16(__builtin_bit_cast(bf16x8, pw0), va1, o[1], 0, 0, 0); AT_EX4(pC0, 4); va0 = tr_frag(Vp + 2048, lo); va1 = tr_frag(Vp + 4096 + 2048, lo); AT_SB();
                o[0] = __builtin_amdgcn_mfma_f32_32x32x16_bf16(__builtin_bit_cast(bf16x8, pw1), vb0, o[0], 0, 0, 0); AT_EX4(pC0, 8); AT_SB();
                o[1] = __builtin_amdgcn_mfma_f32_32x32x16_bf16(__builtin_bit_cast(bf16x8, pw1), vb1, o[1], 0, 0, 0); AT_EX4(pC0, 12); vb0 = tr_frag(Vp + 3072, lo); vb1 = tr_frag(Vp + 4096 + 3072, lo); AT_SB();
                o[0] = __builtin_amdgcn_mfma_f32_32x32x16_bf16(__builtin_bit_cast(bf16x8, pw2), va0, o[0], 0, 0, 0); AT_EX4(pC1, 0); AT_SB();
                o[1] = __builtin_amdgcn_mfma_f32_32x32x16_bf16(__builtin_bit_cast(bf16x8, pw2), va1, o[1], 0, 0, 0); AT_EX4(pC1, 4); AT_SB();
                o[0] = __builtin_amdgcn_mfma_f32_32x32x16_bf16(__builtin_bit_cast(bf16x8, pw3), vb0, o[0], 0, 0, 0); AT_EX4(pC1, 8); AT_SB();
                o[1] = __builtin_amdgcn_mfma_f32_32x32x16_bf16(__builtin_bit_cast(bf16x8, pw3), vb1, o[1], 0, 0, 0); AT_EX4(pC1, 12); AT_SB();
#undef AT_EX4
                if (resc) {
                    LDS_WAIT();
#pragma unroll
                    for (int q4 = 0; q4 < 4; ++q4) { const f32x4 av = *(const LAS f32x4*)(wsf + 8 * q4 + 4 * hi);
#pragma unroll
                        for (int j = 0; j < 4; ++j) { o[0][4 * q4 + j] *= av[j]; o[1][4 * q4 + j] *= av[j]; } }
                }
                pP0 = pC0; pP1 = pC1;
            }
            if (t == Tw) {
                const LAS unsigned char* Vs = Ks + 12288;
                float sacc = 0.f;
#pragma unroll
                for (int r = 0; r < 16; ++r) sacc += pP0[r] + pP1[r];
                l_run += sacc;
                v4u pw[4]; AT_PACK(pw[0], pP0, 0); AT_PACK(pw[1], pP0, 8); AT_PACK(pw[2], pP1, 0); AT_PACK(pw[3], pP1, 8);
#pragma unroll
                for (int ks = 0; ks < 4; ++ks) {
                    const bf16x8 pa = __builtin_bit_cast(bf16x8, pw[ks]);
                    const bf16x8 v0 = tr_frag(Vs + ks * 1024, lo), v1 = tr_frag(Vs + 4096 + ks * 1024, lo);
                    o[0] = __builtin_amdgcn_mfma_f32_32x32x16_bf16(pa, v0, o[0], 0, 0, 0); o[1] = __builtin_amdgcn_mfma_f32_32x32x16_bf16(pa, v1, o[1], 0, 0, 0);
                }
            }
        }
        pslot = slot; slot = (slot + 1) & 3;
    }
    if (nqb >= 0) { const bf16* qp = Q + (rowbase + nqb * 256 + wave * 32 + r32) * QW + h * 96 + hi * 8;
#pragma unroll
      for (int d0 = 0; d0 < 6; ++d0) qn[d0] = *(const bf16x8*)(qp + d0 * 16); }
    l_run += __shfl_xor(l_run, 32);
    if (hi == 0) wsf[32 + r32] = l_run;
    LDS_WAIT();
    {
        LAS bf16* stg = (LAS bf16*)(L + AT_OST + wave * 4096);
#pragma unroll
        for (int q4 = 0; q4 < 4; ++q4) { const f32x4 lv = *(const LAS f32x4*)(wsf + 32 + 8 * q4 + 4 * hi);
#pragma unroll
            for (int j = 0; j < 4; ++j) { const float inv = __builtin_amdgcn_rcpf(lv[j]); const int orow = 8 * q4 + 4 * hi + j;
                stg[orow * 64 + r32] = (bf16)(pk2(o[0][4 * q4 + j] * inv, 0.f) & 0xffffu); stg[orow * 64 + 32 + r32] = (bf16)(pk2(o[1][4 * q4 + j] * inv, 0.f) & 0xffffu); } }
        LDS_WAIT();
        bf16* Ow = OA + (rowbase + q0 + wave * 32) * 1024 + h * 64;
#pragma unroll
        for (int i = 0; i < 4; ++i) { const int row = i * 8 + (lane >> 3), ch = lane & 7; const v4u v = *(const LAS v4u*)(stg + row * 64 + ch * 8); *(v4u*)(Ow + (size_t)row * 1024 + ch * 8) = v; }
    }
    if (nqb < 0) { AT_WAIT_BAR(0); }
#undef AT_DMA
#undef AT_KRD
#undef AT_MASK
#undef AT_ROWMAX
#undef AT_PACK
}
constexpr int PART_STRIDE = 4096 + 32;
__device__ __forceinline__ void decode_unit(const Ctx& X, const Args& a, int unit) {
    unsigned char* ws = X.ws; int lane = X.lane, tid = X.tid, wave = X.wave; asm volatile("" : "+v"(lane)); asm volatile("" : "+v"(tid)); asm volatile("" : "+s"(wave));
    const int b = unit >> 1, sp = unit & 1;
    const bf16* Q = (const bf16*)(ws + WS_Q) + (size_t)(MPR + b) * QW;
    LAS unsigned char* L = X.lds;
    LAS float* qf = (LAS float*)L;
    LAS bf16* Qp = (LAS bf16*)(L + 8192);
    float* QL = (float*)(ws + WS_QL) + (size_t)b * 16 * 288;
    const int* pt = (const int*)a.in[I_PT] + b * NPAGES + 32 * sp + 4 * wave;
    int pages[4];
#pragma unroll
    for (int i = 0; i < 4; ++i) pages[i] = pt[i];
    { bf16 q3[3];
#pragma unroll
      for (int i = 0; i < 3; ++i) q3[i] = Q[tid + 512 * i];
#pragma unroll
      for (int i = 0; i < 3; ++i) qf[tid + 512 * i] = bf1(q3[i]); }
    __syncthreads();
    {
        const int h = tid >> 5, r8 = (tid & 31) * 8; const bf16* wt = (const bf16*)(ws + WS_WUKV) + (size_t)(h * 64) * 256 + r8;
        float acc8[8];
#pragma unroll
        for (int j = 0; j < 8; ++j) acc8[j] = 0.f;
#pragma unroll 1
        for (int d0 = 0; d0 < 64; d0 += 16) {
            v4u wv[16];
#pragma unroll
            for (int d = 0; d < 16; ++d) wv[d] = *(const v4u*)(wt + (size_t)(d0 + d) * 256);
#pragma unroll
            for (int d = 0; d < 16; ++d) { const float q = qf[h * 96 + d0 + d]; float w[8]; unpack8(wv[d], w);
#pragma unroll
                for (int j = 0; j < 8; ++j) acc8[j] += q * w[j]; }
        }
#pragma unroll
        for (int j = 0; j < 8; ++j) { Qp[h * 288 + r8 + j] = (bf16)(pk2(acc8[j], 0.f) & 0xffffu); if (sp == 0) QL[h * 288 + r8 + j] = acc8[j]; }
        if (tid < 256) { const int hh = tid >> 4, i = tid & 15; const float x1 = qf[hh * 96 + 64 + 2 * i], x2 = qf[hh * 96 + 64 + 2 * i + 1];
            Qp[hh * 288 + 256 + i] = (bf16)(pk2(x1, 0.f) & 0xffffu); Qp[hh * 288 + 272 + i] = (bf16)(pk2(x2, 0.f) & 0xffffu);
            if (sp == 0) { QL[hh * 288 + 256 + i] = x1; QL[hh * 288 + 272 + i] = x2; } }
    }
    __syncthreads();
    const int kl = lane & 15, kq = lane >> 4;
    const LAS bf16* qfp = Qp + kl * 288 + 8 * kq;
    LAS unsigned char* Vt = L + 32768 + wave * 9216;
    f32x4 acc[16];
#pragma unroll
    for (int nb = 0; nb < 16; ++nb) acc[nb] = (f32x4){0.f, 0.f, 0.f, 0.f};
    float m_run = -INFINITY, l_run = 0.f;
    const float* ckv = (const float*)a.in[I_CKV]; const float* cpe = (const float*)a.in[I_CPE];
    const int vwoff = (lane >> 3) * 1024 + (lane & 7) * 8, vroff = (4 * kq + (kl >> 2)) * 64 + (kl & 3) * 8, kroff = kl * 64 + kq * 16;
#pragma unroll
    for (int i = 0; i < 4; ++i) pages[i] = __builtin_amdgcn_readfirstlane(pages[i]);
    f32x4 raw[18];
#define DC_ISSUE(blk_) do { const int pg_ = (blk_) >> 3; const int page_ = pg_ == 0 ? pages[0] : pg_ == 1 ? pages[1] : pg_ == 2 ? pages[2] : pages[3]; \
        const float* kp_ = ckv + ((size_t)page_ * PAGE + ((blk_) & 7) * 16) * 256 + 4 * lane; const float* pp_ = cpe + ((size_t)page_ * PAGE + ((blk_) & 7) * 16) * 32 + 4 * lane; \
        _Pragma("unroll") for (int r = 0; r < 16; ++r) raw[r] = __builtin_nontemporal_load((const f32x4*)(kp_ + r * 256)); \
        raw[16] = __builtin_nontemporal_load((const f32x4*)pp_); raw[17] = __builtin_nontemporal_load((const f32x4*)(pp_ + 256)); } while (0)
    DC_ISSUE(0);
    for (int blk = 0; blk < 32; ++blk) {
#pragma unroll
        for (int r = 0; r < 16; ++r) { v2u w; w.x = pk2(raw[r].x, raw[r].y); w.y = pk2(raw[r].z, raw[r].w); *(LAS v2u*)(Vt + vwoff + r * 64) = w; }
        { v2u w; w.x = pk2(raw[16].x, raw[16].y); w.y = pk2(raw[16].z, raw[16].w); *(LAS v2u*)(Vt + 8192 + (lane >> 3) * 64 + (lane & 7) * 8) = w;
          w.x = pk2(raw[17].x, raw[17].y); w.y = pk2(raw[17].z, raw[17].w); *(LAS v2u*)(Vt + 8192 + 512 + (lane >> 3) * 64 + (lane & 7) * 8) = w; }
        asm volatile("" ::: "memory");
        if (blk + 1 < 32) DC_ISSUE(blk + 1);
        asm volatile("" ::: "memory");
        f32x4 st = (f32x4){0.f, 0.f, 0.f, 0.f};
#pragma unroll
        for (int ks = 0; ks < 9; ++ks) st = __builtin_amdgcn_mfma_f32_16x16x32_bf16(*(const LAS bf16x8*)(Vt + ks * 1024 + kroff), *(const LAS bf16x8*)(qfp + 32 * ks), st, 0, 0, 0);
        float bm = fmaxf(fmaxf(st[0], st[1]), fmaxf(st[2], st[3]));
        bm = fmaxf(bm, __shfl_xor(bm, 16)); bm = fmaxf(bm, __shfl_xor(bm, 32));
        const float m_new = fmaxf(m_run, bm);
        if (__any(m_new > m_run)) { const float al = __builtin_amdgcn_exp2f(m_run - m_new); l_run *= al;
#pragma unroll
            for (int nb = 0; nb < 16; ++nb) acc[nb] = acc[nb] * al;
            m_run = m_new; }
        f32x4 p; p.x = __builtin_amdgcn_exp2f(st[0] - m_run); p.y = __builtin_amdgcn_exp2f(st[1] - m_run); p.z = __builtin_amdgcn_exp2f(st[2] - m_run); p.w = __builtin_amdgcn_exp2f(st[3] - m_run);
        l_run += (p.x + p.y) + (p.z + p.w);
        v2u pw; pw.x = pk2(p.x, p.y); pw.y = pk2(p.z, p.w); const bf16x4 pf = __builtin_bit_cast(bf16x4, pw);
#pragma unroll
        for (int nb = 0; nb < 16; ++nb) { const bf16x4 vf = vtr(Vt + (nb >> 1) * 1024 + vroff + (nb & 1) * 32);
            acc[nb] = __builtin_amdgcn_mfma_f32_16x16x16bf16_1k(vf, pf, acc[nb], 0, 0, 0); }
        asm volatile("" ::: "memory");
    }
#undef DC_ISSUE
    l_run += __shfl_xor(l_run, 16); l_run += __shfl_xor(l_run, 32);
    LAS float* mw = (LAS float*)(X.lds + EXTRA_OFF); LAS float* lw = mw + 128;
    if (lane < 16) { mw[wave * 16 + lane] = m_run; lw[wave * 16 + lane] = l_run; }
    __syncthreads();
    float M = mw[kl];
#pragma unroll
    for (int w = 1; w < 8; ++w) M = fmaxf(M, mw[w * 16 + kl]);
    const float sc = __builtin_amdgcn_exp2f(m_run - M);
    LAS float* Ow = (LAS float*)L + wave * 4096;
#pragma unroll
    for (int nb = 0; nb < 16; ++nb)
#pragma unroll
        for (int r = 0; r < 4; ++r) Ow[(16 * nb + 4 * kq + r) * 16 + kl] = acc[nb][r] * sc;
    __syncthreads();
    float* P = (float*)(ws + WS_PART) + (size_t)(b * 2 + sp) * PART_STRIDE;
#pragma unroll
    for (int i = 0; i < 8; ++i) { const int e = tid + 512 * i; float s = 0.f;
#pragma unroll
        for (int w = 0; w < 8; ++w) s += ((LAS float*)L)[w * 4096 + e];
        P[32 + (e & 15) * 256 + (e >> 4)] = s; }
    if (tid < 16) { float Mh = mw[tid];
#pragma unroll
        for (int w = 1; w < 8; ++w) Mh = fmaxf(Mh, mw[w * 16 + tid]);
        float Ls = 0.f;
#pragma unroll
        for (int w = 0; w < 8; ++w) Ls += lw[w * 16 + tid] * __builtin_amdgcn_exp2f(mw[w * 16 + tid] - Mh);
        P[tid] = Mh; P[16 + tid] = Ls; }
    __syncthreads();
}

__device__ __forceinline__ void decode_combine(const Ctx& X, const Args& a, int unit) {
    unsigned char* ws = X.ws; const int lane = X.lane, tid = X.tid, wave = X.wave, b = unit >> 1, h = 8 * (unit & 1) + wave;
    const float* P0 = (const float*)(ws + WS_PART) + (size_t)(b * 2) * PART_STRIDE; const float* P1 = P0 + PART_STRIDE;
    const float* QL = (const float*)(ws + WS_QL) + (size_t)b * 16 * 288 + h * 288;
    const float* ck = X.out + O_KVS + (size_t)b * 256; const float* kr = X.out + O_KRS + (size_t)b * 32;
    LAS float* ol = (LAS float*)X.lds + wave * 256;
    float s = 0.f;
#pragma unroll
    for (int j = 0; j < 4; ++j) s += QL[lane + 64 * j] * ck[lane + 64 * j];
    if (lane < 32) s += QL[256 + lane] * kr[lane];
    s = wave_sum(s);
    const float m0 = P0[h], m1 = P1[h], M = fmaxf(fmaxf(m0, m1), s);
    const float e0 = __builtin_amdgcn_exp2f(m0 - M), e1 = __builtin_amdgcn_exp2f(m1 - M), en = __builtin_amdgcn_exp2f(s - M);
    const float inv = 1.0f / (P0[16 + h] * e0 + P1[16 + h] * e1 + en);
    const float w0 = e0 * inv, w1 = e1 * inv, wn = en * inv;
#pragma unroll
    for (int j = 0; j < 4; ++j) { const int r = lane + 64 * j; ol[r] = P0[32 + h * 256 + r] * w0 + P1[32 + h * 256 + r] * w1 + ck[r] * wn; }
    LDS_WAIT(); asm volatile("" ::: "memory");
    const float* wp = (const float*)a.in[I_WUV] + h * 64 + lane; float o = 0.f;
#pragma unroll 1
    for (int r0 = 0; r0 < 256; r0 += 32) { float wv[32];
#pragma unroll
        for (int r = 0; r < 32; ++r) wv[r] = wp[(size_t)(r0 + r) * 1024];
#pragma unroll
        for (int r = 0; r < 32; ++r) o += ol[r0 + r] * wv[r]; }
    ((bf16*)(ws + WS_OA))[(size_t)(MPR + b) * 1024 + h * 64 + lane] = (bf16)(pk2(o, 0.f) & 0xffffu);
    LDS_WAIT(); asm volatile("" ::: "memory");
}

__device__ __forceinline__ void smp_ssm_item(const Ctx& X, const Args& a, int item) {
    unsigned char* ws = X.ws; const int lane = X.lane, wave = X.wave, g = item & 7, b = item >> 3, row = MPR + b;
    const bf16* XBC = (const bf16*)(ws + WS_XBC) + (size_t)row * 4096; const bf16* PB = (const bf16*)(ws + WS_PB) + (size_t)row * NPB;
    const int hh = wave >> 1, ph = wave & 1, h = 4 * g + hh, n4 = 4 * (lane & 31), prow = lane >> 5;
    const float dt = ((const float*)(ws + WS_DT))[(size_t)row * 32 + h], dA = __expf(-__expf(((const float*)a.in[I_ALOG])[h]) * dt);
    const v2u bw = *(const v2u*)(XBC + 2048 + g * 128 + n4), cw = *(const v2u*)(XBC + 3072 + g * 128 + n4);
    const f32x4 Bv = (f32x4){bflo(bw.x), bfhi(bw.x), bflo(bw.y), bfhi(bw.y)}, Cv = (f32x4){bflo(cw.x), bfhi(cw.x), bflo(cw.y), bfhi(cw.y)};
    const float* sin_ = (const float*)a.in[I_SSM] + (size_t)((b * 32 + h) * 64) * 128 + n4; float* sout = X.out + O_SSS + (size_t)((b * 32 + h) * 64) * 128 + n4;
    LAS float* ys = (LAS float*)(X.lds + EXTRA_OFF);
    const float dsk = ((const float*)a.in[I_DSKIP])[4 * g + (lane >> 4)]; const f32x4 gs = *(const f32x4*)((const float*)a.in[I_GSSM] + g * 256 + 4 * lane);
    const v2u xw = *(const v2u*)(XBC + g * 256 + 4 * lane), zw = *(const v2u*)(PB + PB_Z + g * 256 + 4 * lane);
    f32x4 st[16]; bf16 xr[16];
#pragma unroll
    for (int i = 0; i < 16; ++i) { st[i] = __builtin_nontemporal_load((const f32x4*)(sin_ + (size_t)(32 * ph + 2 * i + prow) * 128)); xr[i] = XBC[h * 64 + 32 * ph + 2 * i + prow]; }
#pragma unroll
    for (int i = 0; i < 16; ++i) { const int p = 32 * ph + 2 * i + prow; const float xv = bf1(xr[i]) * dt;
        const f32x4 nw = st[i] * dA + Bv * xv; __builtin_nontemporal_store(nw, (f32x4*)(sout + (size_t)p * 128));
        float part = (nw.x * Cv.x + nw.y * Cv.y) + (nw.z * Cv.z + nw.w * Cv.w);
#pragma unroll
        for (int o = 1; o < 32; o <<= 1) part += __shfl_xor(part, o);
        if ((lane & 31) == 0) ys[hh * 64 + p] = part; }
    __syncthreads();
    if (wave == 0) {
        const f32x4 y = *(const LAS f32x4*)(ys + 4 * lane);
        f32x4 v;
        v.x = (y.x + dsk * bflo(xw.x)) * silu(bflo(zw.x)); v.y = (y.y + dsk * bfhi(xw.x)) * silu(bfhi(zw.x));
        v.z = (y.z + dsk * bflo(xw.y)) * silu(bflo(zw.y)); v.w = (y.w + dsk * bfhi(xw.y)) * silu(bfhi(zw.y));
        const float ss = wave_sum((v.x * v.x + v.y * v.y) + (v.z * v.z + v.w * v.w)); const float rs = rsqrtf(ss * (1.f / 256.f) + EPS);
        v2u o; o.x = pk2(v.x * rs * gs.x, v.y * rs * gs.y); o.y = pk2(v.z * rs * gs.z, v.w * rs * gs.w);
        *(v2u*)((bf16*)(ws + WS_OS) + (size_t)row * 2048 + g * 256 + 4 * lane) = o;
    }
    __syncthreads();
}

__device__ __forceinline__ void ph_norm1(const Ctx& X, const Args& a) {
    unsigned char* ws = X.ws; const bf16* MIX = (const bf16*)(ws + WS_MIX); bf16* X1 = (bf16*)(ws + WS_X1); bf16* XN = (bf16*)(ws + WS_XN);
    const GAS f32x4* g1p = (const GAS f32x4*)a.in[I_GPOSTMIX] + X.lane; const GAS f32x4* g2p = (const GAS f32x4*)a.in[I_GPREMLP] + X.lane; f32x4 g1[4], g2[4];
#pragma unroll
    for (int j = 0; j < 4; ++j) { g1[j] = g1p[64 * j]; g2[j] = g2p[64 * j]; }
    for (int m0 = X.gw; m0 < MR; m0 += 2 * X.NGW) {
        int mm[2]; mm[0] = m0; mm[1] = m0 + X.NGW < MR ? m0 + X.NGW : m0;
        f32x4 v[2][4], x[2][4];
#pragma unroll
        for (int q = 0; q < 2; ++q) { const int m = mm[q];
            const float* xrow = m < MPR ? (const float*)a.in[I_XP] + (size_t)m * DM : (const float*)a.in[I_XS] + (size_t)(m - MPR) * DM;
            const GAS f32x4* xr = (const GAS f32x4*)xrow + X.lane; const GAS v2u* mr = (const GAS v2u*)(MIX + (size_t)m * DM) + X.lane;
#pragma unroll
            for (int j = 0; j < 4; ++j) { const v2u mw = mr[64 * j]; v[q][j] = (f32x4){bflo(mw.x), bfhi(mw.x), bflo(mw.y), bfhi(mw.y)}; x[q][j] = xr[64 * j]; } }
#pragma unroll
        for (int q = 0; q < 2; ++q) { const int m = mm[q]; float s = 0.f;
#pragma unroll
            for (int j = 0; j < 4; ++j) s += (v[q][j].x * v[q][j].x + v[q][j].y * v[q][j].y) + (v[q][j].z * v[q][j].z + v[q][j].w * v[q][j].w);
            const float rs = rsqrtf(wave_sum(s) * (1.f / DM) + EPS); float s2 = 0.f;
#pragma unroll
            for (int j = 0; j < 4; ++j) { x[q][j] = x[q][j] + v[q][j] * rs * g1[j]; s2 += (x[q][j].x * x[q][j].x + x[q][j].y * x[q][j].y) + (x[q][j].z * x[q][j].z + x[q][j].w * x[q][j].w); }
            const float rs2 = rsqrtf(wave_sum(s2) * (1.f / DM) + EPS);
            GAS unsigned long long* o4 = (GAS unsigned long long*)(X1 + (size_t)m * DM) + X.lane; GAS unsigned long long* o8 = (GAS unsigned long long*)(XN + (size_t)m * DM) + X.lane;
#pragma unroll
            for (int j = 0; j < 4; ++j) { o4[64 * j] = (unsigned long long)pk2(x[q][j].x, x[q][j].y) | ((unsigned long long)pk2(x[q][j].z, x[q][j].w) << 32); const f32x4 t = x[q][j] * rs2 * g2[j]; o8[64 * j] = (unsigned long long)pk2(t.x, t.y) | ((unsigned long long)pk2(t.z, t.w) << 32); }
        }
    }
}
__device__ __forceinline__ void ph_norm2(const Ctx& X, const Args& a) {
    unsigned char* ws = X.ws; const bf16* Fb = (const bf16*)(ws + WS_F); const bf16* X1 = (const bf16*)(ws + WS_X1);
    const GAS f32x4* gp = (const GAS f32x4*)a.in[I_GPOSTMLP] + X.lane; f32x4 g[4];
#pragma unroll
    for (int j = 0; j < 4; ++j) g[j] = gp[64 * j];
    for (int m0 = X.gw; m0 < MR; m0 += 2 * X.NGW) {
        int mm[2]; mm[0] = m0; mm[1] = m0 + X.NGW < MR ? m0 + X.NGW : m0;
        f32x4 v[2][4], x[2][4];
#pragma unroll
        for (int q = 0; q < 2; ++q) { const int m = mm[q];
            const GAS v2u* fr = (const GAS v2u*)(Fb + (size_t)m * DM) + X.lane; const GAS v2u* xr = (const GAS v2u*)(X1 + (size_t)m * DM) + X.lane;
#pragma unroll
            for (int j = 0; j < 4; ++j) { const v2u fw = fr[64 * j]; v[q][j] = (f32x4){bflo(fw.x), bfhi(fw.x), bflo(fw.y), bfhi(fw.y)}; const v2u xw = xr[64 * j]; x[q][j] = (f32x4){bflo(xw.x), bfhi(xw.x), bflo(xw.y), bfhi(xw.y)}; } }
#pragma unroll
        for (int q = 0; q < 2; ++q) { const int m = mm[q]; float s = 0.f;
#pragma unroll
            for (int j = 0; j < 4; ++j) s += (v[q][j].x * v[q][j].x + v[q][j].y * v[q][j].y) + (v[q][j].z * v[q][j].z + v[q][j].w * v[q][j].w);
            const float rs = rsqrtf(wave_sum(s) * (1.f / DM) + EPS);
            float* orow = m < MPR ? X.out + O_YP + (size_t)m * DM : X.out + O_YS + (size_t)(m - MPR) * DM;
            GAS f32x4* o4 = (GAS f32x4*)orow + X.lane;
#pragma unroll
            for (int j = 0; j < 4; ++j) o4[64 * j] = x[q][j] + v[q][j] * rs * g[j];
        }
    }
}

#ifndef MK_N_LAUNCHES
#define MK_N_LAUNCHES 1
#endif
constexpr int N_PHASES = 12;
constexpr int N_LAUNCHES = MK_N_LAUNCHES;
static_assert(N_LAUNCHES == 1 || N_LAUNCHES == N_PHASES, "MK_N_LAUNCHES is 1 or 12");

__global__ void __launch_bounds__(NWAVES * 64, 2) fwd_kernel(Args args) {
    extern __shared__ __attribute__((aligned(16))) unsigned char lds[];
    Ctx X;
    X.lds = (LAS unsigned char*)lds; X.tid = threadIdx.x; X.lane = X.tid & 63; X.wave = __builtin_amdgcn_readfirstlane(X.tid >> 6);
    X.G = gridDim.x; { const int bx = blockIdx.x; X.vcu = (X.G % 8 == 0) ? (bx % 8) * (X.G / 8) + bx / 8 : bx; }
    X.gw = X.vcu * NWAVES + X.wave; X.NGW = X.G * NWAVES; X.ws = args.ws; X.out = args.out;
    unsigned char* ws = args.ws;
    gu32* ctl = (gu32*)(ws + WS_CTL);
    volatile LAS unsigned* MISC = (volatile LAS unsigned*)(X.lds + MISC_OFF);
    for (int u = X.tid; u < (LDS_BYTES - LDSCTL_OFF) / 4; u += NWAVES * 64) ((LAS unsigned*)(X.lds + LDSCTL_OFF))[u] = 0u;
    __syncthreads();
    XcdBarrier bar; bar.bar = (unsigned*)(ctl + CW_BAR); bar.x = 0; bar.st = nullptr;
    if (N_LAUNCHES == 1) bar = xcd_barrier_post((unsigned*)(ctl + CW_BAR), MISC + 8);
#define GRID_BAR() do { if (N_LAUNCHES == 1) xcd_barrier(bar); } while (0)
    const int lo = args.ph_lo, hi = args.ph_hi;
#ifndef PH_MASK
#define PH_MASK 0xFFF
#endif
#define IN(k) (((PH_MASK >> (k)) & 1) && lo <= (k) && (k) < hi)
#define BOTH(k) (IN(k) && IN((k) + 1))
    const pg8::bf16_t* XN = (const pg8::bf16_t*)(ws + WS_XN);
    const int cb = (int)blockIdx.x;

    if (IN(0)) { ph0_prologue(X, args, 0); if (BOTH(0)) GRID_BAR(); }

    if (IN(1)) {
        pg8::Gemm g{XN, (const pg8::bf16_t*)(ws + WS_WIN), MP, NIN, 1024, 1024, 1024}; pg8::StaticOrder S; S.init(MP, NIN, X.G, cb);
        pg8::Epi<pg8::EM_P1> E{(void*)(ws + WS_PF), NPF, (void*)(ws + WS_PB), NPB, nullptr, 0, nullptr};
        const int grpW = (X.vcu >> 1) & 1;
        if (grpW == 0) { ph0_prologue(X, args, 1); __syncthreads(); }
        pg8::gemm_phase<pg8::Epi<pg8::EM_P1>, pg8::StaticOrder, true, true>(X.lds + RING_OFF, g, S, E);
        if (grpW != 0) { ph0_prologue(X, args, 1); }
        if (BOTH(1)) GRID_BAR();
    }
    if (IN(2)) { ph2_token(X, args); if (BOTH(2)) GRID_BAR(); }

    if (IN(3)) {
        const int grp3 = (X.vcu >> 1) & 1;
        if (grp3 == 0) { for (int it = X.vcu; it < 1024; it += X.G) smp_ssm_item(X, args, it); }
        { pg8::Gemm g{(const pg8::bf16_t*)(ws + WS_CQ), (const pg8::bf16_t*)(ws + WS_WUQ), MP, QW, 384, 384, 384}; pg8::StaticOrder S; S.init(MP, QW, X.G, cb);
          pg8::Epi<pg8::EM_Q> E{(void*)(ws + WS_Q), QW, nullptr, 0, nullptr, 0, (const float*)(ws + WS_TAB)};
          pg8::gemm_phase<pg8::Epi<pg8::EM_Q>, pg8::StaticOrder, true, true>(X.lds + RING_OFF, g, S, E); }
        { pg8::Gemm g{(const pg8::bf16_t*)(ws + WS_CKV), (const pg8::bf16_t*)(ws + WS_WUKV), MPR, 2048, 256, 256, 256}; pg8::StaticOrder S; S.init(MPR, 2048, X.G, cb);
          pg8::Epi<pg8::EM_BF16> E{(void*)(ws + WS_KNV), 2048, nullptr, 0, nullptr, 0, nullptr};
          pg8::gemm_phase<pg8::Epi<pg8::EM_BF16>, pg8::StaticOrder, true, true>(X.lds + RING_OFF, g, S, E); }
        ssd_passA_all(X, args);
        if (grp3 != 0) { for (int it = X.vcu; it < 1024; it += X.G) smp_ssm_item(X, args, it); }
        if (BOTH(3)) GRID_BAR();
    }
    if (IN(4)) {
        const int grp = (X.vcu >> 1) & 1;
        if (grp == 0) { for (int u = X.vcu; u < 256; u += X.G) decode_unit(X, args, u); }
        for (int j = X.vcu; j < 256; j += X.G) {
            const int bh = j >> 1, b = bh >> 4, h = bh & 15;
            bf16x8 qn[6];
            if (j & 1) { attn_unit(X, b, h, 5, 4, qn, true); attn_unit(X, b, h, 4, 3, qn, false); attn_unit(X, b, h, 3, 2, qn, false); attn_unit(X, b, h, 2, -1, qn, false); }
            else       { attn_unit(X, b, h, 7, 6, qn, true); attn_unit(X, b, h, 6, 1, qn, false); attn_unit(X, b, h, 1, 0, qn, false); attn_unit(X, b, h, 0, -1, qn, false); }
        }
        ssd_passB(X);
        if (grp != 0) { for (int u = X.vcu; u < 256; u += X.G) decode_unit(X, args, u); }
        if (BOTH(4)) GRID_BAR();
    }
    if (IN(5)) {
        const int grp5 = (X.vcu >> 1) & 1;
        pg8::Epi<pg8::EM_G1> E1{(void*)(ws + WS_MG1), 1024, nullptr, 0, (const pg8::bf16_t*)(ws + WS_PB) + PB_GA, NPB, nullptr};
        if (grp5 == 0) {
            { pg8::Gemm g{(const pg8::bf16_t*)(ws + WS_OA), (const pg8::bf16_t*)(ws + WS_WBRA), MPR, 1024, 1024, 1024, 1024}; pg8::StaticOrder S; S.init(MPR, 1024, X.G, cb);
              pg8::gemm_phase<pg8::Epi<pg8::EM_G1>, pg8::StaticOrder, false, true>(X.lds + RING_OFF, g, S, E1); }
        }
        ssd_passC_all(X, args);
        if (grp5 != 0) {
            { pg8::Gemm g{(const pg8::bf16_t*)(ws + WS_OA), (const pg8::bf16_t*)(ws + WS_WBRA), MPR, 1024, 1024, 1024, 1024}; pg8::StaticOrder S; S.init(MPR, 1024, X.G, cb);
              pg8::gemm_phase<pg8::Epi<pg8::EM_G1>, pg8::StaticOrder, false, true>(X.lds + RING_OFF, g, S, E1); }
        }
        for (int u = X.vcu; u < 2 * NSB; u += X.G) decode_combine(X, args, u);
        __syncthreads();
        if (BOTH(5)) GRID_BAR();
    }
    if (IN(6)) {
        const pg8::bf16_t* PBh = (const pg8::bf16_t*)(ws + WS_PB);
        pg8::Epi<pg8::EM_G1> E1{(void*)(ws + WS_MG1), 1024, nullptr, 0, PBh + PB_GA, NPB, nullptr};
        pg8::Epi<pg8::EM_G2> E2{(void*)(ws + WS_MG), 1024, (void*)(ws + WS_MG1), 1024, PBh + PB_GB, NPB, nullptr};
        for (int u = X.vcu; u < 128; u += X.G) {
            pg8::skinny_unit<pg8::EM_G1>(X.lds, (const pg8::bf16_t*)(ws + WS_OA), 1024, (const pg8::bf16_t*)(ws + WS_WBRA), 1024, 1024, 32 * (u >> 2), E1, MPR + 32 * (u & 3));
            pg8::skinny_unit<pg8::EM_G2>(X.lds, (const pg8::bf16_t*)(ws + WS_OS), 2048, (const pg8::bf16_t*)(ws + WS_WBRS), 2048, 2048, 32 * (u >> 2), E2, MPR + 32 * (u & 3));
        }
        { pg8::Gemm g{(const pg8::bf16_t*)(ws + WS_OS), (const pg8::bf16_t*)(ws + WS_WBRS), MPR, 1024, 2048, 2048, 2048}; pg8::StaticOrder S; S.init(MPR, 1024, X.G, cb);
          pg8::gemm_phase<pg8::Epi<pg8::EM_G2>, pg8::StaticOrder, false, true>(X.lds + RING_OFF, g, S, E2); }
        if (BOTH(6)) GRID_BAR();
    }
    if (IN(7)) {
        pg8::Epi<pg8::EM_BF16> E{(void*)(ws + WS_MIX), 1024, nullptr, 0, nullptr, 0, nullptr};
        for (int u = X.vcu; u < 128; u += X.G) pg8::skinny_unit<pg8::EM_BF16>(X.lds, (const pg8::bf16_t*)(ws + WS_MG), 1024, (const pg8::bf16_t*)(ws + WS_WOUT), 1024, 1024, 32 * (u >> 2), E, MPR + 32 * (u & 3));
        { pg8::Gemm g{(const pg8::bf16_t*)(ws + WS_MG), (const pg8::bf16_t*)(ws + WS_WOUT), MPR, 1024, 1024, 1024, 1024}; pg8::StaticOrder S; S.init(MPR, 1024, X.G, cb);
          pg8::gemm_phase<pg8::Epi<pg8::EM_BF16>, pg8::StaticOrder, false, true>(X.lds + RING_OFF, g, S, E); }
        if (BOTH(7)) GRID_BAR();
    }
    if (IN(8)) { ph_norm1(X, args); if (BOTH(8)) GRID_BAR(); }
    if (IN(9)) {
        pg8::Epi<pg8::EM_UP> E{(void*)(ws + WS_U), 4096, nullptr, 0, nullptr, 0, nullptr};
        const int grp9 = (X.vcu >> 1) & 1;
        if (grp9 == 0) { for (int u = X.vcu; u < 512; u += X.G) pg8::skinny_unit<pg8::EM_UP>(X.lds, XN, 1024, (const pg8::bf16_t*)(ws + WS_WUP), 1024, 1024, 32 * (u >> 2), E, MPR + 32 * (u & 3)); }
        { pg8::Gemm g{XN, (const pg8::bf16_t*)(ws + WS_WUP), MPR, 4096, 1024, 1024, 1024}; pg8::StaticOrder S; S.init(MPR, 4096, X.G, cb);
          pg8::gemm_phase<pg8::Epi<pg8::EM_UP>, pg8::StaticOrder, true, true>(X.lds + RING_OFF, g, S, E); }
        if (grp9 != 0) { for (int u = X.vcu; u < 512; u += X.G) pg8::skinny_unit<pg8::EM_UP>(X.lds, XN, 1024, (const pg8::bf16_t*)(ws + WS_WUP), 1024, 1024, 32 * (u >> 2), E, MPR + 32 * (u & 3)); }
        if (BOTH(9)) GRID_BAR();
    }
    if (IN(10)) {
        pg8::Epi<pg8::EM_BF16> E{(void*)(ws + WS_F), 1024, nullptr, 0, nullptr, 0, nullptr};
        for (int u = X.vcu; u < 128; u += X.G) pg8::skinny_unit<pg8::EM_BF16>(X.lds, (const pg8::bf16_t*)(ws + WS_U), 4096, (const pg8::bf16_t*)(ws + WS_WDN), 4096, 4096, 32 * (u >> 2), E, MPR + 32 * (u & 3));
        { pg8::Gemm g{(const pg8::bf16_t*)(ws + WS_U), (const pg8::bf16_t*)(ws + WS_WDN), MPR, 1024, 4096, 4096, 4096}; pg8::StaticOrder S; S.init(MPR, 1024, X.G, cb);
          pg8::gemm_phase<pg8::Epi<pg8::EM_BF16>, pg8::StaticOrder, false, true>(X.lds + RING_OFF, g, S, E); }
        if (BOTH(10)) GRID_BAR();
    }
    if (IN(11)) { ph_norm2(X, args); }
#undef IN
#undef BOTH
#undef GRID_BAR
}

extern "C" void kernel_launch(void* const* d_in, const int* in_sizes, int n_in, void* d_out, int out_size, void* d_ws, size_t ws_size, hipStream_t stream) {
    static int grid = 0;
    if (grid == 0) {
        if (n_in != N_IN || (size_t)out_size != O_END || ws_size < WS_END) { fprintf(stderr, "kernel_launch: unexpected problem: n_in %d out %d ws %zu; nothing launched\n", n_in, out_size, ws_size); grid = -1; return; }
        int dev = 0, cus = 0, per_cu = 0;
        if (hipGetDevice(&dev) != hipSuccess || hipDeviceGetAttribute(&cus, hipDeviceAttributeMultiprocessorCount, dev) != hipSuccess) { fprintf(stderr, "kernel_launch: device query failed\n"); grid = -1; return; }
        if (hipFuncSetAttribute((const void*)fwd_kernel, hipFuncAttributeMaxDynamicSharedMemorySize, LDS_BYTES) != hipSuccess) { fprintf(stderr, "kernel_launch: hipFuncSetAttribute failed\n"); grid = -1; return; }
        if (hipOccupancyMaxActiveBlocksPerMultiprocessor(&per_cu, (const void*)fwd_kernel, NWAVES * 64, LDS_BYTES) != hipSuccess || per_cu < 1) { fprintf(stderr, "kernel_launch: occupancy query reports %d blocks per CU\n", per_cu); }
        (void)hipGetLastError();
        grid = cus;
    }
    if (grid < 0) return;
    if (hipMemsetAsync((char*)d_ws + WS_CTL, 0, CTL_ZERO_BYTES, stream) != hipSuccess) { fprintf(stderr, "kernel_launch: memset failed\n"); return; }
    Args a{};
    for (int i = 0; i < N_IN; ++i) a.in[i] = d_in[i];
    a.out = (float*)d_out; a.ws = (unsigned char*)d_ws;
    for (int li = 0; li < N_LAUNCHES; ++li) {
        a.ph_lo = (N_LAUNCHES == 1) ? 0 : li; a.ph_hi = (N_LAUNCHES == 1) ? N_PHASES : li + 1; a.li = li; a.pad = 0;
        hipLaunchKernelGGL(fwd_kernel, dim3(grid), dim3(NWAVES * 64), LDS_BYTES, stream, a);
        const hipError_t le = hipPeekAtLastError();
        if (le != hipSuccess) { fprintf(stderr, "kernel_launch: launch %d failed: %s\n", li, hipGetErrorName(le)); break; }
    }
}
```

```cpp
#define MK_N_LAUNCHES 1
#include <hip/hip_runtime.h>
#include <hip/hip_bf16.h>
#include <cstdio>
#include <cstdint>
#include <cmath>

namespace pg8 {
#define PG8_LAS __attribute__((address_space(3)))
typedef unsigned short bf16_t;
typedef short bf16x8 __attribute__((ext_vector_type(8)));
typedef float f32x4 __attribute__((ext_vector_type(4)));
typedef unsigned u32x4 __attribute__((ext_vector_type(4)));
typedef unsigned u32x2 __attribute__((ext_vector_type(2)));
constexpr int BM = 256, BK = 64, HALF = 128, HTB = HALF * BK * 2  , STAGE_BYTES = 8 * HTB, NXCD = 8, WGM = 8;

__host__ __device__ __forceinline__ int lds_byte(int r, int c) { const int st = (r >> 4) * 2 + (c >> 5), rr = r & 15, cc = c & 31, ob = rr * 64 + cc * 2; return st * 1024 + (ob ^ (((ob >> 9) & 1) << 5)); }
__host__ __device__ __forceinline__ void stage_rc(int b, int& R, int& C) { const int st = b / 1024, sb = b % 1024, swz = sb ^ (((sb >> 9) & 1) << 5); R = (st >> 1) * 16 + swz / 64; C = (st & 1) * 32 + (swz % 64) / 2; }
__host__ __device__ __forceinline__ int perm32(int rho) { const int n = rho >> 4, i = rho & 15; return 8 * (i >> 2) + 4 * n + (i & 3); }

struct Unit { int pm, pn; };
struct Gemm { const bf16_t* A; const bf16_t* Bt; int M, N, K, lda, ldb; };

struct StaticOrder {
    int nM, nN, nwg, G, c;
    __host__ __device__ void init(int M, int N, int G_, int c_) { nM = M / BM; nN = N / BM; nwg = nM * nN; G = G_; c = c_; }
    __host__ __device__ bool next(int i, Unit& u) const {
        const long L = (long)i * G + c; if (L >= nwg) return false;
        int wgid = (int)L; { const int q = nwg / NXCD, r = nwg % NXCD, xcd = wgid % NXCD, off = wgid / NXCD; wgid = (xcd < r ? xcd * (q + 1) : r * (q + 1) + (xcd - r) * q) + off; }
        const int nig = WGM * nN, gid = wgid / nig, fm = gid * WGM, gsz = (nM - fm) < WGM ? (nM - fm) : WGM;
        u.pm = fm + ((wgid % nig) % gsz); u.pn = (wgid % nig) / gsz; return true;
    }
    __device__ __forceinline__ void a_ready(const Unit&) const {}
    __device__ __forceinline__ void done(const Unit&) const {}
};

__device__ __forceinline__ unsigned cvt_pk_bf16(float lo, float hi) { unsigned r; asm volatile("v_cvt_pk_bf16_f32 %0, %1, %2" : "=v"(r) : "v"(lo), "v"(hi)); return r; }
__device__ __forceinline__ float bflo(unsigned w) { return __uint_as_float(w << 16); }
__device__ __forceinline__ float bfhi(unsigned w) { return __uint_as_float(w & 0xffff0000u); }
__device__ __forceinline__ float sigm(float x) { return __builtin_amdgcn_rcpf(1.0f + __expf(-x)); }

enum { EM_P1 = 0, EM_Q = 1, EM_BF16 = 2, EM_G1 = 3, EM_G2 = 4, EM_F32 = 5, EM_UP = 6 };
constexpr float QSCALE = 0.10540925533894598f * 1.4426950408889634f;
template <int MODE> struct Epi {
    static constexpr bool PERM = true, AFTER_DRAIN = false;
    void* o0; int ld0;
    void* o1; int ld1;
    const bf16_t* gate; int ldg;
    const float* tab;
    __device__ __forceinline__ void operator()(const f32x4 (&acc)[2][2][4][2], const Unit& u, int wr, int wc, int fr, int fq) const {
        const int row0 = u.pm * BM + wr * 64 + fr;
#pragma unroll
        for (int ai = 0; ai < 2; ++ai) {
            u32x4 gq[4][2], mq[4][2]; f32x4 tq[4][2];
            if constexpr (MODE == EM_G1 || MODE == EM_G2) {
#pragma unroll
                for (int m = 0; m < 4; ++m)
#pragma unroll
                    for (int bj = 0; bj < 2; ++bj) { const size_t go = (size_t)(row0 + ai * HALF + m * 16) * ldg + u.pn * BM + bj * HALF + wc * 32 + 8 * fq;
                        gq[m][bj] = *(const u32x4*)(gate + go);
                        if constexpr (MODE == EM_G2) mq[m][bj] = *(const u32x4*)((const bf16_t*)o1 + (size_t)(row0 + ai * HALF + m * 16) * ld1 + u.pn * BM + bj * HALF + wc * 32 + 8 * fq); }
            }
            if constexpr (MODE == EM_Q) {
#pragma unroll
                for (int m = 0; m < 4; ++m) { const int row = row0 + ai * HALF + m * 16; const int pidx = row < 16384 ? (row & 2047) : 2048;
                    const float* tp = tab + ((size_t)pidx * 16 + 4 * fq) * 2; tq[m][0] = *(const f32x4*)tp; tq[m][1] = *(const f32x4*)(tp + 4); }
            }
#pragma unroll
            for (int m = 0; m < 4; ++m) {
                const int row = row0 + ai * HALF + m * 16;
#pragma unroll
                for (int bj = 0; bj < 2; ++bj) {
                    const int col = u.pn * BM + bj * HALF + wc * 32 + 8 * fq;
                    f32x4 v0 = acc[ai][bj][m][0], v1 = acc[ai][bj][m][1];
                    if constexpr (MODE == EM_P1) {
                        if (u.pn < 3) { u32x4 w; w.x = cvt_pk_bf16(v0[0], v0[1]); w.y = cvt_pk_bf16(v0[2], v0[3]); w.z = cvt_pk_bf16(v1[0], v1[1]); w.w = cvt_pk_bf16(v1[2], v1[3]);
                               *(u32x4*)((bf16_t*)o0 + (size_t)row * ld0 + col) = w; }
                        else { u32x4 w; w.x = cvt_pk_bf16(v0[0], v0[1]); w.y = cvt_pk_bf16(v0[2], v0[3]); w.z = cvt_pk_bf16(v1[0], v1[1]); w.w = cvt_pk_bf16(v1[2], v1[3]);
                               *(u32x4*)((bf16_t*)o1 + (size_t)row * ld1 + (col - 768)) = w; }
                    } else if constexpr (MODE == EM_Q) {
                        const int g32 = col >> 5;
                        if ((g32 % 3) == 2) {
                            const f32x4 t0 = tq[m][0], t1 = tq[m][1];
                            f32x4 r0, r1;
                            r0[0] = v0[0] * t0[0] - v0[1] * t0[1]; r0[1] = v0[0] * t0[1] + v0[1] * t0[0];
                            r0[2] = v0[2] * t0[2] - v0[3] * t0[3]; r0[3] = v0[2] * t0[3] + v0[3] * t0[2];
                            r1[0] = v1[0] * t1[0] - v1[1] * t1[1]; r1[1] = v1[0] * t1[1] + v1[1] * t1[0];
                            r1[2] = v1[2] * t1[2] - v1[3] * t1[3]; r1[3] = v1[2] * t1[3] + v1[3] * t1[2];
                            v0 = r0; v1 = r1;
                        }
                        v0 = v0 * QSCALE; v1 = v1 * QSCALE;
                        u32x4 w; w.x = cvt_pk_bf16(v0[0], v0[1]); w.y = cvt_pk_bf16(v0[2], v0[3]); w.z = cvt_pk_bf16(v1[0], v1[1]); w.w = cvt_pk_bf16(v1[2], v1[3]);
                        *(u32x4*)((bf16_t*)o0 + (size_t)row * ld0 + col) = w;
                    } else if constexpr (MODE == EM_BF16) {
                        u32x4 w; w.x = cvt_pk_bf16(v0[0], v0[1]); w.y = cvt_pk_bf16(v0[2], v0[3]); w.z = cvt_pk_bf16(v1[0], v1[1]); w.w = cvt_pk_bf16(v1[2], v1[3]);
                        *(u32x4*)((bf16_t*)o0 + (size_t)row * ld0 + col) = w;
                    } else if constexpr (MODE == EM_G1) {
                        const u32x4 gw = gq[m][bj];
                        v0[0] *= sigm(bflo(gw.x)); v0[1] *= sigm(bfhi(gw.x)); v0[2] *= sigm(bflo(gw.y)); v0[3] *= sigm(bfhi(gw.y));
                        v1[0] *= sigm(bflo(gw.z)); v1[1] *= sigm(bfhi(gw.z)); v1[2] *= sigm(bflo(gw.w)); v1[3] *= sigm(bfhi(gw.w));
                        u32x4 w; w.x = cvt_pk_bf16(v0[0], v0[1]); w.y = cvt_pk_bf16(v0[2], v0[3]); w.z = cvt_pk_bf16(v1[0], v1[1]); w.w = cvt_pk_bf16(v1[2], v1[3]);
                        *(u32x4*)((bf16_t*)o0 + (size_t)row * ld0 + col) = w;
                    } else if constexpr (MODE == EM_G2) {
                        const u32x4 gw = gq[m][bj];
                        const u32x4 mw = mq[m][bj];
                        const f32x4 a0 = (f32x4){bflo(mw.x), bfhi(mw.x), bflo(mw.y), bfhi(mw.y)}, a1 = (f32x4){bflo(mw.z), bfhi(mw.z), bflo(mw.w), bfhi(mw.w)};
                        v0[0] = a0[0] + v0[0] * sigm(bflo(gw.x)); v0[1] = a0[1] + v0[1] * sigm(bfhi(gw.x)); v0[2] = a0[2] + v0[2] * sigm(bflo(gw.y)); v0[3] = a0[3] + v0[3] * sigm(bfhi(gw.y));
                        v1[0] = a1[0] + v1[0] * sigm(bflo(gw.z)); v1[1] = a1[1] + v1[1] * sigm(bfhi(gw.z)); v1[2] = a1[2] + v1[2] * sigm(bflo(gw.w)); v1[3] = a1[3] + v1[3] * sigm(bfhi(gw.w));
                        u32x4 w; w.x = cvt_pk_bf16(v0[0], v0[1]); w.y = cvt_pk_bf16(v0[2], v0[3]); w.z = cvt_pk_bf16(v1[0], v1[1]); w.w = cvt_pk_bf16(v1[2], v1[3]);
                        *(u32x4*)((bf16_t*)o0 + (size_t)row * ld0 + col) = w;
                    } else if constexpr (MODE == EM_F32) {
                        float* p = (float*)o0 + (size_t)row * ld0 + col; *(f32x4*)p = v0; *(f32x4*)(p + 4) = v1;
                    } else {
#pragma unroll
                        for (int j = 0; j < 4; ++j) { float a, b; asm("v_max_f32 %0, 0, %1" : "=v"(a) : "v"(v0[j])); asm("v_max_f32 %0, 0, %1" : "=v"(b) : "v"(v1[j])); v0[j] = a * a; v1[j] = b * b; }
                        u32x4 w; w.x = cvt_pk_bf16(v0[0], v0[1]); w.y = cvt_pk_bf16(v0[2], v0[3]); w.z = cvt_pk_bf16(v1[0], v1[1]); w.w = cvt_pk_bf16(v1[2], v1[3]);
                        *(u32x4*)((bf16_t*)o0 + (size_t)row * ld0 + col) = w;
                    }
                }
            }
        }
    }
};

template <class Epi, class Sched, bool ALIGN_EPI = false, bool SP2 = false>
__device__ __forceinline__ void gemm_phase(PG8_LAS unsigned char* lds, const Gemm g, const Sched& S, const Epi& E) {
    const int tid = threadIdx.x, wid = __builtin_amdgcn_readfirstlane(tid >> 6), lane = tid & 63, wr = wid >> 2, wc = wid & 3, fr = lane & 15, fq = lane >> 4;
    int K = g.K; asm volatile("" : "+s"(K)); const int nt = K / BK;
    unsigned voffA[2], voffB[2];
#pragma unroll
    for (int i = 0; i < 2; ++i) { int R, C; stage_rc(tid * 16 + i * 8192, R, C); const int Rb = Epi::PERM ? ((R & ~31) + perm32(R & 31)) : R;
        voffA[i] = (unsigned)(R * g.lda + C) * 2u; voffB[i] = (unsigned)(Rb * g.ldb + C) * 2u; }
    const size_t kstep = (size_t)(BK * 2);
    const size_t hstepA = (size_t)HALF * g.lda * 2, hstepB = (size_t)HALF * g.ldb * 2;
    const size_t tstepA = 2 * hstepA, tstepB = 2 * hstepB;
    const unsigned ldsw = (unsigned)wid * 1024u;
    const int aoff = lds_byte(wr * 64 + fr, fq * 8), boff = lds_byte(wc * 32 + fr, fq * 8);
#define PG8_SA(b, h) (((b) * 2 + (h)) * HTB)
#define PG8_SB(b, h) ((4 + (b) * 2 + (h)) * HTB)
#define PG8_STAGE(bufoff, gbase, voff) do { _Pragma("unroll") for (int _i = 0; _i < 2; ++_i) \
        __builtin_amdgcn_global_load_lds((const unsigned*)((const char*)(gbase) + (voff)[_i]), (PG8_LAS unsigned*)(lds + (bufoff) + ldsw + _i * 8192), 16, 0, 0); } while (0)
#define PG8_LDA(dst, b, h) do { _Pragma("unroll") for (int m = 0; m < 4; ++m) _Pragma("unroll") for (int k = 0; k < 2; ++k) dst[m][k] = *(const PG8_LAS bf16x8*)(lds + PG8_SA(b, h) + aoff + m * 2048 + k * 1024); } while (0)
#define PG8_LDB(dst, b, h) do { _Pragma("unroll") for (int n = 0; n < 2; ++n) _Pragma("unroll") for (int k = 0; k < 2; ++k) dst[n][k] = *(const PG8_LAS bf16x8*)(lds + PG8_SB(b, h) + boff + n * 2048 + k * 1024); } while (0)
#define PG8_MMA(ai, bj, At, Bt) do { __builtin_amdgcn_s_setprio(1); _Pragma("unroll") for (int m = 0; m < 4; ++m) _Pragma("unroll") for (int n = 0; n < 2; ++n) _Pragma("unroll") for (int k = 0; k < 2; ++k) \
        acc[ai][bj][m][n] = __builtin_amdgcn_mfma_f32_16x16x32_bf16(Bt[n][k], At[m][k], acc[ai][bj][m][n], 0, 0, 0); __builtin_amdgcn_s_setprio(0); } while (0)
#define PG8_WAIT_V(n) asm volatile("s_waitcnt vmcnt(" #n ")" ::: "memory")
#define PG8_WAIT_L(n) asm volatile("s_waitcnt lgkmcnt(" #n ")" ::: "memory")
#define PG8_BAR __builtin_amdgcn_s_barrier()
#define PG8_SCHED __builtin_amdgcn_sched_barrier(0)
    Unit cur, nxt; int ui = 0;
    if (!S.next(0, cur)) return;
    f32x4 acc[2][2][4][2];
#pragma unroll
    for (int a = 0; a < 2; ++a)
#pragma unroll
        for (int b = 0; b < 2; ++b)
#pragma unroll
            for (int m = 0; m < 4; ++m)
#pragma unroll
                for (int n = 0; n < 2; ++n) acc[a][b][m][n] = (f32x4){0.f, 0.f, 0.f, 0.f};
    bf16x8 At[4][2], B0[2][2], B1[2][2];
    const char* cA = (const char*)g.A + (size_t)cur.pm * tstepA; const char* cB = (const char*)g.Bt + (size_t)cur.pn * tstepB;
    S.a_ready(cur);
    if constexpr (SP2) {
        PG8_STAGE(PG8_SB(0, 0), cB, voffB); PG8_STAGE(PG8_SB(0, 1), cB + hstepB, voffB); PG8_STAGE(PG8_SA(0, 0), cA, voffA); PG8_STAGE(PG8_SA(0, 1), cA + hstepA, voffA);
        if (wr == 1) PG8_BAR;
        PG8_WAIT_V(2); PG8_BAR;
        PG8_STAGE(PG8_SB(1, 0), cB + kstep, voffB); PG8_STAGE(PG8_SA(1, 0), cA + kstep, voffA); PG8_STAGE(PG8_SB(1, 1), cB + hstepB + kstep, voffB);
        PG8_WAIT_V(6); PG8_BAR;
    } else {
        PG8_STAGE(PG8_SB(0, 0), cB, voffB); PG8_STAGE(PG8_SA(0, 0), cA, voffA); PG8_STAGE(PG8_SB(0, 1), cB + hstepB, voffB); PG8_STAGE(PG8_SA(0, 1), cA + hstepA, voffA);
        if (wr == 1) PG8_BAR;
        PG8_WAIT_V(4); PG8_BAR;
        PG8_STAGE(PG8_SB(1, 0), cB + kstep, voffB); PG8_STAGE(PG8_SA(1, 0), cA + kstep, voffA); PG8_STAGE(PG8_SB(1, 1), cB + hstepB + kstep, voffB);
        PG8_WAIT_V(6); PG8_BAR;
    }
    for (;;) {
        const bool has_next = S.next(ui + 1, nxt);
        const char* nA = has_next ? (const char*)g.A + (size_t)nxt.pm * tstepA : cA; const char* nB = has_next ? (const char*)g.Bt + (size_t)nxt.pn * tstepB : cB;
        for (int t = 0; t < nt; t += 2) {
            const bool last = (t == nt - 2);
            const char* a1 = cA + (size_t)(t + 1) * kstep;
            const char* a2 = last ? nA : cA + (size_t)(t + 2) * kstep; const char* b2 = last ? nB : cB + (size_t)(t + 2) * kstep;
            const char* a3 = a2 + kstep; const char* b3 = b2 + kstep;
            if (last && has_next) S.a_ready(nxt);
            if constexpr (SP2) {
            PG8_LDB(B0, 0, 0); PG8_LDB(B1, 0, 1); PG8_SCHED; PG8_LDA(At, 0, 0); PG8_STAGE(PG8_SA(1, 1), a1 + hstepA, voffA);
            PG8_WAIT_V(8); PG8_WAIT_L(0); PG8_BAR; PG8_MMA(0, 0, At, B0); PG8_MMA(0, 1, At, B1); PG8_BAR; PG8_SCHED;
            PG8_LDA(At, 0, 1); PG8_STAGE(PG8_SB(0, 0), b2, voffB); PG8_STAGE(PG8_SB(0, 1), b2 + hstepB, voffB); PG8_STAGE(PG8_SA(0, 0), a2, voffA);
            PG8_WAIT_V(8); PG8_WAIT_L(0); PG8_BAR; PG8_MMA(1, 0, At, B0); PG8_MMA(1, 1, At, B1); PG8_BAR; PG8_SCHED;
            PG8_LDB(B0, 1, 0); PG8_LDB(B1, 1, 1); PG8_SCHED; PG8_LDA(At, 1, 0); PG8_STAGE(PG8_SA(0, 1), a2 + hstepA, voffA);
            PG8_WAIT_V(8); PG8_WAIT_L(0); PG8_BAR; PG8_MMA(0, 0, At, B0); PG8_MMA(0, 1, At, B1); PG8_BAR; PG8_SCHED;
            PG8_LDA(At, 1, 1); PG8_STAGE(PG8_SB(1, 0), b3, voffB); PG8_STAGE(PG8_SB(1, 1), b3 + hstepB, voffB); PG8_STAGE(PG8_SA(1, 0), a3, voffA);
            PG8_WAIT_V(8); PG8_WAIT_L(0); PG8_BAR; PG8_MMA(1, 0, At, B0); PG8_MMA(1, 1, At, B1); PG8_BAR; PG8_SCHED;
            } else {
            PG8_LDB(B0, 0, 0); PG8_SCHED; PG8_LDA(At, 0, 0); PG8_STAGE(PG8_SA(1, 1), a1 + hstepA, voffA);
            PG8_WAIT_L(8); PG8_BAR; PG8_WAIT_L(0); PG8_MMA(0, 0, At, B0); PG8_BAR; PG8_SCHED;
            PG8_LDB(B1, 0, 1); PG8_STAGE(PG8_SB(0, 0), b2, voffB);
            PG8_BAR; PG8_WAIT_L(0); PG8_MMA(0, 1, At, B1); PG8_BAR;
            PG8_LDA(At, 0, 1); PG8_STAGE(PG8_SA(0, 0), a2, voffA);
            PG8_BAR; PG8_WAIT_L(0); PG8_MMA(1, 0, At, B0); PG8_BAR; PG8_SCHED;
            PG8_STAGE(PG8_SB(0, 1), b2 + hstepB, voffB);
            PG8_WAIT_V(6); PG8_BAR; PG8_MMA(1, 1, At, B1); PG8_BAR;
            PG8_LDB(B0, 1, 0); PG8_SCHED; PG8_LDA(At, 1, 0); PG8_STAGE(PG8_SA(0, 1), a2 + hstepA, voffA);
            PG8_WAIT_L(8); PG8_BAR; PG8_WAIT_L(0); PG8_MMA(0, 0, At, B0); PG8_BAR; PG8_SCHED;
            PG8_LDB(B1, 1, 1); PG8_STAGE(PG8_SB(1, 0), b3, voffB);
            PG8_BAR; PG8_WAIT_L(0); PG8_MMA(0, 1, At, B1); PG8_BAR;
            PG8_LDA(At, 1, 1); PG8_STAGE(PG8_SA(1, 0), a3, voffA);
            PG8_BAR; PG8_WAIT_L(0); PG8_MMA(1, 0, At, B0); PG8_BAR; PG8_SCHED;
            PG8_STAGE(PG8_SB(1, 1), b3 + hstepB, voffB);
            PG8_WAIT_V(6); PG8_BAR; PG8_MMA(1, 1, At, B1); PG8_BAR;
            }
        }
        if constexpr (ALIGN_EPI) { if (wr == 0) PG8_BAR; }
        if constexpr (!Epi::AFTER_DRAIN) { E(acc, cur, wr, wc, fr, fq); S.done(cur); }
        if (!has_next) break;
#pragma unroll
        for (int a = 0; a < 2; ++a)
#pragma unroll
            for (int b = 0; b < 2; ++b)
#pragma unroll
                for (int m = 0; m < 4; ++m)
#pragma unroll
                    for (int n = 0; n < 2; ++n) acc[a][b][m][n] = (f32x4){0.f, 0.f, 0.f, 0.f};
        cur = nxt; cA = nA; cB = nB; ++ui;
        if constexpr (ALIGN_EPI) { if (wr == 1) PG8_BAR; }
    }
    PG8_WAIT_V(0);
    if constexpr (!ALIGN_EPI) { if (wr == 0) PG8_BAR; }
    PG8_BAR;
    if constexpr (Epi::AFTER_DRAIN) { E.fused(acc, cur, wr, wc, fr, fq, lds, wid, lane); S.done(cur); }
#undef PG8_SA
#undef PG8_SB
#undef PG8_STAGE
#undef PG8_LDA
#undef PG8_LDB
#undef PG8_MMA
#undef PG8_WAIT_V
#undef PG8_WAIT_L
#undef PG8_BAR
#undef PG8_SCHED
}

template <int MODE> __device__ __forceinline__ void epi4(const Epi<MODE>& E, int row, int col, f32x4 v) {
    if constexpr (MODE == EM_G1) {
        const u32x2 gw = *(const u32x2*)(E.gate + (size_t)row * E.ldg + col);
        v[0] *= sigm(bflo(gw.x)); v[1] *= sigm(bfhi(gw.x)); v[2] *= sigm(bflo(gw.y)); v[3] *= sigm(bfhi(gw.y));
        { u32x2 w; w.x = cvt_pk_bf16(v[0], v[1]); w.y = cvt_pk_bf16(v[2], v[3]); *(u32x2*)((bf16_t*)E.o0 + (size_t)row * E.ld0 + col) = w; }
    } else if constexpr (MODE == EM_G2) {
        const u32x2 gw = *(const u32x2*)(E.gate + (size_t)row * E.ldg + col);
        const u32x2 mw = *(const u32x2*)((const bf16_t*)E.o1 + (size_t)row * E.ld1 + col);
        const f32x4 a = (f32x4){bflo(mw.x), bfhi(mw.x), bflo(mw.y), bfhi(mw.y)};
        v[0] = a[0] + v[0] * sigm(bflo(gw.x)); v[1] = a[1] + v[1] * sigm(bfhi(gw.x)); v[2] = a[2] + v[2] * sigm(bflo(gw.y)); v[3] = a[3] + v[3] * sigm(bfhi(gw.y));
        u32x2 w; w.x = cvt_pk_bf16(v[0], v[1]); w.y = cvt_pk_bf16(v[2], v[3]);
        *(u32x2*)((bf16_t*)E.o0 + (size_t)row * E.ld0 + col) = w;
    } else if constexpr (MODE == EM_F32) {
        *(f32x4*)((float*)E.o0 + (size_t)row * E.ld0 + col) = v;
    } else if constexpr (MODE == EM_BF16) {
        u32x2 w; w.x = cvt_pk_bf16(v[0], v[1]); w.y = cvt_pk_bf16(v[2], v[3]);
        *(u32x2*)((bf16_t*)E.o0 + (size_t)row * E.ld0 + col) = w;
    } else {
#pragma unroll
        for (int j = 0; j < 4; ++j) { const float a = fmaxf(v[j], 0.f); v[j] = a * a; }
        u32x2 w; w.x = cvt_pk_bf16(v[0], v[1]); w.y = cvt_pk_bf16(v[2], v[3]);
        *(u32x2*)((bf16_t*)E.o0 + (size_t)row * E.ld0 + col) = w;
    }
}
template <int MODE> __device__ __forceinline__ void skinny_unit(PG8_LAS unsigned char* lds, const bf16_t* A, int lda, const bf16_t* Bt, int ldb, int K, int n0, const Epi<MODE>& E, int rbase) {
    const int tid = threadIdx.x, wid = __builtin_amdgcn_readfirstlane(tid >> 6), lane = tid & 63, fr = lane & 15, fq = lane >> 4;
    const int klen = K >> 3, k0 = wid * klen;
    f32x4 acc[2][2];
#pragma unroll
    for (int mt = 0; mt < 2; ++mt) { acc[mt][0] = (f32x4){0.f, 0.f, 0.f, 0.f}; acc[mt][1] = (f32x4){0.f, 0.f, 0.f, 0.f}; }
    const bf16_t* ap = A + (size_t)(rbase + fr) * lda + k0 + 8 * fq;
    const bf16_t* bp = Bt + (size_t)(n0 + fr) * ldb + k0 + 8 * fq;
    bf16x8 bq[2][4][2], aq[2][4][2];
#define SK_LOAD(buf_, kk_) do { _Pragma("unroll") for (int u = 0; u < 4; ++u) { bq[buf_][u][0] = *(const bf16x8*)(bp + (kk_) + 32 * u); bq[buf_][u][1] = *(const bf16x8*)(bp + (size_t)16 * ldb + (kk_) + 32 * u); \
            aq[buf_][u][0] = *(const bf16x8*)(ap + (kk_) + 32 * u); aq[buf_][u][1] = *(const bf16x8*)(ap + (size_t)16 * lda + (kk_) + 32 * u); } } while (0)
    SK_LOAD(0, 0);
#pragma unroll
    for (int kk = 0; kk < klen; kk += 128) {
        const int cb = (kk >> 7) & 1;
        if (kk + 128 < klen) SK_LOAD(cb ^ 1, kk + 128);
#pragma unroll
        for (int u = 0; u < 4; ++u) asm volatile("" : "+v"(bq[cb][u][0]), "+v"(bq[cb][u][1]), "+v"(aq[cb][u][0]), "+v"(aq[cb][u][1]) :: "memory");
#pragma unroll
        for (int u = 0; u < 4; ++u)
#pragma unroll
            for (int mt = 0; mt < 2; ++mt) {
                acc[mt][0] = __builtin_amdgcn_mfma_f32_16x16x32_bf16(bq[cb][u][0], aq[cb][u][mt], acc[mt][0], 0, 0, 0);
                acc[mt][1] = __builtin_amdgcn_mfma_f32_16x16x32_bf16(bq[cb][u][1], aq[cb][u][mt], acc[mt][1], 0, 0, 0);
            }
    }
#undef SK_LOAD
    PG8_LAS float* P = (PG8_LAS float*)lds + wid * 1024;
#pragma unroll
    for (int mt = 0; mt < 2; ++mt) { *(PG8_LAS f32x4*)(P + (16 * mt + fr) * 32 + 4 * fq) = acc[mt][0]; *(PG8_LAS f32x4*)(P + (16 * mt + fr) * 32 + 16 + 4 * fq) = acc[mt][1]; }
    __syncthreads();
    if (tid < 256) {
        const int e = tid * 4, m = e >> 5, c4 = e & 31;
        f32x4 s = *(PG8_LAS f32x4*)((PG8_LAS float*)lds + e);
#pragma unroll
        for (int w = 1; w < 8; ++w) s += *(PG8_LAS f32x4*)((PG8_LAS float*)lds + w * 1024 + e);
        epi4<MODE>(E, rbase + m, n0 + c4, s);
    }
    __syncthreads();
}
}

constexpr int NWAVES = 8;
constexpr int DM = 1024, SEQ = 2048, NBAT = 8, MPR = NBAT * SEQ  , NSB = 128  , MR = MPR + NSB  , MP = 16640  ;
constexpr int NIN = 8960;
constexpr int NPF = 768, NPB = 8192;
constexpr int PB_Z = 0, PB_XBC = 2048, PB_GA = 6144, PB_GB = 7168;
constexpr int QW = 1536;
constexpr int PAST = 8192, PAGE = 128, NPAGES = 64;
constexpr float EPS = 1e-6f;
enum { I_XP = 0, I_XS, I_CKV, I_CPE, I_SSM, I_CONV, I_PT, I_WIN, I_GPRE, I_GQ, I_WUQ, I_GKV, I_WUK, I_WUV, I_WCONV, I_BCONV, I_DTB, I_ALOG, I_DSKIP, I_GSSM,
       I_WBRA, I_WBRS, I_WOUT, I_GPOSTMIX, I_GPREMLP, I_WUP, I_WDN, I_GPOSTMLP, N_IN };
constexpr size_t O_YP = 0, O_YS = 16777216, O_KVP = 16908288, O_KRP = 21102592, O_SSP = 21626880, O_CVP = 23724032, O_KVS = 23822336, O_KRS = 23855104, O_SSS = 23859200, O_CVS = 57413632, O_END = 58986496;

constexpr size_t MiB = 1u << 20;
constexpr size_t WS_CTL = 0, CTL_ZERO_BYTES = 64 * 1024;
constexpr size_t WS_WIN = 2 * MiB, WS_WUQ = 20 * MiB, WS_WUKV = 22 * MiB, WS_WBRA = 24 * MiB, WS_WBRS = 26 * MiB, WS_WOUT = 30 * MiB, WS_WUP = 32 * MiB, WS_WDN = 40 * MiB;
constexpr size_t WS_TAB = 48 * MiB, WS_CD = 49 * MiB, WS_PART = 50 * MiB, WS_QL = 56 * MiB, WS_CS = 60 * MiB  ;
constexpr size_t WS_XN = 64 * MiB, WS_PF = 98 * MiB, WS_PB = 148 * MiB, WS_CQ = 408 * MiB, WS_CKV = 422 * MiB, WS_KPE = 432 * MiB, WS_DT = 434 * MiB, WS_XBC = 438 * MiB;
constexpr size_t WS_Q = 568 * MiB, WS_KNV = 618 * MiB, WS_OA = 682 * MiB, WS_OS = 716 * MiB, WS_LOC = 782 * MiB, WS_PREV = 910 * MiB, WS_MG1 = 974 * MiB, WS_MG = 1040 * MiB;
constexpr size_t WS_MIX = 1074 * MiB, WS_X1 = 1140 * MiB, WS_U = 1206 * MiB, WS_F = 1336 * MiB, WS_END = 1402 * MiB;
static_assert(WS_WIN + (size_t)NIN * 1024 * 2 <= WS_WUQ && WS_XN + (size_t)MP * 1024 * 2 <= WS_PF && WS_PF + (size_t)MP * NPF * 4 <= WS_PB && WS_PB + (size_t)MP * NPB * 2 <= WS_CQ, "ws map 1");
static_assert(WS_CQ + (size_t)MP * 384 * 2 <= WS_CKV && WS_CKV + (size_t)MP * 256 * 2 <= WS_KPE && WS_KPE + (size_t)MP * 32 * 2 <= WS_DT && WS_DT + (size_t)MP * 32 * 4 <= WS_XBC && WS_XBC + (size_t)MP * 4096 * 2 <= WS_Q, "ws map 2");
static_assert(WS_Q + (size_t)MP * QW * 2 <= WS_KNV && WS_KNV + (size_t)MPR * 2048 * 2 <= WS_OA && WS_OA + (size_t)MP * 1024 * 2 <= WS_OS && WS_OS + (size_t)MP * 2048 * 2 <= WS_LOC, "ws map 3");
static_assert(WS_LOC + (size_t)MPR / 128 * 32 * 8192 * 4 <= WS_PREV && WS_PREV + (size_t)MPR / 128 * 32 * 8192 * 2 <= WS_MG1 && WS_MG1 + (size_t)MP * 1024 * 4 <= WS_MG && WS_MG + (size_t)MP * 1024 * 2 <= WS_MIX, "ws map 4");
static_assert(WS_MIX + (size_t)MP * 1024 * 4 <= WS_X1 && WS_X1 + (size_t)MP * 1024 * 4 <= WS_U && WS_U + (size_t)MP * 4096 * 2 <= WS_F && WS_F + (size_t)MP * 1024 * 4 <= WS_END, "ws map 5");
constexpr int CW_TMO = 0, CW_CODE = 1, CW_BAR = 4096;
constexpr int RING_OFF = 0, RING_BYTES = 131072, EXTRA_OFF = 131072  , LDSCTL_OFF = 139264, MISC_OFF = LDSCTL_OFF + 320;
constexpr int LDS_BYTES = 147456;
static_assert(MISC_OFF + 128 <= LDS_BYTES, "LDS map");

#define GAS __attribute__((address_space(1)))
#define LAS __attribute__((address_space(3)))
typedef unsigned short bf16;
typedef unsigned v4u __attribute__((ext_vector_type(4)));
typedef unsigned v2u __attribute__((ext_vector_type(2)));
typedef float f32x4 __attribute__((ext_vector_type(4)));
typedef float f32x2 __attribute__((ext_vector_type(2)));
typedef float f32x16 __attribute__((ext_vector_type(16)));
typedef short bf16x8 __attribute__((ext_vector_type(8)));
typedef short bf16x4 __attribute__((ext_vector_type(4)));
typedef short v4i16_t __attribute__((ext_vector_type(4)));
typedef GAS unsigned gu32;
#define RLX_AGENT __ATOMIC_RELAXED, __HIP_MEMORY_SCOPE_AGENT
#define LDS_WAIT() asm volatile("s_waitcnt lgkmcnt(0)" ::: "memory")
#define VM_WAIT() asm volatile("s_waitcnt vmcnt(0)" ::: "memory")
__device__ __forceinline__ unsigned pk2(float lo, float hi) { return pg8::cvt_pk_bf16(lo, hi); }
__device__ __forceinline__ float bflo(unsigned w) { return __uint_as_float(w << 16); }
__device__ __forceinline__ float bfhi(unsigned w) { return __uint_as_float(w & 0xffff0000u); }
__device__ __forceinline__ float bf1(bf16 b) { return __uint_as_float((unsigned)b << 16); }
__device__ __forceinline__ float wave_sum(float v) {
#pragma unroll
    for (int o = 1; o < 64; o <<= 1) v += __shfl_xor(v, o);
    return v;
}
__device__ __forceinline__ int crow(int r, int hi) { return (r & 3) + 8 * (r >> 2) + 4 * hi; }
__device__ __forceinline__ void unpack8(const v4u w, float (&f)[8]) { f[0] = bflo(w.x); f[1] = bfhi(w.x); f[2] = bflo(w.y); f[3] = bfhi(w.y); f[4] = bflo(w.z); f[5] = bfhi(w.z); f[6] = bflo(w.w); f[7] = bfhi(w.w); }
__device__ __forceinline__ v4u pack8(const float (&f)[8]) { v4u w; w.x = pk2(f[0], f[1]); w.y = pk2(f[2], f[3]); w.z = pk2(f[4], f[5]); w.w = pk2(f[6], f[7]); return w; }
__device__ __forceinline__ void glds16(const void* gsrc, unsigned lds_dst) { unsigned keep;
    asm volatile("s_mov_b32 %0, m0\n\ts_mov_b32 m0, %2\n\ts_nop 0\n\tglobal_load_lds_dwordx4 %1, off\n\ts_mov_b32 m0, %0" : "=&s"(keep) : "v"(gsrc), "s"(lds_dst) : "memory"); }
__device__ __forceinline__ bf16x4 vtr(const LAS unsigned char* p) { return __builtin_bit_cast(bf16x4, __builtin_amdgcn_ds_read_tr16_b64_v4i16((LAS v4i16_t*)p)); }
#define JOIN8(lo, hi) (bf16x8){lo[0], lo[1], lo[2], lo[3], hi[0], hi[1], hi[2], hi[3]}
__constant__ float INV_FREQ[16] = {1.000000000e+00f, 5.623413324e-01f, 3.162277639e-01f, 1.778279394e-01f, 1.000000015e-01f, 5.623413250e-02f, 3.162277490e-02f, 1.778279431e-02f,
                                   9.999999776e-03f, 5.623413250e-03f, 3.162277630e-03f, 1.778279431e-03f, 1.000000047e-03f, 5.623413017e-04f, 3.162277571e-04f, 1.778279402e-04f};

#define XB_TMO      128
#define XB_XCNT(j)  (256  + 64 * (j))
#define XB_XSUB(j)  (1280 + 64 * (j))
#define XB_XGEN(j)  (2304 + 64 * (j))
#define XB_TOP      3328
#define XB_TOPGEN   3392
#define XCD_BAR_WORDS 3456
#define XB_SPIN_CAP (1u << 18)

__device__ __forceinline__ unsigned xb_ld(unsigned* p)              { return __hip_atomic_load(p, __ATOMIC_RELAXED, __HIP_MEMORY_SCOPE_AGENT); }
__device__ __forceinline__ unsigned xb_add(unsigned* p, unsigned v) { return __hip_atomic_fetch_add(p, v, __ATOMIC_RELAXED, __HIP_MEMORY_SCOPE_AGENT); }
__device__ __forceinline__ unsigned xb_xcc_id() { return (unsigned)__builtin_amdgcn_s_getreg((3 << 11) | 20) & 0xFu; }
#define XB_SPIN(cond, bar) do { unsigned _sp = 0; while (cond) { __builtin_amdgcn_s_sleep(1); \
    if ((++_sp & 255u) == 0u) { if (xb_ld(&(bar)[XB_TMO])) break; if (_sp > XB_SPIN_CAP) { atomicAdd(&(bar)[XB_TMO], 1u); break; } } } } while (0)

struct XcdBarrier {
    unsigned* bar; unsigned x;
    volatile LAS unsigned* st;
};

__device__ __forceinline__ XcdBarrier xcd_barrier_post(unsigned* bar, volatile LAS unsigned* st) {
    XcdBarrier b; b.bar = bar; b.x = xb_xcc_id(); b.st = st;
    if (threadIdx.x == 0) (void)xb_add(&bar[XB_XCNT(b.x)], 1u);
    return b;
}
__device__ __forceinline__ void xcd_barrier_complete(unsigned* bar, unsigned x, unsigned& nloc, unsigned& nx) {
    const unsigned G = gridDim.x * gridDim.y * gridDim.z;
    unsigned sum, cnt, mine, sp = 0u;
    for (;;) {
        sum = 0u; cnt = 0u; mine = 0u;
#pragma unroll
        for (unsigned j = 0; j < 16; ++j) { const unsigned c = xb_ld(&bar[XB_XCNT(j)]); sum += c; cnt += (c > 0u) ? 1u : 0u; mine = (j == x) ? c : mine; }
        if (sum == G) break;
        __builtin_amdgcn_s_sleep(1);
        if ((++sp & 255u) == 0u) { if (xb_ld(&bar[XB_TMO])) break; if (sp > XB_SPIN_CAP) { atomicAdd(&bar[XB_TMO], 1u); break; } }
    }
    nloc = mine > 0u ? mine : 1u; nx = cnt > 0u ? cnt : 1u;
}

__device__ __forceinline__ void xcd_barrier(const XcdBarrier& b) {
    asm volatile("s_waitcnt vmcnt(0)" ::: "memory");
    __syncthreads();
    if (threadIdx.x == 0) {
        unsigned* bar = b.bar;
        __builtin_amdgcn_s_waitcnt(0);
        unsigned nloc = b.st[0], nx = b.st[1];
        if (nloc == 0u) { xcd_barrier_complete(bar, b.x, nloc, nx); b.st[0] = nloc; b.st[1] = nx; }
        const unsigned old = xb_add(&bar[XB_XSUB(b.x)], 1u);
        const unsigned gen = old / nloc;
        if (old + 1u == (gen + 1u) * nloc) {
            __builtin_amdgcn_fence(__ATOMIC_RELEASE, "agent");
            asm volatile("s_waitcnt vmcnt(0)" ::: "memory");
            const unsigned og = xb_add(&bar[XB_TOP], 1u);
            const unsigned tg = og / nx;
            if (og + 1u == (tg + 1u) * nx) xb_add(&bar[XB_TOPGEN], 1u);
            else XB_SPIN(xb_ld(&bar[XB_TOPGEN]) == tg, bar);
            __builtin_amdgcn_fence(__ATOMIC_ACQUIRE, "agent");
            xb_add(&bar[XB_XGEN(b.x)], 1u);
            asm volatile("s_waitcnt vmcnt(0)" ::: "memory");
        } else {
            XB_SPIN(xb_ld(&bar[XB_XGEN(b.x)]) == gen, bar);
            __builtin_amdgcn_fence(__ATOMIC_ACQUIRE, "agent");
            asm volatile("s_waitcnt vmcnt(0)" ::: "memory");
        }
    }
    __syncthreads();
}

struct Args { const void* in[N_IN]; float* out; unsigned char* ws; int ph_lo, ph_hi, li, pad; };
struct Ctx {
    LAS unsigned char* lds; int tid, lane, wave, vcu, G, gw, NGW;
    unsigned char* ws; float* out;
};

template <class FN> __device__ __forceinline__ void tr_item(const float* W, int srcN, bf16* WT, int K, int k0, int n0, LAS float* scr, int lane, FN srccol) {
    const int sc = srccol(n0 + (lane & 31));
    float tv[32];
#pragma unroll
    for (int i = 0; i < 32; ++i) { const int kk = 2 * i + (lane >> 5); tv[i] = sc >= 0 ? W[(size_t)(k0 + kk) * srcN + sc] : 0.f; }
#pragma unroll
    for (int i = 0; i < 32; ++i) { const int kk = 2 * i + (lane >> 5); scr[kk * 33 + (lane & 31)] = tv[i]; }
    LDS_WAIT(); asm volatile("" ::: "memory");
    const int c = lane & 7;
#pragma unroll
    for (int j = 0; j < 4; ++j) { const int n = (lane >> 3) + 8 * j; const LAS float* s = scr + (8 * c) * 33 + n;
        v4u o; o.x = pk2(s[0 * 33], s[1 * 33]); o.y = pk2(s[2 * 33], s[3 * 33]); o.z = pk2(s[4 * 33], s[5 * 33]); o.w = pk2(s[6 * 33], s[7 * 33]);
        *(GAS v4u*)(WT + (size_t)(n0 + n) * K + k0 + 8 * c) = o; }
    LDS_WAIT(); asm volatile("" ::: "memory");
}
__device__ __forceinline__ int win_src(int n) { return n < 384 ? n : n < 416 ? n + 256 : n < 448 ? n + 6400 : n < 512 ? -1 : n < 768 ? n - 128 : n < 6912 ? n - 96 : n - 64; }
__device__ __forceinline__ int wuq_src(int n) { const int h = n / 96, j = n - h * 96; if (j < 64) return n; const int jj = j - 64; return h * 96 + 64 + (jj >> 1) + 16 * (jj & 1); }
__device__ __forceinline__ int id_src(int n) { return n; }

__device__ __forceinline__ void ph0_prologue(const Ctx& X, const Args& a, const int part) {
    unsigned char* ws = X.ws;
    LAS float* scr = (LAS float*)(X.lds + RING_OFF + X.wave * 16384);
    constexpr int I0 = 16 * 280, I1 = 6 * 48, I2 = 4 * 32, I3 = 4 * 32, I4 = 16 * 32, I5 = 32 * 32, I6 = 16 * 32, I7 = 16 * 128, I8 = 64 * 32;
    constexpr int NITEMS = I0 + I1 + I2 + I3 + I4 + I5 + I6 + I7 + I8;
    constexpr int NEARLY = I0 + I1 + I2 + I3;
    for (int it = (part == 0 ? 0 : NEARLY) + X.gw; it < (part == 0 ? NEARLY : NITEMS); it += X.NGW) {
        int r = it;
        if (r < I0) { tr_item((const float*)a.in[I_WIN], 8896, (bf16*)(ws + WS_WIN), 1024, 64 * (r / 280), 32 * (r % 280), scr, X.lane, win_src); continue; } r -= I0;
        if (r < I1) { tr_item((const float*)a.in[I_WUQ], 1536, (bf16*)(ws + WS_WUQ), 384, 64 * (r / 48), 32 * (r % 48), scr, X.lane, wuq_src); continue; } r -= I1;
        if (r < I2) { tr_item((const float*)a.in[I_WUK], 1024, (bf16*)(ws + WS_WUKV), 256, 64 * (r / 32), 32 * (r % 32), scr, X.lane, id_src); continue; } r -= I2;
        if (r < I3) { tr_item((const float*)a.in[I_WUV], 1024, (bf16*)(ws + WS_WUKV) + (size_t)1024 * 256, 256, 64 * (r / 32), 32 * (r % 32), scr, X.lane, id_src); continue; } r -= I3;
        if (r < I4) { tr_item((const float*)a.in[I_WBRA], 1024, (bf16*)(ws + WS_WBRA), 1024, 64 * (r / 32), 32 * (r % 32), scr, X.lane, id_src); continue; } r -= I4;
        if (r < I5) { tr_item((const float*)a.in[I_WBRS], 1024, (bf16*)(ws + WS_WBRS), 2048, 64 * (r / 32), 32 * (r % 32), scr, X.lane, id_src); continue; } r -= I5;
        if (r < I6) { tr_item((const float*)a.in[I_WOUT], 1024, (bf16*)(ws + WS_WOUT), 1024, 64 * (r / 32), 32 * (r % 32), scr, X.lane, id_src); continue; } r -= I6;
        if (r < I7) { tr_item((const float*)a.in[I_WUP], 4096, (bf16*)(ws + WS_WUP), 1024, 64 * (r / 128), 32 * (r % 128), scr, X.lane, id_src); continue; } r -= I7;
        tr_item((const float*)a.in[I_WDN], 1024, (bf16*)(ws + WS_WDN), 4096, 64 * (r / 32), 32 * (r % 32), scr, X.lane, id_src);
    }
    if (part != 0) return;
    {
        const GAS f32x4* gp = (const GAS f32x4*)a.in[I_GPRE] + X.lane; f32x4 g[4];
#pragma unroll
        for (int j = 0; j < 4; ++j) g[j] = gp[64 * j];
        bf16* XN = (bf16*)(ws + WS_XN);
        for (int m0 = X.gw; m0 < MP; m0 += 2 * X.NGW) {
            int mm[2]; mm[0] = m0; mm[1] = m0 + X.NGW < MP ? m0 + X.NGW : m0;
            f32x4 v[2][4];
#pragma unroll
            for (int q = 0; q < 2; ++q) { const int m = mm[q];
                if (m < MR) { const float* xrow = m < MPR ? (const float*)a.in[I_XP] + (size_t)m * DM : (const float*)a.in[I_XS] + (size_t)(m - MPR) * DM;
                    const GAS f32x4* xr = (const GAS f32x4*)xrow + X.lane;
#pragma unroll
                    for (int j = 0; j < 4; ++j) v[q][j] = xr[64 * j]; }
                else {
#pragma unroll
                    for (int j = 0; j < 4; ++j) v[q][j] = (f32x4){0.f, 0.f, 0.f, 0.f}; } }
#pragma unroll
            for (int q = 0; q < 2; ++q) { const int m = mm[q]; float s = 0.f;
#pragma unroll
                for (int j = 0; j < 4; ++j) s += (v[q][j].x * v[q][j].x + v[q][j].y * v[q][j].y) + (v[q][j].z * v[q][j].z + v[q][j].w * v[q][j].w);
                const float rs = rsqrtf(wave_sum(s) * (1.f / DM) + EPS);
                GAS unsigned long long* o8 = (GAS unsigned long long*)(XN + (size_t)m * DM) + X.lane;
#pragma unroll
                for (int j = 0; j < 4; ++j) { const f32x4 t = v[q][j] * rs * g[j]; o8[64 * j] = (unsigned long long)pk2(t.x, t.y) | ((unsigned long long)pk2(t.z, t.w) << 32); } }
        }
    }
    {
        float* tab = (float*)(ws + WS_TAB);
        for (int e = X.gw * 64 + X.lane; e < 2049 * 16; e += X.NGW * 64) {
            const int pidx = e >> 4, i = e & 15; const float pos = (float)(pidx < 2048 ? pidx : PAST);
            float s, c; sincosf(pos * INV_FREQ[i], &s, &c);
            tab[2 * e] = c; tab[2 * e + 1] = s;
        }
    }
}

__device__ __forceinline__ float softplus(float x) { return x > 20.f ? x : log1pf(__expf(x)); }
__device__ __forceinline__ float silu(float x) { return x * pg8::sigm(x); }
__device__ __forceinline__ f32x2 silu2(f32x2 x) {
    const f32x2 t = x * (f32x2){-1.4426950408889634f, -1.4426950408889634f};
    const f32x2 d = (f32x2){__builtin_amdgcn_exp2f(t.x), __builtin_amdgcn_exp2f(t.y)} + (f32x2){1.f, 1.f};
    return x * (f32x2){__builtin_amdgcn_rcpf(d.x), __builtin_amdgcn_rcpf(d.y)};
}
__device__ __forceinline__ void ph2_token(const Ctx& X, const Args& a) {
    unsigned char* ws = X.ws; const int lane = X.lane;
    const bf16* PF = (const bf16*)(ws + WS_PF); const bf16* PB = (const bf16*)(ws + WS_PB);
    bf16* CQ = (bf16*)(ws + WS_CQ); bf16* CKV = (bf16*)(ws + WS_CKV); bf16* KPE = (bf16*)(ws + WS_KPE); float* DT = (float*)(ws + WS_DT); bf16* XBC = (bf16*)(ws + WS_XBC);
    const float* tab = (const float*)(ws + WS_TAB);
    {
        const float* gq = (const float*)a.in[I_GQ]; const float* gkv = (const float*)a.in[I_GKV]; const float* dtb = (const float*)a.in[I_DTB];
        f32x2 gqv[3];
#pragma unroll
        for (int j = 0; j < 3; ++j) gqv[j] = *(const f32x2*)(gq + 2 * lane + 128 * j);
        const f32x4 gk = *(const f32x4*)(gkv + 4 * lane);
        const float dbias = dtb[lane & 31];
        for (int row0 = X.gw; row0 < MR; row0 += 4 * X.NGW) {
            unsigned qw[4][3]; v2u kw[4]; bf16 vv[4]; f32x2 cs[4];
#pragma unroll
            for (int r = 0; r < 4; ++r) { const int row = row0 + r * X.NGW < MR ? row0 + r * X.NGW : row0; const bf16* pf = PF + (size_t)row * NPF;
#pragma unroll
                for (int j = 0; j < 3; ++j) qw[r][j] = *(const unsigned*)(pf + 2 * lane + 128 * j);
                kw[r] = *(const v2u*)(pf + 512 + 4 * lane); vv[r] = pf[384 + lane];
                cs[r] = *(const f32x2*)(tab + ((size_t)(row < MPR ? (row & (SEQ - 1)) : 2048) * 16 + (lane & 15)) * 2); }
#pragma unroll
            for (int r = 0; r < 4; ++r) {
                const int row = row0 + r * X.NGW;
                if (row < MR) {
                    f32x2 q[3]; float s = 0.f;
#pragma unroll
                    for (int j = 0; j < 3; ++j) { q[j] = (f32x2){bflo(qw[r][j]), bfhi(qw[r][j])}; s += q[j].x * q[j].x + q[j].y * q[j].y; }
                    const f32x4 k = (f32x4){bflo(kw[r].x), bfhi(kw[r].x), bflo(kw[r].y), bfhi(kw[r].y)};
                    const float v = bf1(vv[r]);
                    float s2 = (k.x * k.x + k.y * k.y) + (k.z * k.z + k.w * k.w);
#pragma unroll
                    for (int o = 1; o < 64; o <<= 1) { s += __shfl_xor(s, o); s2 += __shfl_xor(s2, o); }
                    const float rs = rsqrtf(s * (1.f / 384.f) + EPS), rs2 = rsqrtf(s2 * (1.f / 256.f) + EPS);
#pragma unroll
                    for (int j = 0; j < 3; ++j) *(unsigned*)(CQ + (size_t)row * 384 + 2 * lane + 128 * j) = pk2(q[j].x * rs * gqv[j].x, q[j].y * rs * gqv[j].y);
                    const f32x4 c = k * rs2 * gk;
                    float* okv = row < MPR ? X.out + O_KVP + (size_t)row * 256 : X.out + O_KVS + (size_t)(row - MPR) * 256;
                    *(f32x4*)(okv + 4 * lane) = c;
                    v2u cw; cw.x = pk2(c.x, c.y); cw.y = pk2(c.z, c.w); *(v2u*)(CKV + (size_t)row * 256 + 4 * lane) = cw;
                    const float partner = __shfl_xor(v, 16);
                    if (lane < 32) {
                        const int i = lane & 15;
                        const float o = lane < 16 ? v * cs[r].x - partner * cs[r].y : partner * cs[r].y + v * cs[r].x;
                        float* okr = row < MPR ? X.out + O_KRP + (size_t)row * 32 : X.out + O_KRS + (size_t)(row - MPR) * 32;
                        okr[lane] = o;
                        KPE[(size_t)row * 32 + 2 * i + (lane >> 4)] = (bf16)(pk2(o, 0.f) & 0xffffu);
                    } else {
                        DT[(size_t)row * 32 + (lane - 32)] = softplus(v + dbias);
                    }
                }
            }
        }
    }
    {
        const float* wc = (const float*)a.in[I_WCONV]; const float* bc = (const float*)a.in[I_BCONV];
        for (int item = X.gw; item < 2048 + 1024; item += X.NGW) {
            const bool smp = item >= 2048;
            const int sl = item & 7, ch = sl * 512 + 8 * lane;
            float w[4][8], bias[8];
#pragma unroll
            for (int k = 0; k < 4; ++k) { const f32x4 w0 = *(const f32x4*)(wc + k * 4096 + ch), w1 = *(const f32x4*)(wc + k * 4096 + ch + 4);
                w[k][0] = w0.x; w[k][1] = w0.y; w[k][2] = w0.z; w[k][3] = w0.w; w[k][4] = w1.x; w[k][5] = w1.y; w[k][6] = w1.z; w[k][7] = w1.w; }
            { const f32x4 b0 = *(const f32x4*)(bc + ch), b1 = *(const f32x4*)(bc + ch + 4); bias[0] = b0.x; bias[1] = b0.y; bias[2] = b0.z; bias[3] = b0.w; bias[4] = b1.x; bias[5] = b1.y; bias[6] = b1.z; bias[7] = b1.w; }
            float r3[8], r2[8], r1[8], cur[8], y[8];
            if (!smp) {
                const int row_s = (item >> 3) * 64;
                if ((row_s & (SEQ - 1)) == 0) {
#pragma unroll
                    for (int j = 0; j < 8; ++j) { r3[j] = 0.f; r2[j] = 0.f; r1[j] = 0.f; }
                } else {
                    const v4u h3 = *(const v4u*)(PB + (size_t)(row_s - 3) * NPB + PB_XBC + ch), h2 = *(const v4u*)(PB + (size_t)(row_s - 2) * NPB + PB_XBC + ch), h1 = *(const v4u*)(PB + (size_t)(row_s - 1) * NPB + PB_XBC + ch);
                    unpack8(h3, r3); unpack8(h2, r2); unpack8(h1, r1);
                }
                v4u rawv[2][8];
#pragma unroll
                for (int t = 0; t < 8; ++t) rawv[0][t] = *(const v4u*)(PB + (size_t)(row_s + t) * NPB + PB_XBC + ch);
#pragma unroll
                for (int bt = 0; bt < 8; ++bt) {
                    if (bt < 7) {
#pragma unroll
                        for (int t = 0; t < 8; ++t) rawv[(bt + 1) & 1][t] = *(const v4u*)(PB + (size_t)(row_s + 8 * (bt + 1) + t) * NPB + PB_XBC + ch);
                    }
#pragma unroll
                    for (int t = 0; t < 8; t += 4) asm volatile("" : "+v"(rawv[bt & 1][t]), "+v"(rawv[bt & 1][t + 1]), "+v"(rawv[bt & 1][t + 2]), "+v"(rawv[bt & 1][t + 3]) :: "memory");
#pragma unroll
                    for (int t = 0; t < 8; ++t) {
                        unpack8(rawv[bt & 1][t], cur);
#pragma unroll
                        for (int p = 0; p < 4; ++p) {
                            f32x2 acc = (f32x2){bias[2 * p], bias[2 * p + 1]};
                            acc = __builtin_elementwise_fma((f32x2){w[0][2 * p], w[0][2 * p + 1]}, (f32x2){r3[2 * p], r3[2 * p + 1]}, acc);
                            acc = __builtin_elementwise_fma((f32x2){w[1][2 * p], w[1][2 * p + 1]}, (f32x2){r2[2 * p], r2[2 * p + 1]}, acc);
                            acc = __builtin_elementwise_fma((f32x2){w[2][2 * p], w[2][2 * p + 1]}, (f32x2){r1[2 * p], r1[2 * p + 1]}, acc);
                            acc = __builtin_elementwise_fma((f32x2){w[3][2 * p], w[3][2 * p + 1]}, (f32x2){cur[2 * p], cur[2 * p + 1]}, acc);
                            const f32x2 tt = acc * (f32x2){-1.4426950408889634f, -1.4426950408889634f};
                            const f32x2 dd = (f32x2){__builtin_amdgcn_exp2f(tt.x), __builtin_amdgcn_exp2f(tt.y)} + (f32x2){1.f, 1.f};
                            const f32x2 yy = acc * (f32x2){__builtin_amdgcn_rcpf(dd.x), __builtin_amdgcn_rcpf(dd.y)};
                            y[2 * p] = yy.x; y[2 * p + 1] = yy.y;
                        }
#pragma unroll
                        for (int j = 0; j < 8; ++j) { r3[j] = r2[j]; r2[j] = r1[j]; r1[j] = cur[j]; }
                        *(v4u*)(XBC + (size_t)(row_s + 8 * bt + t) * 4096 + ch) = pack8(y);
                    }
                }
            } else {
                const int b = (item - 2048) >> 3, row = MPR + b;
                const float* sc = (const float*)a.in[I_CONV] + (size_t)b * 3 * 4096 + ch;
                float* oc = X.out + O_CVS + (size_t)b * 3 * 4096 + ch;
#pragma unroll
                for (int j = 0; j < 8; ++j) { r3[j] = sc[j]; r2[j] = sc[4096 + j]; r1[j] = sc[8192 + j]; }
                unpack8(*(const v4u*)(PB + (size_t)row * NPB + PB_XBC + ch), cur);
#pragma unroll
                for (int j = 0; j < 8; ++j) { const float acc = bias[j] + w[0][j] * r3[j] + w[1][j] * r2[j] + w[2][j] * r1[j] + w[3][j] * cur[j]; y[j] = silu(acc); oc[j] = r2[j]; oc[4096 + j] = r1[j]; oc[8192 + j] = cur[j]; }
                *(v4u*)(XBC + (size_t)row * 4096 + ch) = pack8(y);
            }
        }
        for (int item = X.gw; item < NBAT * 3 * 8; item += X.NGW) {
            const int sl = item & 7, k = (item >> 3) % 3, b = item / 24, ch = sl * 512 + 8 * lane;
            float cur[8]; unpack8(*(const v4u*)(PB + (size_t)(b * SEQ + SEQ - 3 + k) * NPB + PB_XBC + ch), cur);
            float* oc = X.out + O_CVP + (size_t)(b * 3 + k) * 4096 + ch;
            *(f32x4*)oc = (f32x4){cur[0], cur[1], cur[2], cur[3]}; *(f32x4*)(oc + 4) = (f32x4){cur[4], cur[5], cur[6], cur[7]};
        }
    }
}

__device__ __forceinline__ int tr_lane_off(int lane) { return (4 * (lane >> 5) + ((lane & 15) >> 2)) * 64 + ((lane >> 4) & 1) * 32 + (lane & 3) * 8; }
__device__ __forceinline__ bf16x8 tr_frag(const LAS unsigned char* piece, int lo) { const bf16x4 a = vtr(piece + lo), b = vtr(piece + lo + 512); return JOIN8(a, b); }
__device__ __forceinline__ void scan128(float v0, float v1, int lane, float& c0, float& c1, float& tot) {
    const float s = v0 + v1; float incl = s;
#pragma unroll
    for (int o = 1; o < 64; o <<= 1) { const float t = __shfl_up(incl, o); if (lane >= o) incl += t; }
    const float excl = incl - s; c0 = excl + v0; c1 = excl + s; tot = __shfl(incl, 63);
}

__device__ __forceinline__ void ssd_passA_all(const Ctx& X, const Args& a) {
    unsigned char* ws = X.ws; const int lane = X.lane, tid = X.tid, wave = X.wave;
    const bf16* XBC = (const bf16*)(ws + WS_XBC); const float* DT = (const float*)(ws + WS_DT); float* CS = (float*)(ws + WS_CS);
    LAS unsigned char* L = X.lds;
    LAS float* sc = (LAS float*)(X.lds + EXTRA_OFF);
    const int hh = wave >> 1, nh = wave & 1, lo = tr_lane_off(lane), hi = lane >> 5, r32 = lane & 31;
    unsigned voB = (unsigned)((tid >> 4) * 8192 + (tid & 15) * 16), voX = (unsigned)((tid >> 5) * 8192 + (tid & 31) * 16), voD = (unsigned)((2 * lane * 32 + (wave & 3)) * 4);
    v4u bv[4], xv[8]; float d0, d1, al;
#define PA_PREFETCH(item_) do { const int g_ = (item_) & 7, c_ = ((item_) >> 3) & 15, b_ = (item_) >> 7, row0_ = b_ * SEQ + c_ * 128; \
        const char* sb_ = (const char*)XBC + ((size_t)row0_ * 4096 + 2048 + g_ * 128) * 2; const char* sx_ = (const char*)XBC + ((size_t)row0_ * 4096 + g_ * 256) * 2; \
        _Pragma("unroll") for (int i = 0; i < 4; ++i) bv[i] = *(const v4u*)(sb_ + (size_t)i * 262144 + voB); \
        _Pragma("unroll") for (int i = 0; i < 8; ++i) xv[i] = *(const v4u*)(sx_ + (size_t)i * 131072 + voX); \
        const char* sd_ = (const char*)DT + ((size_t)row0_ * 32 + 4 * g_) * 4; d0 = *(const float*)(sd_ + voD); d1 = *(const float*)(sd_ + voD + 128); al = ((const float*)a.in[I_ALOG])[4 * g_ + (wave & 3)]; } while (0)
    { const int first = X.vcu < 1024 ? X.vcu : 0; PA_PREFETCH(first); }
    for (int item = X.vcu; item < 1024; item += X.G) {
        const int g = item & 7, c = (item >> 3) & 15, b = item >> 7, row0 = b * SEQ + c * 128;
        asm volatile("" : "+v"(voB), "+v"(voX), "+v"(voD));
        if (wave < 4) {
            const int h = 4 * g + wave; const float av = -__expf(al);
            float c0, c1, tot; scan128(d0 * av, d1 * av, lane, c0, c1, tot);
            sc[wave * 128 + 2 * lane] = __expf(tot - c0) * d0; sc[wave * 128 + 2 * lane + 1] = __expf(tot - c1) * d1;
            CS[(size_t)(row0 + 2 * lane) * 32 + h] = c0; CS[(size_t)(row0 + 2 * lane + 1) * 32 + h] = c1;
            if (lane == 0) ((float*)(ws + WS_CD))[(b * 16 + c) * 32 + h] = __expf(tot);
        }
        int tl = tid; asm volatile("" : "+v"(tl));
#pragma unroll
        for (int i = 0; i < 4; ++i) {
            const int q = tl + 512 * i, s_ = q >> 4, n = (q & 15) * 8;
            *(LAS v4u*)(L + ((n >> 5) * 8 + (s_ >> 4)) * 1024 + (s_ & 15) * 64 + (n & 31) * 2) = bv[i];
        }
        __syncthreads();
#pragma unroll
        for (int i = 0; i < 8; ++i) {
            const int q = tl + 512 * i, s_ = q >> 5, col = (q & 31) * 8, h_ = col >> 6, p = col & 63;
            float f[8]; unpack8(xv[i], f);
            const float scale = sc[h_ * 128 + s_];
#pragma unroll
            for (int j = 0; j < 8; ++j) f[j] *= scale;
            *(LAS v4u*)(L + 32768 + h_ * 16384 + ((p >> 5) * 8 + (s_ >> 4)) * 1024 + (s_ & 15) * 64 + (p & 31) * 2) = pack8(f);
        }
        __syncthreads();
        { const int nxt = item + X.G < 1024 ? item + X.G : item; PA_PREFETCH(nxt); }
        f32x16 acc[2][2];
#pragma unroll
        for (int i = 0; i < 2; ++i)
#pragma unroll
            for (int j = 0; j < 2; ++j)
#pragma unroll
                for (int r = 0; r < 16; ++r) acc[i][j][r] = 0.f;
#pragma unroll
        for (int ks = 0; ks < 8; ++ks) {
            const bf16x8 a0 = tr_frag(L + 32768 + hh * 16384 + (0 * 8 + ks) * 1024, lo), a1 = tr_frag(L + 32768 + hh * 16384 + (1 * 8 + ks) * 1024, lo);
            const bf16x8 b0 = tr_frag(L + ((2 * nh + 0) * 8 + ks) * 1024, lo), b1 = tr_frag(L + ((2 * nh + 1) * 8 + ks) * 1024, lo);
            acc[0][0] = __builtin_amdgcn_mfma_f32_32x32x16_bf16(a0, b0, acc[0][0], 0, 0, 0); acc[0][1] = __builtin_amdgcn_mfma_f32_32x32x16_bf16(a0, b1, acc[0][1], 0, 0, 0);
            acc[1][0] = __builtin_amdgcn_mfma_f32_32x32x16_bf16(a1, b0, acc[1][0], 0, 0, 0); acc[1][1] = __builtin_amdgcn_mfma_f32_32x32x16_bf16(a1, b1, acc[1][1], 0, 0, 0);
        }
        bf16* dst = (bf16*)(ws + WS_LOC) + (size_t)((b * 16 + c) * 32 + 4 * g + hh) * 8192;
#pragma unroll
        for (int pt = 0; pt < 2; ++pt)
#pragma unroll
            for (int nt = 0; nt < 2; ++nt)
#pragma unroll
                for (int r = 0; r < 16; ++r) dst[(32 * pt + crow(r, hi)) * 128 + 64 * nh + 32 * nt + r32] = (bf16)(pk2(acc[pt][nt][r], 0.f) & 0xffffu);
        __syncthreads();
    }
#undef PA_PREFETCH
}

__device__ __forceinline__ void ssd_passB(const Ctx& X) {
    unsigned char* ws = X.ws;
    const bf16* LOC = (const bf16*)(ws + WS_LOC); const float* CD = (const float*)(ws + WS_CD); bf16* PREV = (bf16*)(ws + WS_PREV);
    const int nthr = X.G * 512;
    const int NE = NBAT * 32 * 64 * 32;
    v2u lw[16]; float cd[16];
#define PB_LOAD(e_) do { const int n4_ = (e_) & 31, p_ = ((e_) >> 5) & 63, h_ = ((e_) >> 11) & 31, b_ = (e_) >> 16; \
        _Pragma("unroll") for (int c = 0; c < 16; ++c) { lw[c] = *(const v2u*)(LOC + (size_t)((b_ * 16 + c) * 32 + h_) * 8192 + p_ * 128 + 4 * n4_); cd[c] = CD[(b_ * 16 + c) * 32 + h_]; } } while (0)
    { const int e0 = X.vcu * 512 + X.tid; PB_LOAD(e0 < NE ? e0 : 0); }
    for (int e = X.vcu * 512 + X.tid; e < NE; e += nthr) {
        const int n4 = e & 31, p = (e >> 5) & 63, h = (e >> 11) & 31, b = e >> 16;
        f32x4 loc[16]; float cdc[16];
#pragma unroll
        for (int c = 0; c < 16; ++c) { loc[c] = (f32x4){bflo(lw[c].x), bfhi(lw[c].x), bflo(lw[c].y), bfhi(lw[c].y)}; cdc[c] = cd[c]; }
#pragma unroll
        for (int c = 0; c < 16; c += 4) asm volatile("" : "+v"(loc[c]), "+v"(loc[c + 1]), "+v"(loc[c + 2]), "+v"(loc[c + 3]), "+v"(cdc[c]), "+v"(cdc[c + 1]), "+v"(cdc[c + 2]), "+v"(cdc[c + 3]) :: "memory");
        { const int en = e + nthr < NE ? e + nthr : e; PB_LOAD(en); }
        f32x4 st = (f32x4){0.f, 0.f, 0.f, 0.f};
#pragma unroll
        for (int c = 0; c < 16; ++c) {
            v2u w; w.x = pk2(st.x, st.y); w.y = pk2(st.z, st.w);
            *(v2u*)(PREV + (size_t)((b * 16 + c) * 32 + h) * 8192 + p * 128 + 4 * n4) = w;
            st = st * cdc[c] + loc[c];
        }
        *(f32x4*)(X.out + O_SSP + (size_t)((b * 32 + h) * 64 + p) * 128 + 4 * n4) = st;
    }
#undef PB_LOAD
}

__device__ __forceinline__ void ssd_passC_all(const Ctx& X, const Args& a) {
    unsigned char* ws = X.ws; const int lane = X.lane, tid = X.tid, wave = X.wave;
    const bf16* XBC = (const bf16*)(ws + WS_XBC); const float* DT = (const float*)(ws + WS_DT); const bf16* PB = (const bf16*)(ws + WS_PB);
    const float* CS = (const float*)(ws + WS_CS); const bf16* PREV = (const bf16*)(ws + WS_PREV); bf16* OS = (bf16*)(ws + WS_OS);
    LAS unsigned char* L = X.lds;
    LAS float* cs = (LAS float*)(X.lds + EXTRA_OFF);
    LAS float* dts = cs + 512;
    const int hh = wave >> 1, wsel = wave & 1, lo = tr_lane_off(lane), hi = lane >> 5, r32 = lane & 31;
    const LAS float* csh = cs + hh * 128; const LAS float* dth = dts + hh * 128;
    const int lt_[2] = {wsel ? 1 : 0, wsel ? 2 : 3};
    v4u cbv[4], bbv[4], xv[8]; float csv, dtv;
    unsigned voCB = (unsigned)((tid >> 4) * 8192 + (tid & 15) * 16), voX = (unsigned)((tid >> 5) * 8192 + (tid & 31) * 16), voS = (unsigned)(((tid & 127) * 32 + (tid >> 7)) * 4), voP = (unsigned)((r32 * 128 + 8 * hi) * 2);
#define PC_PREFETCH(item_) do { const int g_ = (item_) & 7, c_ = ((item_) >> 3) & 15, b_ = (item_) >> 7, row0_ = b_ * SEQ + c_ * 128; \
        const char* sb_ = (const char*)XBC + ((size_t)row0_ * 4096 + g_ * 128) * 2; const char* sx_ = (const char*)XBC + ((size_t)row0_ * 4096 + g_ * 256) * 2; \
        _Pragma("unroll") for (int i = 0; i < 4; ++i) { cbv[i] = *(const v4u*)(sb_ + (size_t)i * 262144 + 6144 + voCB); bbv[i] = *(const v4u*)(sb_ + (size_t)i * 262144 + 4096 + voCB); } \
        _Pragma("unroll") for (int i = 0; i < 8; ++i) xv[i] = *(const v4u*)(sx_ + (size_t)i * 131072 + voX); \
        csv = *(const float*)((const char*)CS + ((size_t)row0_ * 32 + 4 * g_) * 4 + voS); dtv = *(const float*)((const char*)DT + ((size_t)row0_ * 32 + 4 * g_) * 4 + voS); \
        } while (0)
    { const int first = X.vcu < 1024 ? X.vcu : 0; PC_PREFETCH(first); }
    for (int item = X.vcu; item < 1024; item += X.G) {
        const int g = item & 7, c = (item >> 3) & 15, b = item >> 7, row0 = b * SEQ + c * 128;
        asm volatile("" : "+v"(voCB), "+v"(voX), "+v"(voS), "+v"(voP));
        const bf16* prev_ = (const bf16*)((const char*)(PREV + (size_t)((b * 16 + c) * 32 + 4 * g + hh) * 8192) + voP);
        bf16x8 pfa[4], pfb[4];
#pragma unroll
        for (int ks = 0; ks < 4; ++ks) { pfa[ks] = *(const bf16x8*)(prev_ + 16 * ks); pfb[ks] = *(const bf16x8*)(prev_ + 4096 + 16 * ks); }
        int tl = tid; asm volatile("" : "+v"(tl));
        cs[tl] = csv; dts[tl] = dtv;
#pragma unroll
        for (int i = 0; i < 4; ++i) { const int q = tl + 512 * i, s_ = q >> 4, ch = q & 15; *(LAS v4u*)(L + ch * 2048 + s_ * 16) = cbv[i]; *(LAS v4u*)(L + 32768 + ch * 2048 + s_ * 16) = bbv[i]; }
#pragma unroll
        for (int i = 0; i < 8; ++i) { const int q = tl + 512 * i, s_ = q >> 5, col = (q & 31) * 8, h_ = col >> 6, p = col & 63;
            *(LAS v4u*)(L + 65536 + h_ * 16384 + ((p >> 5) * 8 + (s_ >> 4)) * 1024 + (s_ & 15) * 64 + (p & 31) * 2) = xv[i]; }
        bf16x8 pfc[4], pfd[4];
#pragma unroll
        for (int ks = 0; ks < 4; ++ks) { pfc[ks] = *(const bf16x8*)(prev_ + 16 * (ks + 4)); pfd[ks] = *(const bf16x8*)(prev_ + 4096 + 16 * (ks + 4)); }
        __syncthreads();
        f32x16 Z[2][2];
#pragma unroll
        for (int i = 0; i < 2; ++i)
#pragma unroll
            for (int j = 0; j < 2; ++j)
#pragma unroll
                for (int r = 0; r < 16; ++r) Z[i][j][r] = 0.f;
        if (c > 0) {
#pragma unroll
            for (int ks = 0; ks < 8; ++ks) {
                const bf16x8 p0 = ks < 4 ? pfa[ks & 3] : pfc[ks & 3], p1 = ks < 4 ? pfb[ks & 3] : pfd[ks & 3];
#pragma unroll
                for (int li = 0; li < 2; ++li) {
                    const bf16x8 af = *(const LAS bf16x8*)(L + (2 * ks + hi) * 2048 + (32 * lt_[li] + r32) * 16);
                    Z[li][0] = __builtin_amdgcn_mfma_f32_32x32x16_bf16(af, p0, Z[li][0], 0, 0, 0); Z[li][1] = __builtin_amdgcn_mfma_f32_32x32x16_bf16(af, p1, Z[li][1], 0, 0, 0);
                }
            }
#pragma unroll
            for (int li = 0; li < 2; ++li)
#pragma unroll
                for (int q4 = 0; q4 < 4; ++q4) { const f32x4 cv = *(const LAS f32x4*)(csh + 32 * lt_[li] + 8 * q4 + 4 * hi);
#pragma unroll
                    for (int j = 0; j < 4; ++j) { const float e = __expf(cv[j]); Z[li][0][4 * q4 + j] *= e; Z[li][1][4 * q4 + j] *= e; } }
        }
#pragma unroll
        for (int li = 0; li < 2; ++li) {
            const int lt = lt_[li]; const float csl = csh[32 * lt + r32];
            for (int st = 0; st <= lt; ++st) {
                f32x16 Xt;
#pragma unroll
                for (int r = 0; r < 16; ++r) Xt[r] = 0.f;
#pragma unroll
                for (int ks = 0; ks < 8; ++ks) {
                    const bf16x8 af = *(const LAS bf16x8*)(L + 32768 + (2 * ks + hi) * 2048 + (32 * st + r32) * 16);
                    const bf16x8 bf = *(const LAS bf16x8*)(L + (2 * ks + hi) * 2048 + (32 * lt + r32) * 16);
                    Xt = __builtin_amdgcn_mfma_f32_32x32x16_bf16(af, bf, Xt, 0, 0, 0);
                }
#pragma unroll
                for (int q4 = 0; q4 < 4; ++q4) { const f32x4 cv = *(const LAS f32x4*)(csh + 32 * st + 8 * q4 + 4 * hi); const f32x4 dv = *(const LAS f32x4*)(dth + 32 * st + 8 * q4 + 4 * hi);
#pragma unroll
                    for (int j = 0; j < 4; ++j) { const int sl = 8 * q4 + 4 * hi + j; const float wgt = (st < lt || sl <= r32) ? __expf(csl - cv[j]) * dv[j] : 0.f; Xt[4 * q4 + j] *= wgt; } }
                v4u pw0, pw1;
                pw0.x = pk2(Xt[0], Xt[1]); pw0.y = pk2(Xt[2], Xt[3]); pw0.z = pk2(Xt[4], Xt[5]); pw0.w = pk2(Xt[6], Xt[7]);
                pw1.x = pk2(Xt[8], Xt[9]); pw1.y = pk2(Xt[10], Xt[11]); pw1.z = pk2(Xt[12], Xt[13]); pw1.w = pk2(Xt[14], Xt[15]);
                const bf16x8 pa0 = __builtin_bit_cast(bf16x8, pw0), pa1 = __builtin_bit_cast(bf16x8, pw1);
                const LAS unsigned char* xi = L + 65536 + hh * 16384;
#pragma unroll
                for (int pt = 0; pt < 2; ++pt) {
                    const bf16x8 v0 = tr_frag(xi + (pt * 8 + 2 * st) * 1024, lo), v1 = tr_frag(xi + (pt * 8 + 2 * st + 1) * 1024, lo);
                    Z[li][pt] = __builtin_amdgcn_mfma_f32_32x32x16_bf16(pa0, v0, Z[li][pt], 0, 0, 0);
                    Z[li][pt] = __builtin_amdgcn_mfma_f32_32x32x16_bf16(pa1, v1, Z[li][pt], 0, 0, 0);
                }
            }
        }
        __syncthreads();
        { const int nxt = item + X.G < 1024 ? item + X.G : item; PC_PREFETCH(nxt); }
        {
            const float dsk = ((const float*)a.in[I_DSKIP])[4 * g + (lane >> 4)];
            const f32x4 gs = *(const f32x4*)((const float*)a.in[I_GSSM] + g * 256 + 4 * lane);
            LAS float* Y = (LAS float*)L;
            const int xh = lane >> 4, xp = 4 * (lane & 15);
            v2u zv16[2][8];
#pragma unroll
            for (int i = 0; i < 8; ++i) zv16[0][i] = *(const v2u*)(PB + (size_t)(row0 + 8 * wave + i) * NPB + PB_Z + g * 256 + 4 * lane);
#pragma unroll
            for (int hb = 0; hb < 2; ++hb) {
#pragma unroll
                for (int pt = 0; pt < 2; ++pt)
#pragma unroll
                    for (int r = 0; r < 16; ++r) Y[(32 * (lt_[hb] & 1) + crow(r, hi)) * 256 + hh * 64 + 32 * pt + r32] = Z[hb][pt][r];
                if (hb == 0) {
#pragma unroll
                    for (int i = 0; i < 8; ++i) zv16[1][i] = *(const v2u*)(PB + (size_t)(row0 + 64 + 8 * wave + i) * NPB + PB_Z + g * 256 + 4 * lane);
                }
                __syncthreads();
#pragma unroll
                for (int i1 = 0; i1 < 8; ++i1) {
                    const int lr = 8 * wave + i1, l = 64 * hb + lr, row = row0 + l;
                    const v2u zv = zv16[hb][i1];
                    const f32x4 y = *(const LAS f32x4*)(Y + lr * 256 + 4 * lane);
                    const v2u xw = *(const LAS v2u*)(L + 65536 + xh * 16384 + ((xp >> 5) * 8 + (l >> 4)) * 1024 + (l & 15) * 64 + (xp & 31) * 2);
                    f32x4 v;
                    { const f32x2 s01 = silu2((f32x2){bflo(zv.x), bfhi(zv.x)}), s23 = silu2((f32x2){bflo(zv.y), bfhi(zv.y)});
                      v.x = (y.x + dsk * bflo(xw.x)) * s01.x; v.y = (y.y + dsk * bfhi(xw.x)) * s01.y; v.z = (y.z + dsk * bflo(xw.y)) * s23.x; v.w = (y.w + dsk * bfhi(xw.y)) * s23.y; }
                    const float ss = wave_sum((v.x * v.x + v.y * v.y) + (v.z * v.z + v.w * v.w));
                    const float rs = rsqrtf(ss * (1.f / 256.f) + EPS);
                    v2u o; o.x = pk2(v.x * rs * gs.x, v.y * rs * gs.y); o.y = pk2(v.z * rs * gs.z, v.w * rs * gs.w);
                    *(v2u*)(OS + (size_t)row * 2048 + g * 256 + 4 * lane) = o;
                }
                __syncthreads();
            }
        }
    }
#undef PC_PREFETCH
}

constexpr int AT_NSLOT = 4, AT_SLOT = 20480, AT_WS = AT_NSLOT * AT_SLOT  , AT_OST = 86016;
#define AT_WAIT_BAR(N) asm volatile("s_waitcnt vmcnt(" #N ") lgkmcnt(0)\n\ts_barrier" ::: "memory")
#define AT_SB() __builtin_amdgcn_sched_barrier(0)
__device__ __forceinline__ void attn_unit(const Ctx& X, int b, int h, int qb, int nqb, bf16x8 (&qn)[6], bool first) {
    unsigned char* ws = X.ws; int lane = X.lane, wave = X.wave; asm volatile("" : "+v"(lane)); asm volatile("" : "+s"(wave));
    const int r32 = lane & 31, hi = lane >> 5;
    const bf16* Q = (const bf16*)(ws + WS_Q); const bf16* KNV = (const bf16*)(ws + WS_KNV); const bf16* KPE = (const bf16*)(ws + WS_KPE); bf16* OA = (bf16*)(ws + WS_OA);
    const size_t rowbase = (size_t)b * SEQ; const int q0 = qb * 256, NT = 4 * (qb + 1);
    LAS unsigned char* L = X.lds; const unsigned lds0 = (unsigned)(uintptr_t)L;
    LAS float* wsf = (LAS float*)(L + AT_WS) + wave * 64;
    const bf16* ksrc = KNV + (rowbase + lane) * 2048 + h * 64 + wave * 8;
    const bf16* rsrc = KPE + (rowbase + lane) * 32 + (wave & 3) * 8;
    const bf16* vsrc = KNV + (rowbase + 16 * (wave & 3) + (lane >> 2)) * 2048 + 1024 + h * 64 + (wave >> 2) * 32 + (lane & 3) * 8;
    const unsigned kdst = lds0 + wave * 1024, rdst = lds0 + (8 + (wave & 3)) * 1024, vdst = lds0 + 12288 + wave * 1024;
#define AT_DMA(t, slot) do { const unsigned so_ = (unsigned)(slot) * AT_SLOT; \
        glds16(ksrc + (size_t)(t) * 64 * 2048, (unsigned)__builtin_amdgcn_readfirstlane(kdst + so_)); \
        glds16(rsrc + (size_t)(t) * 64 * 32, (unsigned)__builtin_amdgcn_readfirstlane(rdst + so_)); \
        glds16(vsrc + (size_t)(t) * 64 * 2048, (unsigned)__builtin_amdgcn_readfirstlane(vdst + so_)); } while (0)
    if (first) { AT_DMA(0, 0); AT_DMA(1, 1); }
    bf16x8 qr[6];
    { const bf16* qp = Q + (rowbase + q0 + wave * 32 + r32) * QW + h * 96 + hi * 8;
#pragma unroll
      for (int d0 = 0; d0 < 6; ++d0) qr[d0] = first ? *(const bf16x8*)(qp + d0 * 16) : qn[d0];
#pragma unroll
      for (int d0 = 0; d0 < 6; ++d0) asm volatile("" : "+v"(qr[d0])); }
    float mhat = 0.f, l_run = 0.f; f32x16 o[2], pC0, pC1, pP0, pP1, negm;
#pragma unroll
    for (int r = 0; r < 16; ++r) { o[0][r] = 0.f; o[1][r] = 0.f; pP0[r] = 0.f; pP1[r] = 0.f; negm[r] = 0.f; }
    const int qrow = q0 + wave * 32 + r32, qmax_w = q0 + wave * 32 + 31;
    const int Tw = (qmax_w >> 6) < NT - 1 ? (qmax_w >> 6) : NT - 1;
    const int lo = tr_lane_off(lane);
    int slot = 0, pslot = 0;
#define AT_KRD(dst0, dst1, Ks_, d0_) do { dst0 = *(const LAS bf16x8*)((Ks_) + (2 * (d0_) + hi) * 1024 + r32 * 16); dst1 = *(const LAS bf16x8*)((Ks_) + (2 * (d0_) + hi) * 1024 + 512 + r32 * 16); } while (0)
#define AT_MASK(C0, C1, t_) do { if (64 * (t_) + 63 > q0 + wave * 32) { const int kb_ = 64 * (t_) + 4 * hi; \
        _Pragma("unroll") for (int r = 0; r < 16; ++r) { const int kv_ = kb_ + (r & 3) + 8 * (r >> 2); if (kv_ > qrow) C0[r] = -INFINITY; if (kv_ + 32 > qrow) C1[r] = -INFINITY; } } } while (0)
#define AT_ROWMAX(C0, C1, rm_) do { asm("v_max_f32 %0, %1, %2" : "=v"(rm_) : "v"(C0[0]), "v"(C1[0]));   \
        _Pragma("unroll") for (int r = 1; r < 16; ++r) asm("v_max3_f32 %0, %0, %1, %2" : "+v"(rm_) : "v"(C0[r]), "v"(C1[r])); rm_ = fmaxf(rm_, __shfl_xor(rm_, 32)); } while (0)
#define AT_SUM8(P_, B_) ((((f32x2){P_[B_], P_[B_ + 1]} + (f32x2){P_[B_ + 2], P_[B_ + 3]})) + (((f32x2){P_[B_ + 4], P_[B_ + 5]} + (f32x2){P_[B_ + 6], P_[B_ + 7]})))
#define AT_PACK(w_, P_, B_) do { w_.x = pk2(P_[B_], P_[B_ + 1]); w_.y = pk2(P_[B_ + 2], P_[B_ + 3]); w_.z = pk2(P_[B_ + 4], P_[B_ + 5]); w_.w = pk2(P_[B_ + 6], P_[B_ + 7]); } while (0)
    for (int t = 0; t < NT; ++t) {
        if (t + 1 < NT) { AT_WAIT_BAR(3); } else { AT_WAIT_BAR(0); }
        if (t + 2 < NT) { const int s2 = (slot + 2) & 3; AT_DMA(t + 2, s2); }
        if (nqb >= 0 && t == NT - 1) { AT_DMA(0, 0); AT_DMA(1, 1); }
        if (t <= Tw) {
            const LAS unsigned char* Ks = L + slot * AT_SLOT;
            if (t == 0) {
                bf16x8 ka0, ka1;
#pragma unroll
                for (int r = 0; r < 16; ++r) { pP0[r] = 0.f; pP1[r] = 0.f; }
#pragma unroll
                for (int d0 = 0; d0 < 6; ++d0) { AT_KRD(ka0, ka1, Ks, d0); pP0 = __builtin_amdgcn_mfma_f32_32x32x16_bf16(ka0, qr[d0], pP0, 0, 0, 0); pP1 = __builtin_amdgcn_mfma_f32_32x32x16_bf16(ka1, qr[d0], pP1, 0, 0, 0); }
                AT_MASK(pP0, pP1, 0);
                float rm; AT_ROWMAX(pP0, pP1, rm);
                mhat = rm;
#pragma unroll
                for (int r = 0; r < 16; ++r) negm[r] = -rm;
#pragma unroll
                for (int r = 0; r < 16; ++r) { pP0[r] = __builtin_amdgcn_exp2f(pP0[r] - rm); pP1[r] = __builtin_amdgcn_exp2f(pP1[r] - rm); }
            } else {
                const LAS unsigned char* Vp = L + pslot * AT_SLOT + 12288;
                bf16x8 ka0, ka1, kb0, kb1, va0, va1, vb0, vb1; v4u pw0, pw1, pw2, pw3; f32x2 sacc2;
                AT_KRD(ka0, ka1, Ks, 0); AT_KRD(kb0, kb1, Ks, 1); AT_SB();
                pC0 = __builtin_amdgcn_mfma_f32_32x32x16_bf16(ka0, qr[0], negm, 0, 0, 0); pC1 = __builtin_amdgcn_mfma_f32_32x32x16_bf16(ka1, qr[0], negm, 0, 0, 0);
                AT_KRD(ka0, ka1, Ks, 2);
                sacc2 = AT_SUM8(pP0, 0); AT_PACK(pw0, pP0, 0); AT_SB();
                pC0 = __builtin_amdgcn_mfma_f32_32x32x16_bf16(kb0, qr[1], pC0, 0, 0, 0); pC1 = __builtin_amdgcn_mfma_f32_32x32x16_bf16(kb1, qr[1], pC1, 0, 0, 0);
                AT_KRD(kb0, kb1, Ks, 3);
                sacc2 += AT_SUM8(pP0, 8); AT_PACK(pw1, pP0, 8); AT_SB();
                pC0 = __builtin_amdgcn_mfma_f32_32x32x16_bf16(ka0, qr[2], pC0, 0, 0, 0); pC1 = __builtin_amdgcn_mfma_f32_32x32x16_bf16(ka1, qr[2], pC1, 0, 0, 0);
                AT_KRD(ka0, ka1, Ks, 4);
                sacc2 += AT_SUM8(pP1, 0); AT_PACK(pw2, pP1, 0); AT_SB();
                pC0 = __builtin_amdgcn_mfma_f32_32x32x16_bf16(kb0, qr[3], pC0, 0, 0, 0); pC1 = __builtin_amdgcn_mfma_f32_32x32x16_bf16(kb1, qr[3], pC1, 0, 0, 0);
                AT_KRD(kb0, kb1, Ks, 5);
                sacc2 += AT_SUM8(pP1, 8); AT_PACK(pw3, pP1, 8); AT_SB();
                pC0 = __builtin_amdgcn_mfma_f32_32x32x16_bf16(ka0, qr[4], pC0, 0, 0, 0); pC1 = __builtin_amdgcn_mfma_f32_32x32x16_bf16(ka1, qr[4], pC1, 0, 0, 0);
                pC0 = __builtin_amdgcn_mfma_f32_32x32x16_bf16(kb0, qr[5], pC0, 0, 0, 0); pC1 = __builtin_amdgcn_mfma_f32_32x32x16_bf16(kb1, qr[5], pC1, 0, 0, 0);
                l_run += sacc2.x + sacc2.y;
                AT_MASK(pC0, pC1, t);
                float rm; AT_ROWMAX(pC0, pC1, rm);
                bool resc = false;
                if (__any(rm > 0.f)) {
                    const float dl = fmaxf(rm, 0.f); mhat += dl;
#pragma unroll
                    for (int r = 0; r < 16; ++r) negm[r] -= dl;
#pragma unroll
                    for (int r = 0; r < 16; ++r) { pC0[r] -= dl; pC1[r] -= dl; }
                    const float f = __builtin_amdgcn_exp2f(-dl); l_run *= f; if (hi == 0) wsf[r32] = f; resc = true;
                }
                AT_SB();
#define AT_EX4(C_, B_) do { C_[B_] = __builtin_amdgcn_exp2f(C_[B_]); C_[B_ + 1] = __builtin_amdgcn_exp2f(C_[B_ + 1]); C_[B_ + 2] = __builtin_amdgcn_exp2f(C_[B_ + 2]); C_[B_ + 3] = __builtin_amdgcn_exp2f(C_[B_ + 3]); } while (0)
                va0 = tr_frag(Vp, lo); va1 = tr_frag(Vp + 4096, lo); vb0 = tr_frag(Vp + 1024, lo); vb1 = tr_frag(Vp + 4096 + 1024, lo); AT_SB();
                o[0] = __builtin_amdgcn_mfma_f32_32x32x16_bf16(__builtin_bit_cast(bf16x8, pw0), va0, o[0], 0, 0, 0); AT_EX4(pC0, 0); AT_SB();
                o[1] = __builtin_amdgcn_mfma_f32_32x32x16_bf16(__builtin_bit_cast(bf16x8, pw0), va1, o[1], 0, 0, 0); AT_EX4(pC0, 4); va0 = tr_frag(Vp + 2048, lo); va1 = tr_frag(Vp + 4096 + 2048, lo); AT_SB();
                o[0] = __builtin_amdgcn_mfma_f32_32x32x16_bf16(__builtin_bit_cast(bf16x8, pw1), vb0, o[0], 0, 0, 0); AT_EX4(pC0, 8); AT_SB();
                o[1] = __builtin_amdgcn_mfma_f32_32x32x16_bf16(__builtin_bit_cast(bf16x8, pw1), vb1, o[1], 0, 0, 0); AT_EX4(pC0, 12); vb0 = tr_frag(Vp + 3072, lo); vb1 = tr_frag(Vp + 4096 + 3072, lo); AT_SB();
                o[0] = __builtin_amdgcn_mfma_f32_32x32x16_bf16(__builtin_bit_cast(bf16x8, pw2), va0, o[0], 0, 0, 0); AT_EX4(pC1, 0); AT_SB();
                o[1] = __builtin_amdgcn_mfma_f32_32x32x16_bf16(__builtin_bit_cast(bf16x8, pw2), va1, o[1], 0, 0, 0); AT_EX4(pC1, 4); AT_SB();
                o[0] = __builtin_amdgcn_mfma_f32_32x32x16_bf16(__builtin_bit_cast(bf16x8, pw3), vb0, o[0], 0, 0, 0); AT_EX4(pC1, 8); AT_SB();
                o[1] = __builtin_amdgcn_mfma_f32_32x32x16_bf16(__builtin_bit_cast(bf16x8, pw3), vb1, o[1], 0, 0, 0); AT_EX4(pC1, 12); AT_SB();
#undef AT_EX4
                if (resc) {
                    LDS_WAIT();
#pragma unroll
                    for (int q4 = 0; q4 < 4; ++q4) { const f32x4 av = *(const LAS f32x4*)(wsf + 8 * q4 + 4 * hi);
#pragma unroll
                        for (int j = 0; j < 4; ++j) { o[0][4 * q4 + j] *= av[j]; o[1][4 * q4 + j] *= av[j]; } }
                }
                pP0 = pC0; pP1 = pC1;
            }
            if (t == Tw) {
                const LAS unsigned char* Vs = Ks + 12288;
                float sacc = 0.f;
#pragma unroll
                for (int r = 0; r < 16; ++r) sacc += pP0[r] + pP1[r];
                l_run += sacc;
                v4u pw[4]; AT_PACK(pw[0], pP0, 0); AT_PACK(pw[1], pP0, 8); AT_PACK(pw[2], pP1, 0); AT_PACK(pw[3], pP1, 8);
#pragma unroll
                for (int ks = 0; ks < 4; ++ks) {
                    const bf16x8 pa = __builtin_bit_cast(bf16x8, pw[ks]);
                    const bf16x8 v0 = tr_frag(Vs + ks * 1024, lo), v1 = tr_frag(Vs + 4096 + ks * 1024, lo);
                    o[0] = __builtin_amdgcn_mfma_f32_32x32x16_bf16(pa, v0, o[0], 0, 0, 0); o[1] = __builtin_amdgcn_mfma_f32_32x32x16_bf16(pa, v1, o[1], 0, 0, 0);
                }
            }
        }
        pslot = slot; slot = (slot + 1) & 3;
    }
    if (nqb >= 0) { const bf16* qp = Q + (rowbase + nqb * 256 + wave * 32 + r32) * QW + h * 96 + hi * 8;
#pragma unroll
      for (int d0 = 0; d0 < 6; ++d0) qn[d0] = *(const bf16x8*)(qp + d0 * 16); }
    l_run += __shfl_xor(l_run, 32);
    if (hi == 0) wsf[32 + r32] = l_run;
    LDS_WAIT();
    {
        LAS bf16* stg = (LAS bf16*)(L + AT_OST + wave * 4096);
#pragma unroll
        for (int q4 = 0; q4 < 4; ++q4) { const f32x4 lv = *(const LAS f32x4*)(wsf + 32 + 8 * q4 + 4 * hi);
#pragma unroll
            for (int j = 0; j < 4; ++j) { const float inv = __builtin_amdgcn_rcpf(lv[j]); const int orow = 8 * q4 + 4 * hi + j;
                stg[orow * 64 + r32] = (bf16)(pk2(o[0][4 * q4 + j] * inv, 0.f) & 0xffffu); stg[orow * 64 + 32 + r32] = (bf16)(pk2(o[1][4 * q4 + j] * inv, 0.f) & 0xffffu); } }
        LDS_WAIT();
        bf16* Ow = OA + (rowbase + q0 + wave * 32) * 1024 + h * 64;
#pragma unroll
        for (int i = 0; i < 4; ++i) { const int row = i * 8 + (lane >> 3), ch = lane & 7; const v4u v = *(const LAS v4u*)(stg + row * 64 + ch * 8); *(v4u*)(Ow + (size_t)row * 1024 + ch * 8) = v; }
    }
    if (nqb < 0) { AT_WAIT_BAR(0); }
#undef AT_DMA
#undef AT_KRD
#undef AT_MASK
#undef AT_ROWMAX
#undef AT_PACK
}
constexpr int PART_STRIDE = 4096 + 32;
__device__ __forceinline__ void decode_unit(const Ctx& X, const Args& a, int unit) {
    unsigned char* ws = X.ws; int lane = X.lane, tid = X.tid, wave = X.wave; asm volatile("" : "+v"(lane)); asm volatile("" : "+v"(tid)); asm volatile("" : "+s"(wave));
    const int b = unit >> 1, sp = unit & 1;
    const bf16* Q = (const bf16*)(ws + WS_Q) + (size_t)(MPR + b) * QW;
    LAS unsigned char* L = X.lds;
    LAS float* qf = (LAS float*)L;
    LAS bf16* Qp = (LAS bf16*)(L + 8192);
    float* QL = (float*)(ws + WS_QL) + (size_t)b * 16 * 288;
    const int* pt = (const int*)a.in[I_PT] + b * NPAGES + 32 * sp + 4 * wave;
    int pages[4];
#pragma unroll
    for (int i = 0; i < 4; ++i) pages[i] = pt[i];
    { bf16 q3[3];
#pragma unroll
      for (int i = 0; i < 3; ++i) q3[i] = Q[tid + 512 * i];
#pragma unroll
      for (int i = 0; i < 3; ++i) qf[tid + 512 * i] = bf1(q3[i]); }
    __syncthreads();
    {
        const int h = tid >> 5, r8 = (tid & 31) * 8; const bf16* wt = (const bf16*)(ws + WS_WUKV) + (size_t)(h * 64) * 256 + r8;
        float acc8[8];
#pragma unroll
        for (int j = 0; j < 8; ++j) acc8[j] = 0.f;
#pragma unroll 1
        for (int d0 = 0; d0 < 64; d0 += 16) {
            v4u wv[16];
#pragma unroll
            for (int d = 0; d < 16; ++d) wv[d] = *(const v4u*)(wt + (size_t)(d0 + d) * 256);
#pragma unroll
            for (int d = 0; d < 16; ++d) { const float q = qf[h * 96 + d0 + d]; float w[8]; unpack8(wv[d], w);
#pragma unroll
                for (int j = 0; j < 8; ++j) acc8[j] += q * w[j]; }
        }
#pragma unroll
        for (int j = 0; j < 8; ++j) { Qp[h * 288 + r8 + j] = (bf16)(pk2(acc8[j], 0.f) & 0xffffu); if (sp == 0) QL[h * 288 + r8 + j] = acc8[j]; }
        if (tid < 256) { const int hh = tid >> 4, i = tid & 15; const float x1 = qf[hh * 96 + 64 + 2 * i], x2 = qf[hh * 96 + 64 + 2 * i + 1];
            Qp[hh * 288 + 256 + i] = (bf16)(pk2(x1, 0.f) & 0xffffu); Qp[hh * 288 + 272 + i] = (bf16)(pk2(x2, 0.f) & 0xffffu);
            if (sp == 0) { QL[hh * 288 + 256 + i] = x1; QL[hh * 288 + 272 + i] = x2; } }
    }
    __syncthreads();
    const int kl = lane & 15, kq = lane >> 4;
    const LAS bf16* qfp = Qp + kl * 288 + 8 * kq;
    LAS unsigned char* Vt = L + 32768 + wave * 9216;
    f32x4 acc[16];
#pragma unroll
    for (int nb = 0; nb < 16; ++nb) acc[nb] = (f32x4){0.f, 0.f, 0.f, 0.f};
    float m_run = -INFINITY, l_run = 0.f;
    const float* ckv = (const float*)a.in[I_CKV]; const float* cpe = (const float*)a.in[I_CPE];
    const int vwoff = (lane >> 3) * 1024 + (lane & 7) * 8, vroff = (4 * kq + (kl >> 2)) * 64 + (kl & 3) * 8, kroff = kl * 64 + kq * 16;
#pragma unroll
    for (int i = 0; i < 4; ++i) pages[i] = __builtin_amdgcn_readfirstlane(pages[i]);
    f32x4 raw[18];
#define DC_ISSUE(blk_) do { const int pg_ = (blk_) >> 3; const int page_ = pg_ == 0 ? pages[0] : pg_ == 1 ? pages[1] : pg_ == 2 ? pages[2] : pages[3]; \
        const float* kp_ = ckv + ((size_t)page_ * PAGE + ((blk_) & 7) * 16) * 256 + 4 * lane; const float* pp_ = cpe + ((size_t)page_ * PAGE + ((blk_) & 7) * 16) * 32 + 4 * lane; \
        _Pragma("unroll") for (int r = 0; r < 16; ++r) raw[r] = __builtin_nontemporal_load((const f32x4*)(kp_ + r * 256)); \
        raw[16] = __builtin_nontemporal_load((const f32x4*)pp_); raw[17] = __builtin_nontemporal_load((const f32x4*)(pp_ + 256)); } while (0)
    DC_ISSUE(0);
    for (int blk = 0; blk < 32; ++blk) {
#pragma unroll
        for (int r = 0; r < 16; ++r) { v2u w; w.x = pk2(raw[r].x, raw[r].y); w.y = pk2(raw[r].z, raw[r].w); *(LAS v2u*)(Vt + vwoff + r * 64) = w; }
        { v2u w; w.x = pk2(raw[16].x, raw[16].y); w.y = pk2(raw[16].z, raw[16].w); *(LAS v2u*)(Vt + 8192 + (lane >> 3) * 64 + (lane & 7) * 8) = w;
          w.x = pk2(raw[17].x, raw[17].y); w.y = pk2(raw[17].z, raw[17].w); *(LAS v2u*)(Vt + 8192 + 512 + (lane >> 3) * 64 + (lane & 7) * 8) = w; }
        asm volatile("" ::: "memory");
        if (blk + 1 < 32) DC_ISSUE(blk + 1);
        asm volatile("" ::: "memory");
        f32x4 st = (f32x4){0.f, 0.f, 0.f, 0.f};
#pragma unroll
        for (int ks = 0; ks < 9; ++ks) st = __builtin_amdgcn_mfma_f32_16x16x32_bf16(*(const LAS bf16x8*)(Vt + ks * 1024 + kroff), *(const LAS bf16x8*)(qfp + 32 * ks), st, 0, 0, 0);
        float bm = fmaxf(fmaxf(st[0], st[1]), fmaxf(st[2], st[3]));
        bm = fmaxf(bm, __shfl_xor(bm, 16)); bm = fmaxf(bm, __shfl_xor(bm, 32));
        const float m_new = fmaxf(m_run, bm);
        if (__any(m_new > m_run)) { const float al = __builtin_amdgcn_exp2f(m_run - m_new); l_run *= al;
#pragma unroll
            for (int nb = 0; nb < 16; ++nb) acc[nb] = acc[nb] * al;
            m_run = m_new; }
        f32x4 p; p.x = __builtin_amdgcn_exp2f(st[0] - m_run); p.y = __builtin_amdgcn_exp2f(st[1] - m_run); p.z = __builtin_amdgcn_exp2f(st[2] - m_run); p.w = __builtin_amdgcn_exp2f(st[3] - m_run);
        l_run += (p.x + p.y) + (p.z + p.w);
        v2u pw; pw.x = pk2(p.x, p.y); pw.y = pk2(p.z, p.w); const bf16x4 pf = __builtin_bit_cast(bf16x4, pw);
#pragma unroll
        for (int nb = 0; nb < 16; ++nb) { const bf16x4 vf = vtr(Vt + (nb >> 1) * 1024 + vroff + (nb & 1) * 32);
            acc[nb] = __builtin_amdgcn_mfma_f32_16x16x16bf16_1k(vf, pf, acc[nb], 0, 0, 0); }
        asm volatile("" ::: "memory");
    }
#undef DC_ISSUE
    l_run += __shfl_xor(l_run, 16); l_run += __shfl_xor(l_run, 32);
    LAS float* mw = (LAS float*)(X.lds + EXTRA_OFF); LAS float* lw = mw + 128;
    if (lane < 16) { mw[wave * 16 + lane] = m_run; lw[wave * 16 + lane] = l_run; }
    __syncthreads();
    float M = mw[kl];
#pragma unroll
    for (int w = 1; w < 8; ++w) M = fmaxf(M, mw[w * 16 + kl]);
    const float sc = __builtin_amdgcn_exp2f(m_run - M);
    LAS float* Ow = (LAS float*)L + wave * 4096;
#pragma unroll
    for (int nb = 0; nb < 16; ++nb)
#pragma unroll
        for (int r = 0; r < 4; ++r) Ow[(16 * nb + 4 * kq + r) * 16 + kl] = acc[nb][r] * sc;
    __syncthreads();
    float* P = (float*)(ws + WS_PART) + (size_t)(b * 2 + sp) * PART_STRIDE;
#pragma unroll
    for (int i = 0; i < 8; ++i) { const int e = tid + 512 * i; float s = 0.f;
#pragma unroll
        for (int w = 0; w < 8; ++w) s += ((LAS float*)L)[w * 4096 + e];
        P[32 + (e & 15) * 256 + (e >> 4)] = s; }
    if (tid < 16) { float Mh = mw[tid];
#pragma unroll
        for (int w = 1; w < 8; ++w) Mh = fmaxf(Mh, mw[w * 16 + tid]);
        float Ls = 0.f;
#pragma unroll
        for (int w = 0; w < 8; ++w) Ls += lw[w * 16 + tid] * __builtin_amdgcn_exp2f(mw[w * 16 + tid] - Mh);
        P[tid] = Mh; P[16 + tid] = Ls; }
    __syncthreads();
}

__device__ __forceinline__ void decode_combine(const Ctx& X, const Args& a, int unit) {
    unsigned char* ws = X.ws; const int lane = X.lane, tid = X.tid, wave = X.wave, b = unit >> 1, h = 8 * (unit & 1) + wave;
    const float* P0 = (const float*)(ws + WS_PART) + (size_t)(b * 2) * PART_STRIDE; const float* P1 = P0 + PART_STRIDE;
    const float* QL = (const float*)(ws + WS_QL) + (size_t)b * 16 * 288 + h * 288;
    const float* ck = X.out + O_KVS + (size_t)b * 256; const float* kr = X.out + O_KRS + (size_t)b * 32;
    LAS float* ol = (LAS float*)X.lds + wave * 256;
    float s = 0.f;
#pragma unroll
    for (int j = 0; j < 4; ++j) s += QL[lane + 64 * j] * ck[lane + 64 * j];
    if (lane < 32) s += QL[256 + lane] * kr[lane];
    s = wave_sum(s);
    const float m0 = P0[h], m1 = P1[h], M = fmaxf(fmaxf(m0, m1), s);
    const float e0 = __builtin_amdgcn_exp2f(m0 - M), e1 = __builtin_amdgcn_exp2f(m1 - M), en = __builtin_amdgcn_exp2f(s - M);
    const float inv = 1.0f / (P0[16 + h] * e0 + P1[16 + h] * e1 + en);
    const float w0 = e0 * inv, w1 = e1 * inv, wn = en * inv;
#pragma unroll
    for (int j = 0; j < 4; ++j) { const int r = lane + 64 * j; ol[r] = P0[32 + h * 256 + r] * w0 + P1[32 + h * 256 + r] * w1 + ck[r] * wn; }
    LDS_WAIT(); asm volatile("" ::: "memory");
    const float* wp = (const float*)a.in[I_WUV] + h * 64 + lane; float o = 0.f;
#pragma unroll 1
    for (int r0 = 0; r0 < 256; r0 += 32) { float wv[32];
#pragma unroll
        for (int r = 0; r < 32; ++r) wv[r] = wp[(size_t)(r0 + r) * 1024];
#pragma unroll
        for (int r = 0; r < 32; ++r) o += ol[r0 + r] * wv[r]; }
    ((bf16*)(ws + WS_OA))[(size_t)(MPR + b) * 1024 + h * 64 + lane] = (bf16)(pk2(o, 0.f) & 0xffffu);
    LDS_WAIT(); asm volatile("" ::: "memory");
}

__device__ __forceinline__ void smp_ssm_item(const Ctx& X, const Args& a, int item) {
    unsigned char* ws = X.ws; const int lane = X.lane, wave = X.wave, g = item & 7, b = item >> 3, row = MPR + b;
    const bf16* XBC = (const bf16*)(ws + WS_XBC) + (size_t)row * 4096; const bf16* PB = (const bf16*)(ws + WS_PB) + (size_t)row * NPB;
    const int hh = wave >> 1, ph = wave & 1, h = 4 * g + hh, n4 = 4 * (lane & 31), prow = lane >> 5;
    const float dt = ((const float*)(ws + WS_DT))[(size_t)row * 32 + h], dA = __expf(-__expf(((const float*)a.in[I_ALOG])[h]) * dt);
    const v2u bw = *(const v2u*)(XBC + 2048 + g * 128 + n4), cw = *(const v2u*)(XBC + 3072 + g * 128 + n4);
    const f32x4 Bv = (f32x4){bflo(bw.x), bfhi(bw.x), bflo(bw.y), bfhi(bw.y)}, Cv = (f32x4){bflo(cw.x), bfhi(cw.x), bflo(cw.y), bfhi(cw.y)};
    const float* sin_ = (const float*)a.in[I_SSM] + (size_t)((b * 32 + h) * 64) * 128 + n4; float* sout = X.out + O_SSS + (size_t)((b * 32 + h) * 64) * 128 + n4;
    LAS float* ys = (LAS float*)(X.lds + EXTRA_OFF);
    const float dsk = ((const float*)a.in[I_DSKIP])[4 * g + (lane >> 4)]; const f32x4 gs = *(const f32x4*)((const float*)a.in[I_GSSM] + g * 256 + 4 * lane);
    const v2u xw = *(const v2u*)(XBC + g * 256 + 4 * lane), zw = *(const v2u*)(PB + PB_Z + g * 256 + 4 * lane);
    f32x4 st[16]; bf16 xr[16];
#pragma unroll
    for (int i = 0; i < 16; ++i) { st[i] = __builtin_nontemporal_load((const f32x4*)(sin_ + (size_t)(32 * ph + 2 * i + prow) * 128)); xr[i] = XBC[h * 64 + 32 * ph + 2 * i + prow]; }
#pragma unroll
    for (int i = 0; i < 16; ++i) { const int p = 32 * ph + 2 * i + prow; const float xv = bf1(xr[i]) * dt;
        const f32x4 nw = st[i] * dA + Bv * xv; __builtin_nontemporal_store(nw, (f32x4*)(sout + (size_t)p * 128));
        float part = (nw.x * Cv.x + nw.y * Cv.y) + (nw.z * Cv.z + nw.w * Cv.w);
#pragma unroll
        for (int o = 1; o < 32; o <<= 1) part += __shfl_xor(part, o);
        if ((lane & 31) == 0) ys[hh * 64 + p] = part; }
    __syncthreads();
    if (wave == 0) {
        const f32x4 y = *(const LAS f32x4*)(ys + 4 * lane);
        f32x4 v;
        v.x = (y.x + dsk * bflo(xw.x)) * silu(bflo(zw.x)); v.y = (y.y + dsk * bfhi(xw.x)) * silu(bfhi(zw.x));
        v.z = (y.z + dsk * bflo(xw.y)) * silu(bflo(zw.y)); v.w = (y.w + dsk * bfhi(xw.y)) * silu(bfhi(zw.y));
        const float ss = wave_sum((v.x * v.x + v.y * v.y) + (v.z * v.z + v.w * v.w)); const float rs = rsqrtf(ss * (1.f / 256.f) + EPS);
        v2u o; o.x = pk2(v.x * rs * gs.x, v.y * rs * gs.y); o.y = pk2(v.z * rs * gs.z, v.w * rs * gs.w);
        *(v2u*)((bf16*)(ws + WS_OS) + (size_t)row * 2048 + g * 256 + 4 * lane) = o;
    }
    __syncthreads();
}

__device__ __forceinline__ void ph_norm1(const Ctx& X, const Args& a) {
    unsigned char* ws = X.ws; const bf16* MIX = (const bf16*)(ws + WS_MIX); bf16* X1 = (bf16*)(ws + WS_X1); bf16* XN = (bf16*)(ws + WS_XN);
    const GAS f32x4* g1p = (const GAS f32x4*)a.in[I_GPOSTMIX] + X.lane; const GAS f32x4* g2p = (const GAS f32x4*)a.in[I_GPREMLP] + X.lane; f32x4 g1[4], g2[4];
#pragma unroll
    for (int j = 0; j < 4; ++j) { g1[j] = g1p[64 * j]; g2[j] = g2p[64 * j]; }
    for (int m0 = X.gw; m0 < MR; m0 += 2 * X.NGW) {
        int mm[2]; mm[0] = m0; mm[1] = m0 + X.NGW < MR ? m0 + X.NGW : m0;
        f32x4 v[2][4], x[2][4];
#pragma unroll
        for (int q = 0; q < 2; ++q) { const int m = mm[q];
            const float* xrow = m < MPR ? (const float*)a.in[I_XP] + (size_t)m * DM : (const float*)a.in[I_XS] + (size_t)(m - MPR) * DM;
            const GAS f32x4* xr = (const GAS f32x4*)xrow + X.lane; const GAS v2u* mr = (const GAS v2u*)(MIX + (size_t)m * DM) + X.lane;
#pragma unroll
            for (int j = 0; j < 4; ++j) { const v2u mw = mr[64 * j]; v[q][j] = (f32x4){bflo(mw.x), bfhi(mw.x), bflo(mw.y), bfhi(mw.y)}; x[q][j] = xr[64 * j]; } }
#pragma unroll
        for (int q = 0; q < 2; ++q) { const int m = mm[q]; float s = 0.f;
#pragma unroll
            for (int j = 0; j < 4; ++j) s += (v[q][j].x * v[q][j].x + v[q][j].y * v[q][j].y) + (v[q][j].z * v[q][j].z + v[q][j].w * v[q][j].w);
            const float rs = rsqrtf(wave_sum(s) * (1.f / DM) + EPS); float s2 = 0.f;
#pragma unroll
            for (int j = 0; j < 4; ++j) { x[q][j] = x[q][j] + v[q][j] * rs * g1[j]; s2 += (x[q][j].x * x[q][j].x + x[q][j].y * x[q][j].y) + (x[q][j].z * x[q][j].z + x[q][j].w * x[q][j].w); }
            const float rs2 = rsqrtf(wave_sum(s2) * (1.f / DM) + EPS);
            GAS unsigned long long* o4 = (GAS unsigned long long*)(X1 + (size_t)m * DM) + X.lane; GAS unsigned long long* o8 = (GAS unsigned long long*)(XN + (size_t)m * DM) + X.lane;
#pragma unroll
            for (int j = 0; j < 4; ++j) { o4[64 * j] = (unsigned long long)pk2(x[q][j].x, x[q][j].y) | ((unsigned long long)pk2(x[q][j].z, x[q][j].w) << 32); const f32x4 t = x[q][j] * rs2 * g2[j]; o8[64 * j] = (unsigned long long)pk2(t.x, t.y) | ((unsigned long long)pk2(t.z, t.w) << 32); }
        }
    }
}
__device__ __forceinline__ void ph_norm2(const Ctx& X, const Args& a) {
    unsigned char* ws = X.ws; const bf16* Fb = (const bf16*)(ws + WS_F); const bf16* X1 = (const bf16*)(ws + WS_X1);
    const GAS f32x4* gp = (const GAS f32x4*)a.in[I_GPOSTMLP] + X.lane; f32x4 g[4];
#pragma unroll
    for (int j = 0; j < 4; ++j) g[j] = gp[64 * j];
    for (int m0 = X.gw; m0 < MR; m0 += 2 * X.NGW) {
        int mm[2]; mm[0] = m0; mm[1] = m0 + X.NGW < MR ? m0 + X.NGW : m0;
        f32x4 v[2][4], x[2][4];
#pragma unroll
        for (int q = 0; q < 2; ++q) { const int m = mm[q];
            const GAS v2u* fr = (const GAS v2u*)(Fb + (size_t)m * DM) + X.lane; const GAS v2u* xr = (const GAS v2u*)(X1 + (size_t)m * DM) + X.lane;
#pragma unroll
            for (int j = 0; j < 4; ++j) { const v2u fw = fr[64 * j]; v[q][j] = (f32x4){bflo(fw.x), bfhi(fw.x), bflo(fw.y), bfhi(fw.y)}; const v2u xw = xr[64 * j]; x[q][j] = (f32x4){bflo(xw.x), bfhi(xw.x), bflo(xw.y), bfhi(xw.y)}; } }
#pragma unroll
        for (int q = 0; q < 2; ++q) { const int m = mm[q]; float s = 0.f;
#pragma unroll
            for (int j = 0; j < 4; ++j) s += (v[q][j].x * v[q][j].x + v[q][j].y * v[q][j].y) + (v[q][j].z * v[q][j].z + v[q][j].w * v[q][j].w);
            const float rs = rsqrtf(wave_sum(s) * (1.f / DM) + EPS);
            float* orow = m < MPR ? X.out + O_YP + (size_t)m * DM : X.out + O_YS + (size_t)(m - MPR) * DM;
            GAS f32x4* o4 = (GAS f32x4*)orow + X.lane;
#pragma unroll
            for (int j = 0; j < 4; ++j) o4[64 * j] = x[q][j] + v[q][j] * rs * g[j];
        }
    }
}

#ifndef MK_N_LAUNCHES
#define MK_N_LAUNCHES 1
#endif
constexpr int N_PHASES = 12;
constexpr int N_LAUNCHES = MK_N_LAUNCHES;
static_assert(N_LAUNCHES == 1 || N_LAUNCHES == N_PHASES, "MK_N_LAUNCHES is 1 or 12");

__global__ void __launch_bounds__(NWAVES * 64, 2) fwd_kernel(Args args) {
    extern __shared__ __attribute__((aligned(16))) unsigned char lds[];
    Ctx X;
    X.lds = (LAS unsigned char*)lds; X.tid = threadIdx.x; X.lane = X.tid & 63; X.wave = __builtin_amdgcn_readfirstlane(X.tid >> 6);
    X.G = gridDim.x; { const int bx = blockIdx.x; X.vcu = (X.G % 8 == 0) ? (bx % 8) * (X.G / 8) + bx / 8 : bx; }
    X.gw = X.vcu * NWAVES + X.wave; X.NGW = X.G * NWAVES; X.ws = args.ws; X.out = args.out;
    unsigned char* ws = args.ws;
    gu32* ctl = (gu32*)(ws + WS_CTL);
    volatile LAS unsigned* MISC = (volatile LAS unsigned*)(X.lds + MISC_OFF);
    for (int u = X.tid; u < (LDS_BYTES - LDSCTL_OFF) / 4; u += NWAVES * 64) ((LAS unsigned*)(X.lds + LDSCTL_OFF))[u] = 0u;
    __syncthreads();
    XcdBarrier bar; bar.bar = (unsigned*)(ctl + CW_BAR); bar.x = 0; bar.st = nullptr;
    if (N_LAUNCHES == 1) bar = xcd_barrier_post((unsigned*)(ctl + CW_BAR), MISC + 8);
#define GRID_BAR() do { if (N_LAUNCHES == 1) xcd_barrier(bar); } while (0)
    const int lo = args.ph_lo, hi = args.ph_hi;
#ifndef PH_MASK
#define PH_MASK 0xFFF
#endif
#define IN(k) (((PH_MASK >> (k)) & 1) && lo <= (k) && (k) < hi)
#define BOTH(k) (IN(k) && IN((k) + 1))
    const pg8::bf16_t* XN = (const pg8::bf16_t*)(ws + WS_XN);
    const int cb = (int)blockIdx.x;

    if (IN(0)) { ph0_prologue(X, args, 0); if (BOTH(0)) GRID_BAR(); }

    if (IN(1)) {
        pg8::Gemm g{XN, (const pg8::bf16_t*)(ws + WS_WIN), MP, NIN, 1024, 1024, 1024}; pg8::StaticOrder S; S.init(MP, NIN, X.G, cb);
        pg8::Epi<pg8::EM_P1> E{(void*)(ws + WS_PF), NPF, (void*)(ws + WS_PB), NPB, nullptr, 0, nullptr};
        const int grpW = (X.vcu >> 1) & 1;
        if (grpW == 0) { ph0_prologue(X, args, 1); __syncthreads(); }
        pg8::gemm_phase<pg8::Epi<pg8::EM_P1>, pg8::StaticOrder, true, true>(X.lds + RING_OFF, g, S, E);
        if (grpW != 0) { ph0_prologue(X, args, 1); }
        if (BOTH(1)) GRID_BAR();
    }
    if (IN(2)) { ph2_token(X, args); if (BOTH(2)) GRID_BAR(); }

    if (IN(3)) {
        const int grp3 = (X.vcu >> 1) & 1;
        if (grp3 == 0) { for (int it = X.vcu; it < 1024; it += X.G) smp_ssm_item(X, args, it); }
        { pg8::Gemm g{(const pg8::bf16_t*)(ws + WS_CQ), (const pg8::bf16_t*)(ws + WS_WUQ), MP, QW, 384, 384, 384}; pg8::StaticOrder S; S.init(MP, QW, X.G, cb);
          pg8::Epi<pg8::EM_Q> E{(void*)(ws + WS_Q), QW, nullptr, 0, nullptr, 0, (const float*)(ws + WS_TAB)};
          pg8::gemm_phase<pg8::Epi<pg8::EM_Q>, pg8::StaticOrder, true, true>(X.lds + RING_OFF, g, S, E); }
        { pg8::Gemm g{(const pg8::bf16_t*)(ws + WS_CKV), (const pg8::bf16_t*)(ws + WS_WUKV), MPR, 2048, 256, 256, 256}; pg8::StaticOrder S; S.init(MPR, 2048, X.G, cb);
          pg8::Epi<pg8::EM_BF16> E{(void*)(ws + WS_KNV), 2048, nullptr, 0, nullptr, 0, nullptr};
          pg8::gemm_phase<pg8::Epi<pg8::EM_BF16>, pg8::StaticOrder, true, true>(X.lds + RING_OFF, g, S, E); }
        ssd_passA_all(X, args);
        if (grp3 != 0) { for (int it = X.vcu; it < 1024; it += X.G) smp_ssm_item(X, args, it); }
        if (BOTH(3)) GRID_BAR();
    }
    if (IN(4)) {
        const int grp = (X.vcu >> 1) & 1;
        if (grp == 0) { for (int u = X.vcu; u < 256; u += X.G) decode_unit(X, args, u); }
        for (int j = X.vcu; j < 256; j += X.G) {
            const int bh = j >> 1, b = bh >> 4, h = bh & 15;
            bf16x8 qn[6];
            if (j & 1) { attn_unit(X, b, h, 5, 4, qn, true); attn_unit(X, b, h, 4, 3, qn, false); attn_unit(X, b, h, 3, 2, qn, false); attn_unit(X, b, h, 2, -1, qn, false); }
            else       { attn_unit(X, b, h, 7, 6, qn, true); attn_unit(X, b, h, 6, 1, qn, false); attn_unit(X, b, h, 1, 0, qn, false); attn_unit(X, b, h, 0, -1, qn, false); }
        }
        ssd_passB(X);
        if (grp != 0) { for (int u = X.vcu; u < 256; u += X.G) decode_unit(X, args, u); }
        if (BOTH(4)) GRID_BAR();
    }
    if (IN(5)) {
        const int grp5 = (X.vcu >> 1) & 1;
        pg8::Epi<pg8::EM_G1> E1{(void*)(ws + WS_MG1), 1024, nullptr, 0, (const pg8::bf16_t*)(ws + WS_PB) + PB_GA, NPB, nullptr};
        if (grp5 == 0) {
            { pg8::Gemm g{(const pg8::bf16_t*)(ws + WS_OA), (const pg8::bf16_t*)(ws + WS_WBRA), MPR, 1024, 1024, 1024, 1024}; pg8::StaticOrder S; S.init(MPR, 1024, X.G, cb);
              pg8::gemm_phase<pg8::Epi<pg8::EM_G1>, pg8::StaticOrder, false, true>(X.lds + RING_OFF, g, S, E1); }
        }
        ssd_passC_all(X, args);
        if (grp5 != 0) {
            { pg8::Gemm g{(const pg8::bf16_t*)(ws + WS_OA), (const pg8::bf16_t*)(ws + WS_WBRA), MPR, 1024, 1024, 1024, 1024}; pg8::StaticOrder S; S.init(MPR, 1024, X.G, cb);
              pg8::gemm_phase<pg8::Epi<pg8::EM_G1>, pg8::StaticOrder, false, true>(X.lds + RING_OFF, g, S, E1); }
        }
        for (int u = X.vcu; u < 2 * NSB; u += X.G) decode_combine(X, args, u);
        __syncthreads();
        if (BOTH(5)) GRID_BAR();
    }
    if (IN(6)) {
        const pg8::bf16_t* PBh = (const pg8::bf16_t*)(ws + WS_PB);
        pg8::Epi<pg8::EM_G1> E1{(void*)(ws + WS_MG1), 1024, nullptr, 0, PBh + PB_GA, NPB, nullptr};
        pg8::Epi<pg8::EM_G2> E2{(void*)(ws + WS_MG), 1024, (void*)(ws + WS_MG1), 1024, PBh + PB_GB, NPB, nullptr};
        if (((X.vcu >> 1) & 1) == 0) for (int u = ((X.vcu >> 2) << 1) | (X.vcu & 1); u < 128; u += (X.G >> 1)) {
            pg8::skinny_unit<pg8::EM_G1>(X.lds, (const pg8::bf16_t*)(ws + WS_OA), 1024, (const pg8::bf16_t*)(ws + WS_WBRA), 1024, 1024, 32 * (u >> 2), E1, MPR + 32 * (u & 3));
            pg8::skinny_unit<pg8::EM_G2>(X.lds, (const pg8::bf16_t*)(ws + WS_OS), 2048, (const pg8::bf16_t*)(ws + WS_WBRS), 2048, 2048, 32 * (u >> 2), E2, MPR + 32 * (u & 3));
        }
        { pg8::Gemm g{(const pg8::bf16_t*)(ws + WS_OS), (const pg8::bf16_t*)(ws + WS_WBRS), MPR, 1024, 2048, 2048, 2048}; pg8::StaticOrder S; S.init(MPR, 1024, X.G, cb);
          pg8::gemm_phase<pg8::Epi<pg8::EM_G2>, pg8::StaticOrder, false, true>(X.lds + RING_OFF, g, S, E2); }
        if (BOTH(6)) GRID_BAR();
    }
    if (IN(7)) {
        pg8::Epi<pg8::EM_BF16> E{(void*)(ws + WS_MIX), 1024, nullptr, 0, nullptr, 0, nullptr};
        if (((X.vcu >> 1) & 1) == 0) for (int u = ((X.vcu >> 2) << 1) | (X.vcu & 1); u < 128; u += (X.G >> 1)) pg8::skinny_unit<pg8::EM_BF16>(X.lds, (const pg8::bf16_t*)(ws + WS_MG), 1024, (const pg8::bf16_t*)(ws + WS_WOUT), 1024, 1024, 32 * (u >> 2), E, MPR + 32 * (u & 3));
        { pg8::Gemm g{(const pg8::bf16_t*)(ws + WS_MG), (const pg8::bf16_t*)(ws + WS_WOUT), MPR, 1024, 1024, 1024, 1024}; pg8::StaticOrder S; S.init(MPR, 1024, X.G, cb);
          pg8::gemm_phase<pg8::Epi<pg8::EM_BF16>, pg8::StaticOrder, false, true>(X.lds + RING_OFF, g, S, E); }
        if (BOTH(7)) GRID_BAR();
    }
    if (IN(8)) { ph_norm1(X, args); if (BOTH(8)) GRID_BAR(); }
    if (IN(9)) {
        pg8::Epi<pg8::EM_UP> E{(void*)(ws + WS_U), 4096, nullptr, 0, nullptr, 0, nullptr};
        const int grp9 = (X.vcu >> 1) & 1;
        if (grp9 == 0) { for (int u = X.vcu; u < 512; u += X.G) pg8::skinny_unit<pg8::EM_UP>(X.lds, XN, 1024, (const pg8::bf16_t*)(ws + WS_WUP), 1024, 1024, 32 * (u >> 2), E, MPR + 32 * (u & 3)); }
        { pg8::Gemm g{XN, (const pg8::bf16_t*)(ws + WS_WUP), MPR, 4096, 1024, 1024, 1024}; pg8::StaticOrder S; S.init(MPR, 4096, X.G, cb);
          pg8::gemm_phase<pg8::Epi<pg8::EM_UP>, pg8::StaticOrder, true, true>(X.lds + RING_OFF, g, S, E); }
        if (grp9 != 0) { for (int u = X.vcu; u < 512; u += X.G) pg8::skinny_unit<pg8::EM_UP>(X.lds, XN, 1024, (const pg8::bf16_t*)(ws + WS_WUP), 1024, 1024, 32 * (u >> 2), E, MPR + 32 * (u & 3)); }
        if (BOTH(9)) GRID_BAR();
    }
    if (IN(10)) {
        pg8::Epi<pg8::EM_BF16> E{(void*)(ws + WS_F), 1024, nullptr, 0, nullptr, 0, nullptr};
        if (((X.vcu >> 1) & 1) == 0) for (int u = ((X.vcu >> 2) << 1) | (X.vcu & 1); u < 128; u += (X.G >> 1)) pg8::skinny_unit<pg8::EM_BF16>(X.lds, (const pg8::bf16_t*)(ws + WS_U), 4096, (const pg8::bf16_t*)(ws + WS_WDN), 4096, 4096, 32 * (u >> 2), E, MPR + 32 * (u & 3));
        { pg8::Gemm g{(const pg8::bf16_t*)(ws + WS_U), (const pg8::bf16_t*)(ws + WS_WDN), MPR, 1024, 4096, 4096, 4096}; pg8::StaticOrder S; S.init(MPR, 1024, X.G, cb);
          pg8::gemm_phase<pg8::Epi<pg8::EM_BF16>, pg8::StaticOrder, false, true>(X.lds + RING_OFF, g, S, E); }
        if (BOTH(10)) GRID_BAR();
    }
    if (IN(11)) { ph_norm2(X, args); }
#undef IN
#undef BOTH
#undef GRID_BAR
}

extern "C" void kernel_launch(void* const* d_in, const int* in_sizes, int n_in, void* d_out, int out_size, void* d_ws, size_t ws_size, hipStream_t stream) {
    static int grid = 0;
    if (grid == 0) {
        if (n_in != N_IN || (size_t)out_size != O_END || ws_size < WS_END) { fprintf(stderr, "kernel_launch: unexpected problem: n_in %d out %d ws %zu; nothing launched\n", n_in, out_size, ws_size); grid = -1; return; }
        int dev = 0, cus = 0, per_cu = 0;
        if (hipGetDevice(&dev) != hipSuccess || hipDeviceGetAttribute(&cus, hipDeviceAttributeMultiprocessorCount, dev) != hipSuccess) { fprintf(stderr, "kernel_launch: device query failed\n"); grid = -1; return; }
        if (hipFuncSetAttribute((const void*)fwd_kernel, hipFuncAttributeMaxDynamicSharedMemorySize, LDS_BYTES) != hipSuccess) { fprintf(stderr, "kernel_launch: hipFuncSetAttribute failed\n"); grid = -1; return; }
        if (hipOccupancyMaxActiveBlocksPerMultiprocessor(&per_cu, (const void*)fwd_kernel, NWAVES * 64, LDS_BYTES) != hipSuccess || per_cu < 1) { fprintf(stderr, "kernel_launch: occupancy query reports %d blocks per CU\n", per_cu); }
        (void)hipGetLastError();
        grid = cus;
    }
    if (grid < 0) return;
    if (hipMemsetAsync((char*)d_ws + WS_CTL, 0, CTL_ZERO_BYTES, stream) != hipSuccess) { fprintf(stderr, "kernel_launch: memset failed\n"); return; }
    Args a{};
    for (int i = 0; i < N_IN; ++i) a.in[i] = d_in[i];
    a.out = (float*)d_out; a.ws = (unsigned char*)d_ws;
    for (int li = 0; li < N_LAUNCHES; ++li) {
        a.ph_lo = (N_LAUNCHES == 1) ? 0 : li; a.ph_hi = (N_LAUNCHES == 1) ? N_PHASES : li + 1; a.li = li; a.pad = 0;
        hipLaunchKernelGGL(fwd_kernel, dim3(grid), dim3(NWAVES * 64), LDS_BYTES, stream, a);
        const hipError_t le = hipPeekAtLastError();
        if (le != hipSuccess) { fprintf(stderr, "kernel_launch: launch %d failed: %s\n", li, hipGetErrorName(le)); break; }
    }
}
```

```cpp
#define MK_N_LAUNCHES 1
#include <hip/hip_runtime.h>
#include <hip/hip_bf16.h>
#include <cstdio>
#include <cstdint>
#include <cmath>

namespace pg8 {
#define PG8_LAS __attribute__((address_space(3)))
typedef unsigned short bf16_t;
typedef short bf16x8 __attribute__((ext_vector_type(8)));
typedef float f32x4 __attribute__((ext_vector_type(4)));
typedef unsigned u32x4 __attribute__((ext_vector_type(4)));
typedef unsigned u32x2 __attribute__((ext_vector_type(2)));
constexpr int BM = 256, BK = 64, HALF = 128, HTB = HALF * BK * 2  , STAGE_BYTES = 8 * HTB, NXCD = 8, WGM = 8;

__host__ __device__ __forceinline__ int lds_byte(int r, int c) { const int st = (r >> 4) * 2 + (c >> 5), rr = r & 15, cc = c & 31, ob = rr * 64 + cc * 2; return st * 1024 + (ob ^ (((ob >> 9) & 1) << 5)); }
__host__ __device__ __forceinline__ void stage_rc(int b, int& R, int& C) { const int st = b / 1024, sb = b % 1024, swz = sb ^ (((sb >> 9) & 1) << 5); R = (st >> 1) * 16 + swz / 64; C = (st & 1) * 32 + (swz % 64) / 2; }
__host__ __device__ __forceinline__ int perm32(int rho) { const int n = rho >> 4, i = rho & 15; return 8 * (i >> 2) + 4 * n + (i & 3); }

struct Unit { int pm, pn; };
struct Gemm { const bf16_t* A; const bf16_t* Bt; int M, N, K, lda, ldb; };

struct StaticOrder {
    int nM, nN, nwg, G, c;
    __host__ __device__ void init(int M, int N, int G_, int c_) { nM = M / BM; nN = N / BM; nwg = nM * nN; G = G_; c = c_; }
    __host__ __device__ bool next(int i, Unit& u) const {
        const long L = (long)i * G + c; if (L >= nwg) return false;
        int wgid = (int)L; { const int q = nwg / NXCD, r = nwg % NXCD, xcd = wgid % NXCD, off = wgid / NXCD; wgid = (xcd < r ? xcd * (q + 1) : r * (q + 1) + (xcd - r) * q) + off; }
        const int nig = WGM * nN, gid = wgid / nig, fm = gid * WGM, gsz = (nM - fm) < WGM ? (nM - fm) : WGM;
        u.pm = fm + ((wgid % nig) % gsz); u.pn = (wgid % nig) / gsz; return true;
    }
    __device__ __forceinline__ void a_ready(const Unit&) const {}
    __device__ __forceinline__ void done(const Unit&) const {}
};

__device__ __forceinline__ unsigned cvt_pk_bf16(float lo, float hi) { unsigned r; asm volatile("v_cvt_pk_bf16_f32 %0, %1, %2" : "=v"(r) : "v"(lo), "v"(hi)); return r; }
__device__ __forceinline__ float bflo(unsigned w) { return __uint_as_float(w << 16); }
__device__ __forceinline__ float bfhi(unsigned w) { return __uint_as_float(w & 0xffff0000u); }
__device__ __forceinline__ float sigm(float x) { return __builtin_amdgcn_rcpf(1.0f + __expf(-x)); }

enum { EM_P1 = 0, EM_Q = 1, EM_BF16 = 2, EM_G1 = 3, EM_G2 = 4, EM_F32 = 5, EM_UP = 6 };
constexpr float QSCALE = 0.10540925533894598f * 1.4426950408889634f;
template <int MODE> struct Epi {
    static constexpr bool PERM = true, AFTER_DRAIN = false;
    void* o0; int ld0;
    void* o1; int ld1;
    const bf16_t* gate; int ldg;
    const float* tab;
    __device__ __forceinline__ void operator()(const f32x4 (&acc)[2][2][4][2], const Unit& u, int wr, int wc, int fr, int fq) const {
        const int row0 = u.pm * BM + wr * 64 + fr;
#pragma unroll
        for (int ai = 0; ai < 2; ++ai) {
            u32x4 gq[4][2], mq[4][2]; f32x4 tq[4][2];
            if constexpr (MODE == EM_G1 || MODE == EM_G2) {
#pragma unroll
                for (int m = 0; m < 4; ++m)
#pragma unroll
                    for (int bj = 0; bj < 2; ++bj) { const size_t go = (size_t)(row0 + ai * HALF + m * 16) * ldg + u.pn * BM + bj * HALF + wc * 32 + 8 * fq;
                        gq[m][bj] = *(const u32x4*)(gate + go);
                        if constexpr (MODE == EM_G2) mq[m][bj] = *(const u32x4*)((const bf16_t*)o1 + (size_t)(row0 + ai * HALF + m * 16) * ld1 + u.pn * BM + bj * HALF + wc * 32 + 8 * fq); }
            }
            if constexpr (MODE == EM_Q) {
#pragma unroll
                for (int m = 0; m < 4; ++m) { const int row = row0 + ai * HALF + m * 16; const int pidx = row < 16384 ? (row & 2047) : 2048;
                    const float* tp = tab + ((size_t)pidx * 16 + 4 * fq) * 2; tq[m][0] = *(const f32x4*)tp; tq[m][1] = *(const f32x4*)(tp + 4); }
            }
#pragma unroll
            for (int m = 0; m < 4; ++m) {
                const int row = row0 + ai * HALF + m * 16;
#pragma unroll
                for (int bj = 0; bj < 2; ++bj) {
                    const int col = u.pn * BM + bj * HALF + wc * 32 + 8 * fq;
                    f32x4 v0 = acc[ai][bj][m][0], v1 = acc[ai][bj][m][1];
                    if constexpr (MODE == EM_P1) {
                        if (u.pn < 3) { u32x4 w; w.x = cvt_pk_bf16(v0[0], v0[1]); w.y = cvt_pk_bf16(v0[2], v0[3]); w.z = cvt_pk_bf16(v1[0], v1[1]); w.w = cvt_pk_bf16(v1[2], v1[3]);
                               *(u32x4*)((bf16_t*)o0 + (size_t)row * ld0 + col) = w; }
                        else { u32x4 w; w.x = cvt_pk_bf16(v0[0], v0[1]); w.y = cvt_pk_bf16(v0[2], v0[3]); w.z = cvt_pk_bf16(v1[0], v1[1]); w.w = cvt_pk_bf16(v1[2], v1[3]);
                               *(u32x4*)((bf16_t*)o1 + (size_t)row * ld1 + (col - 768)) = w; }
                    } else if constexpr (MODE == EM_Q) {
                        const int g32 = col >> 5;
                        if ((g32 % 3) == 2) {
                            const f32x4 t0 = tq[m][0], t1 = tq[m][1];
                            f32x4 r0, r1;
                            r0[0] = v0[0] * t0[0] - v0[1] * t0[1]; r0[1] = v0[0] * t0[1] + v0[1] * t0[0];
                            r0[2] = v0[2] * t0[2] - v0[3] * t0[3]; r0[3] = v0[2] * t0[3] + v0[3] * t0[2];
                            r1[0] = v1[0] * t1[0] - v1[1] * t1[1]; r1[1] = v1[0] * t1[1] + v1[1] * t1[0];
                            r1[2] = v1[2] * t1[2] - v1[3] * t1[3]; r1[3] = v1[2] * t1[3] + v1[3] * t1[2];
                            v0 = r0; v1 = r1;
                        }
                        v0 = v0 * QSCALE; v1 = v1 * QSCALE;
                        u32x4 w; w.x = cvt_pk_bf16(v0[0], v0[1]); w.y = cvt_pk_bf16(v0[2], v0[3]); w.z = cvt_pk_bf16(v1[0], v1[1]); w.w = cvt_pk_bf16(v1[2], v1[3]);
                        *(u32x4*)((bf16_t*)o0 + (size_t)row * ld0 + col) = w;
                    } else if constexpr (MODE == EM_BF16) {
                        u32x4 w; w.x = cvt_pk_bf16(v0[0], v0[1]); w.y = cvt_pk_bf16(v0[2], v0[3]); w.z = cvt_pk_bf16(v1[0], v1[1]); w.w = cvt_pk_bf16(v1[2], v1[3]);
                        *(u32x4*)((bf16_t*)o0 + (size_t)row * ld0 + col) = w;
                    } else if constexpr (MODE == EM_G1) {
                        const u32x4 gw = gq[m][bj];
                        v0[0] *= sigm(bflo(gw.x)); v0[1] *= sigm(bfhi(gw.x)); v0[2] *= sigm(bflo(gw.y)); v0[3] *= sigm(bfhi(gw.y));
                        v1[0] *= sigm(bflo(gw.z)); v1[1] *= sigm(bfhi(gw.z)); v1[2] *= sigm(bflo(gw.w)); v1[3] *= sigm(bfhi(gw.w));
                        u32x4 w; w.x = cvt_pk_bf16(v0[0], v0[1]); w.y = cvt_pk_bf16(v0[2], v0[3]); w.z = cvt_pk_bf16(v1[0], v1[1]); w.w = cvt_pk_bf16(v1[2], v1[3]);
                        *(u32x4*)((bf16_t*)o0 + (size_t)row * ld0 + col) = w;
                    } else if constexpr (MODE == EM_G2) {
                        const u32x4 gw = gq[m][bj];
                        const u32x4 mw = mq[m][bj];
                        const f32x4 a0 = (f32x4){bflo(mw.x), bfhi(mw.x), bflo(mw.y), bfhi(mw.y)}, a1 = (f32x4){bflo(mw.z), bfhi(mw.z), bflo(mw.w), bfhi(mw.w)};
                        v0[0] = a0[0] + v0[0] * sigm(bflo(gw.x)); v0[1] = a0[1] + v0[1] * sigm(bfhi(gw.x)); v0[2] = a0[2] + v0[2] * sigm(bflo(gw.y)); v0[3] = a0[3] + v0[3] * sigm(bfhi(gw.y));
                        v1[0] = a1[0] + v1[0] * sigm(bflo(gw.z)); v1[1] = a1[1] + v1[1] * sigm(bfhi(gw.z)); v1[2] = a1[2] + v1[2] * sigm(bflo(gw.w)); v1[3] = a1[3] + v1[3] * sigm(bfhi(gw.w));
                        u32x4 w; w.x = cvt_pk_bf16(v0[0], v0[1]); w.y = cvt_pk_bf16(v0[2], v0[3]); w.z = cvt_pk_bf16(v1[0], v1[1]); w.w = cvt_pk_bf16(v1[2], v1[3]);
                        *(u32x4*)((bf16_t*)o0 + (size_t)row * ld0 + col) = w;
                    } else if constexpr (MODE == EM_F32) {
                        float* p = (float*)o0 + (size_t)row * ld0 + col; *(f32x4*)p = v0; *(f32x4*)(p + 4) = v1;
                    } else {
#pragma unroll
                        for (int j = 0; j < 4; ++j) { float a, b; asm("v_max_f32 %0, 0, %1" : "=v"(a) : "v"(v0[j])); asm("v_max_f32 %0, 0, %1" : "=v"(b) : "v"(v1[j])); v0[j] = a * a; v1[j] = b * b; }
                        u32x4 w; w.x = cvt_pk_bf16(v0[0], v0[1]); w.y = cvt_pk_bf16(v0[2], v0[3]); w.z = cvt_pk_bf16(v1[0], v1[1]); w.w = cvt_pk_bf16(v1[2], v1[3]);
                        *(u32x4*)((bf16_t*)o0 + (size_t)row * ld0 + col) = w;
                    }
                }
            }
        }
    }
};

template <class Epi, class Sched, bool ALIGN_EPI = false, bool SP2 = false>
__device__ __forceinline__ void gemm_phase(PG8_LAS unsigned char* lds, const Gemm g, const Sched& S, const Epi& E) {
    const int tid = threadIdx.x, wid = __builtin_amdgcn_readfirstlane(tid >> 6), lane = tid & 63, wr = wid >> 2, wc = wid & 3, fr = lane & 15, fq = lane >> 4;
    int K = g.K; asm volatile("" : "+s"(K)); const int nt = K / BK;
    unsigned voffA[2], voffB[2];
#pragma unroll
    for (int i = 0; i < 2; ++i) { int R, C; stage_rc(tid * 16 + i * 8192, R, C); const int Rb = Epi::PERM ? ((R & ~31) + perm32(R & 31)) : R;
        voffA[i] = (unsigned)(R * g.lda + C) * 2u; voffB[i] = (unsigned)(Rb * g.ldb + C) * 2u; }
    const size_t kstep = (size_t)(BK * 2);
    const size_t hstepA = (size_t)HALF * g.lda * 2, hstepB = (size_t)HALF * g.ldb * 2;
    const size_t tstepA = 2 * hstepA, tstepB = 2 * hstepB;
    const unsigned ldsw = (unsigned)wid * 1024u;
    const int aoff = lds_byte(wr * 64 + fr, fq * 8), boff = lds_byte(wc * 32 + fr, fq * 8);
#define PG8_SA(b, h) (((b) * 2 + (h)) * HTB)
#define PG8_SB(b, h) ((4 + (b) * 2 + (h)) * HTB)
#define PG8_STAGE(bufoff, gbase, voff) do { _Pragma("unroll") for (int _i = 0; _i < 2; ++_i) \
        __builtin_amdgcn_global_load_lds((const unsigned*)((const char*)(gbase) + (voff)[_i]), (PG8_LAS unsigned*)(lds + (bufoff) + ldsw + _i * 8192), 16, 0, 0); } while (0)
#define PG8_LDA(dst, b, h) do { _Pragma("unroll") for (int m = 0; m < 4; ++m) _Pragma("unroll") for (int k = 0; k < 2; ++k) dst[m][k] = *(const PG8_LAS bf16x8*)(lds + PG8_SA(b, h) + aoff + m * 2048 + k * 1024); } while (0)
#define PG8_LDB(dst, b, h) do { _Pragma("unroll") for (int n = 0; n < 2; ++n) _Pragma("unroll") for (int k = 0; k < 2; ++k) dst[n][k] = *(const PG8_LAS bf16x8*)(lds + PG8_SB(b, h) + boff + n * 2048 + k * 1024); } while (0)
#define PG8_MMA(ai, bj, At, Bt) do { __builtin_amdgcn_s_setprio(1); _Pragma("unroll") for (int m = 0; m < 4; ++m) _Pragma("unroll") for (int n = 0; n < 2; ++n) _Pragma("unroll") for (int k = 0; k < 2; ++k) \
        acc[ai][bj][m][n] = __builtin_amdgcn_mfma_f32_16x16x32_bf16(Bt[n][k], At[m][k], acc[ai][bj][m][n], 0, 0, 0); __builtin_amdgcn_s_setprio(0); } while (0)
#define PG8_WAIT_V(n) asm volatile("s_waitcnt vmcnt(" #n ")" ::: "memory")
#define PG8_WAIT_L(n) asm volatile("s_waitcnt lgkmcnt(" #n ")" ::: "memory")
#define PG8_BAR __builtin_amdgcn_s_barrier()
#define PG8_SCHED __builtin_amdgcn_sched_barrier(0)
    Unit cur, nxt; int ui = 0;
    if (!S.next(0, cur)) return;
    f32x4 acc[2][2][4][2];
#pragma unroll
    for (int a = 0; a < 2; ++a)
#pragma unroll
        for (int b = 0; b < 2; ++b)
#pragma unroll
            for (int m = 0; m < 4; ++m)
#pragma unroll
                for (int n = 0; n < 2; ++n) acc[a][b][m][n] = (f32x4){0.f, 0.f, 0.f, 0.f};
    bf16x8 At[4][2], B0[2][2], B1[2][2];
    const char* cA = (const char*)g.A + (size_t)cur.pm * tstepA; const char* cB = (const char*)g.Bt + (size_t)cur.pn * tstepB;
    S.a_ready(cur);
    if constexpr (SP2) {
        PG8_STAGE(PG8_SB(0, 0), cB, voffB); PG8_STAGE(PG8_SB(0, 1), cB + hstepB, voffB); PG8_STAGE(PG8_SA(0, 0), cA, voffA); PG8_STAGE(PG8_SA(0, 1), cA + hstepA, voffA);
        if (wr == 1) PG8_BAR;
        PG8_WAIT_V(2); PG8_BAR;
        PG8_STAGE(PG8_SB(1, 0), cB + kstep, voffB); PG8_STAGE(PG8_SA(1, 0), cA + kstep, voffA); PG8_STAGE(PG8_SB(1, 1), cB + hstepB + kstep, voffB);
        PG8_WAIT_V(6); PG8_BAR;
    } else {
        PG8_STAGE(PG8_SB(0, 0), cB, voffB); PG8_STAGE(PG8_SA(0, 0), cA, voffA); PG8_STAGE(PG8_SB(0, 1), cB + hstepB, voffB); PG8_STAGE(PG8_SA(0, 1), cA + hstepA, voffA);
        if (wr == 1) PG8_BAR;
        PG8_WAIT_V(4); PG8_BAR;
        PG8_STAGE(PG8_SB(1, 0), cB + kstep, voffB); PG8_STAGE(PG8_SA(1, 0), cA + kstep, voffA); PG8_STAGE(PG8_SB(1, 1), cB + hstepB + kstep, voffB);
        PG8_WAIT_V(6); PG8_BAR;
    }
    for (;;) {
        const bool has_next = S.next(ui + 1, nxt);
        const char* nA = has_next ? (const char*)g.A + (size_t)nxt.pm * tstepA : cA; const char* nB = has_next ? (const char*)g.Bt + (size_t)nxt.pn * tstepB : cB;
        for (int t = 0; t < nt; t += 2) {
            const bool last = (t == nt - 2);
            const char* a1 = cA + (size_t)(t + 1) * kstep;
            const char* a2 = last ? nA : cA + (size_t)(t + 2) * kstep; const char* b2 = last ? nB : cB + (size_t)(t + 2) * kstep;
            const char* a3 = a2 + kstep; const char* b3 = b2 + kstep;
            if (last && has_next) S.a_ready(nxt);
            if constexpr (SP2) {
            PG8_LDB(B0, 0, 0); PG8_LDB(B1, 0, 1); PG8_SCHED; PG8_LDA(At, 0, 0); PG8_STAGE(PG8_SA(1, 1), a1 + hstepA, voffA);
            PG8_WAIT_V(8); PG8_WAIT_L(0); PG8_BAR; PG8_MMA(0, 0, At, B0); PG8_MMA(0, 1, At, B1); PG8_BAR; PG8_SCHED;
            PG8_LDA(At, 0, 1); PG8_STAGE(PG8_SB(0, 0), b2, voffB); PG8_STAGE(PG8_SB(0, 1), b2 + hstepB, voffB); PG8_STAGE(PG8_SA(0, 0), a2, voffA);
            PG8_WAIT_V(8); PG8_WAIT_L(0); PG8_BAR; PG8_MMA(1, 0, At, B0); PG8_MMA(1, 1, At, B1); PG8_BAR; PG8_SCHED;
            PG8_LDB(B0, 1, 0); PG8_LDB(B1, 1, 1); PG8_SCHED; PG8_LDA(At, 1, 0); PG8_STAGE(PG8_SA(0, 1), a2 + hstepA, voffA);
            PG8_WAIT_V(8); PG8_WAIT_L(0); PG8_BAR; PG8_MMA(0, 0, At, B0); PG8_MMA(0, 1, At, B1); PG8_BAR; PG8_SCHED;
            PG8_LDA(At, 1, 1); PG8_STAGE(PG8_SB(1, 0), b3, voffB); PG8_STAGE(PG8_SB(1, 1), b3 + hstepB, voffB); PG8_STAGE(PG8_SA(1, 0), a3, voffA);
            PG8_WAIT_V(8); PG8_WAIT_L(0); PG8_BAR; PG8_MMA(1, 0, At, B0); PG8_MMA(1, 1, At, B1); PG8_BAR; PG8_SCHED;
            } else {
            PG8_LDB(B0, 0, 0); PG8_SCHED; PG8_LDA(At, 0, 0); PG8_STAGE(PG8_SA(1, 1), a1 + hstepA, voffA);
            PG8_WAIT_L(8); PG8_BAR; PG8_WAIT_L(0); PG8_MMA(0, 0, At, B0); PG8_BAR; PG8_SCHED;
            PG8_LDB(B1, 0, 1); PG8_STAGE(PG8_SB(0, 0), b2, voffB);
            PG8_BAR; PG8_WAIT_L(0); PG8_MMA(0, 1, At, B1); PG8_BAR;
            PG8_LDA(At, 0, 1); PG8_STAGE(PG8_SA(0, 0), a2, voffA);
            PG8_BAR; PG8_WAIT_L(0); PG8_MMA(1, 0, At, B0); PG8_BAR; PG8_SCHED;
            PG8_STAGE(PG8_SB(0, 1), b2 + hstepB, voffB);
            PG8_WAIT_V(6); PG8_BAR; PG8_MMA(1, 1, At, B1); PG8_BAR;
            PG8_LDB(B0, 1, 0); PG8_SCHED; PG8_LDA(At, 1, 0); PG8_STAGE(PG8_SA(0, 1), a2 + hstepA, voffA);
            PG8_WAIT_L(8); PG8_BAR; PG8_WAIT_L(0); PG8_MMA(0, 0, At, B0); PG8_BAR; PG8_SCHED;
            PG8_LDB(B1, 1, 1); PG8_STAGE(PG8_SB(1, 0), b3, voffB);
            PG8_BAR; PG8_WAIT_L(0); PG8_MMA(0, 1, At, B1); PG8_BAR;
            PG8_LDA(At, 1, 1); PG8_STAGE(PG8_SA(1, 0), a3, voffA);
            PG8_BAR; PG8_WAIT_L(0); PG8_MMA(1, 0, At, B0); PG8_BAR; PG8_SCHED;
            PG8_STAGE(PG8_SB(1, 1), b3 + hstepB, voffB);
            PG8_WAIT_V(6); PG8_BAR; PG8_MMA(1, 1, At, B1); PG8_BAR;
            }
        }
        if constexpr (ALIGN_EPI) { if (wr == 0) PG8_BAR; }
        if constexpr (!Epi::AFTER_DRAIN) { E(acc, cur, wr, wc, fr, fq); S.done(cur); }
        if (!has_next) break;
#pragma unroll
        for (int a = 0; a < 2; ++a)
#pragma unroll
            for (int b = 0; b < 2; ++b)
#pragma unroll
                for (int m = 0; m < 4; ++m)
#pragma unroll
                    for (int n = 0; n < 2; ++n) acc[a][b][m][n] = (f32x4){0.f, 0.f, 0.f, 0.f};
        cur = nxt; cA = nA; cB = nB; ++ui;
        if constexpr (ALIGN_EPI) { if (wr == 1) PG8_BAR; }
    }
    PG8_WAIT_V(0);
    if constexpr (!ALIGN_EPI) { if (wr == 0) PG8_BAR; }
    PG8_BAR;
    if constexpr (Epi::AFTER_DRAIN) { E.fused(acc, cur, wr, wc, fr, fq, lds, wid, lane); S.done(cur); }
#undef PG8_SA
#undef PG8_SB
#undef PG8_STAGE
#undef PG8_LDA
#undef PG8_LDB
#undef PG8_MMA
#undef PG8_WAIT_V
#undef PG8_WAIT_L
#undef PG8_BAR
#undef PG8_SCHED
}

template <int MODE> __device__ __forceinline__ void epi4(const Epi<MODE>& E, int row, int col, f32x4 v) {
    if constexpr (MODE == EM_G1) {
        const u32x2 gw = *(const u32x2*)(E.gate + (size_t)row * E.ldg + col);
        v[0] *= sigm(bflo(gw.x)); v[1] *= sigm(bfhi(gw.x)); v[2] *= sigm(bflo(gw.y)); v[3] *= sigm(bfhi(gw.y));
        { u32x2 w; w.x = cvt_pk_bf16(v[0], v[1]); w.y = cvt_pk_bf16(v[2], v[3]); *(u32x2*)((bf16_t*)E.o0 + (size_t)row * E.ld0 + col) = w; }
    } else if constexpr (MODE == EM_G2) {
        const u32x2 gw = *(const u32x2*)(E.gate + (size_t)row * E.ldg + col);
        const u32x2 mw = *(const u32x2*)((const bf16_t*)E.o1 + (size_t)row * E.ld1 + col);
        const f32x4 a = (f32x4){bflo(mw.x), bfhi(mw.x), bflo(mw.y), bfhi(mw.y)};
        v[0] = a[0] + v[0] * sigm(bflo(gw.x)); v[1] = a[1] + v[1] * sigm(bfhi(gw.x)); v[2] = a[2] + v[2] * sigm(bflo(gw.y)); v[3] = a[3] + v[3] * sigm(bfhi(gw.y));
        u32x2 w; w.x = cvt_pk_bf16(v[0], v[1]); w.y = cvt_pk_bf16(v[2], v[3]);
        *(u32x2*)((bf16_t*)E.o0 + (size_t)row * E.ld0 + col) = w;
    } else if constexpr (MODE == EM_F32) {
        *(f32x4*)((float*)E.o0 + (size_t)row * E.ld0 + col) = v;
    } else if constexpr (MODE == EM_BF16) {
        u32x2 w; w.x = cvt_pk_bf16(v[0], v[1]); w.y = cvt_pk_bf16(v[2], v[3]);
        *(u32x2*)((bf16_t*)E.o0 + (size_t)row * E.ld0 + col) = w;
    } else {
#pragma unroll
        for (int j = 0; j < 4; ++j) { const float a = fmaxf(v[j], 0.f); v[j] = a * a; }
        u32x2 w; w.x = cvt_pk_bf16(v[0], v[1]); w.y = cvt_pk_bf16(v[2], v[3]);
        *(u32x2*)((bf16_t*)E.o0 + (size_t)row * E.ld0 + col) = w;
    }
}
template <int MODE> __device__ __forceinline__ void skinny_unit(PG8_LAS unsigned char* lds, const bf16_t* A, int lda, const bf16_t* Bt, int ldb, int K, int n0, const Epi<MODE>& E, int rbase) {
    const int tid = threadIdx.x, wid = __builtin_amdgcn_readfirstlane(tid >> 6), lane = tid & 63, fr = lane & 15, fq = lane >> 4;
    const int klen = K >> 3, k0 = wid * klen;
    f32x4 acc[2][2];
#pragma unroll
    for (int mt = 0; mt < 2; ++mt) { acc[mt][0] = (f32x4){0.f, 0.f, 0.f, 0.f}; acc[mt][1] = (f32x4){0.f, 0.f, 0.f, 0.f}; }
    const bf16_t* ap = A + (size_t)(rbase + fr) * lda + k0 + 8 * fq;
    const bf16_t* bp = Bt + (size_t)(n0 + fr) * ldb + k0 + 8 * fq;
    bf16x8 bq[2][4][2], aq[2][4][2];
#define SK_LOAD(buf_, kk_) do { _Pragma("unroll") for (int u = 0; u < 4; ++u) { bq[buf_][u][0] = *(const bf16x8*)(bp + (kk_) + 32 * u); bq[buf_][u][1] = *(const bf16x8*)(bp + (size_t)16 * ldb + (kk_) + 32 * u); \
            aq[buf_][u][0] = *(const bf16x8*)(ap + (kk_) + 32 * u); aq[buf_][u][1] = *(const bf16x8*)(ap + (size_t)16 * lda + (kk_) + 32 * u); } } while (0)
    SK_LOAD(0, 0);
#pragma unroll
    for (int kk = 0; kk < klen; kk += 128) {
        const int cb = (kk >> 7) & 1;
        if (kk + 128 < klen) SK_LOAD(cb ^ 1, kk + 128);
#pragma unroll
        for (int u = 0; u < 4; ++u) asm volatile("" : "+v"(bq[cb][u][0]), "+v"(bq[cb][u][1]), "+v"(aq[cb][u][0]), "+v"(aq[cb][u][1]) :: "memory");
#pragma unroll
        for (int u = 0; u < 4; ++u)
#pragma unroll
            for (int mt = 0; mt < 2; ++mt) {
                acc[mt][0] = __builtin_amdgcn_mfma_f32_16x16x32_bf16(bq[cb][u][0], aq[cb][u][mt], acc[mt][0], 0, 0, 0);
                acc[mt][1] = __builtin_amdgcn_mfma_f32_16x16x32_bf16(bq[cb][u][1], aq[cb][u][mt], acc[mt][1], 0, 0, 0);
            }
    }
#undef SK_LOAD
    PG8_LAS float* P = (PG8_LAS float*)lds + wid * 1024;
#pragma unroll
    for (int mt = 0; mt < 2; ++mt) { *(PG8_LAS f32x4*)(P + (16 * mt + fr) * 32 + 4 * fq) = acc[mt][0]; *(PG8_LAS f32x4*)(P + (16 * mt + fr) * 32 + 16 + 4 * fq) = acc[mt][1]; }
    __syncthreads();
    if (tid < 256) {
        const int e = tid * 4, m = e >> 5, c4 = e & 31;
        f32x4 s = *(PG8_LAS f32x4*)((PG8_LAS float*)lds + e);
#pragma unroll
        for (int w = 1; w < 8; ++w) s += *(PG8_LAS f32x4*)((PG8_LAS float*)lds + w * 1024 + e);
        epi4<MODE>(E, rbase + m, n0 + c4, s);
    }
    __syncthreads();
}
}

constexpr int NWAVES = 8;
constexpr int DM = 1024, SEQ = 2048, NBAT = 8, MPR = NBAT * SEQ  , NSB = 128  , MR = MPR + NSB  , MP = 16640  ;
constexpr int NIN = 8960;
constexpr int NPF = 768, NPB = 8192;
constexpr int PB_Z = 0, PB_XBC = 2048, PB_GA = 6144, PB_GB = 7168;
constexpr int QW = 1536;
constexpr int PAST = 8192, PAGE = 128, NPAGES = 64;
constexpr float EPS = 1e-6f;
enum { I_XP = 0, I_XS, I_CKV, I_CPE, I_SSM, I_CONV, I_PT, I_WIN, I_GPRE, I_GQ, I_WUQ, I_GKV, I_WUK, I_WUV, I_WCONV, I_BCONV, I_DTB, I_ALOG, I_DSKIP, I_GSSM,
       I_WBRA, I_WBRS, I_WOUT, I_GPOSTMIX, I_GPREMLP, I_WUP, I_WDN, I_GPOSTMLP, N_IN };
constexpr size_t O_YP = 0, O_YS = 16777216, O_KVP = 16908288, O_KRP = 21102592, O_SSP = 21626880, O_CVP = 23724032, O_KVS = 23822336, O_KRS = 23855104, O_SSS = 23859200, O_CVS = 57413632, O_END = 58986496;

constexpr size_t MiB = 1u << 20;
constexpr size_t WS_CTL = 0, CTL_ZERO_BYTES = 64 * 1024;
constexpr size_t WS_WIN = 2 * MiB, WS_WUQ = 20 * MiB, WS_WUKV = 22 * MiB, WS_WBRA = 24 * MiB, WS_WBRS = 26 * MiB, WS_WOUT = 30 * MiB, WS_WUP = 32 * MiB, WS_WDN = 40 * MiB;
constexpr size_t WS_TAB = 48 * MiB, WS_CD = 49 * MiB, WS_PART = 50 * MiB, WS_QL = 56 * MiB, WS_CS = 60 * MiB  ;
constexpr size_t WS_XN = 64 * MiB, WS_PF = 98 * MiB, WS_PB = 148 * MiB, WS_CQ = 408 * MiB, WS_CKV = 422 * MiB, WS_KPE = 432 * MiB, WS_DT = 434 * MiB, WS_XBC = 438 * MiB;
constexpr size_t WS_Q = 568 * MiB, WS_KNV = 618 * MiB, WS_OA = 682 * MiB, WS_OS = 716 * MiB, WS_LOC = 782 * MiB, WS_PREV = 910 * MiB, WS_MG1 = 974 * MiB, WS_MG = 1040 * MiB;
constexpr size_t WS_MIX = 1074 * MiB, WS_X1 = 1140 * MiB, WS_U = 1206 * MiB, WS_F = 1336 * MiB, WS_END = 1402 * MiB;
static_assert(WS_WIN + (size_t)NIN * 1024 * 2 <= WS_WUQ && WS_XN + (size_t)MP * 1024 * 2 <= WS_PF && WS_PF + (size_t)MP * NPF * 4 <= WS_PB && WS_PB + (size_t)MP * NPB * 2 <= WS_CQ, "ws map 1");
static_assert(WS_CQ + (size_t)MP * 384 * 2 <= WS_CKV && WS_CKV + (size_t)MP * 256 * 2 <= WS_KPE && WS_KPE + (size_t)MP * 32 * 2 <= WS_DT && WS_DT + (size_t)MP * 32 * 4 <= WS_XBC && WS_XBC + (size_t)MP * 4096 * 2 <= WS_Q, "ws map 2");
static_assert(WS_Q + (size_t)MP * QW * 2 <= WS_KNV && WS_KNV + (size_t)MPR * 2048 * 2 <= WS_OA && WS_OA + (size_t)MP * 1024 * 2 <= WS_OS && WS_OS + (size_t)MP * 2048 * 2 <= WS_LOC, "ws map 3");
static_assert(WS_LOC + (size_t)MPR / 128 * 32 * 8192 * 4 <= WS_PREV && WS_PREV + (size_t)MPR / 128 * 32 * 8192 * 2 <= WS_MG1 && WS_MG1 + (size_t)MP * 1024 * 4 <= WS_MG && WS_MG + (size_t)MP * 1024 * 2 <= WS_MIX, "ws map 4");
static_assert(WS_MIX + (size_t)MP * 1024 * 4 <= WS_X1 && WS_X1 + (size_t)MP * 1024 * 4 <= WS_U && WS_U + (size_t)MP * 4096 * 2 <= WS_F && WS_F + (size_t)MP * 1024 * 4 <= WS_END, "ws map 5");
constexpr int CW_TMO = 0, CW_CODE = 1, CW_BAR = 4096;
constexpr int RING_OFF = 0, RING_BYTES = 131072, EXTRA_OFF = 131072  , LDSCTL_OFF = 139264, MISC_OFF = LDSCTL_OFF + 320;
constexpr int LDS_BYTES = 147456;
static_assert(MISC_OFF + 128 <= LDS_BYTES, "LDS map");

#define GAS __attribute__((address_space(1)))
#define LAS __attribute__((address_space(3)))
typedef unsigned short bf16;
typedef unsigned v4u __attribute__((ext_vector_type(4)));
typedef unsigned v2u __attribute__((ext_vector_type(2)));
typedef float f32x4 __attribute__((ext_vector_type(4)));
typedef float f32x2 __attribute__((ext_vector_type(2)));
typedef float f32x16 __attribute__((ext_vector_type(16)));
typedef short bf16x8 __attribute__((ext_vector_type(8)));
typedef short bf16x4 __attribute__((ext_vector_type(4)));
typedef short v4i16_t __attribute__((ext_vector_type(4)));
typedef GAS unsigned gu32;
#define RLX_AGENT __ATOMIC_RELAXED, __HIP_MEMORY_SCOPE_AGENT
#define LDS_WAIT() asm volatile("s_waitcnt lgkmcnt(0)" ::: "memory")
#define VM_WAIT() asm volatile("s_waitcnt vmcnt(0)" ::: "memory")
__device__ __forceinline__ unsigned pk2(float lo, float hi) { return pg8::cvt_pk_bf16(lo, hi); }
__device__ __forceinline__ float bflo(unsigned w) { return __uint_as_float(w << 16); }
__device__ __forceinline__ float bfhi(unsigned w) { return __uint_as_float(w & 0xffff0000u); }
__device__ __forceinline__ float bf1(bf16 b) { return __uint_as_float((unsigned)b << 16); }
__device__ __forceinline__ float wave_sum(float v) {
#pragma unroll
    for (int o = 1; o < 64; o <<= 1) v += __shfl_xor(v, o);
    return v;
}
__device__ __forceinline__ int crow(int r, int hi) { return (r & 3) + 8 * (r >> 2) + 4 * hi; }
__device__ __forceinline__ void unpack8(const v4u w, float (&f)[8]) { f[0] = bflo(w.x); f[1] = bfhi(w.x); f[2] = bflo(w.y); f[3] = bfhi(w.y); f[4] = bflo(w.z); f[5] = bfhi(w.z); f[6] = bflo(w.w); f[7] = bfhi(w.w); }
__device__ __forceinline__ v4u pack8(const float (&f)[8]) { v4u w; w.x = pk2(f[0], f[1]); w.y = pk2(f[2], f[3]); w.z = pk2(f[4], f[5]); w.w = pk2(f[6], f[7]); return w; }
__device__ __forceinline__ void glds16(const void* gsrc, unsigned lds_dst) { unsigned keep;
    asm volatile("s_mov_b32 %0, m0\n\ts_mov_b32 m0, %2\n\ts_nop 0\n\tglobal_load_lds_dwordx4 %1, off\n\ts_mov_b32 m0, %0" : "=&s"(keep) : "v"(gsrc), "s"(lds_dst) : "memory"); }
__device__ __forceinline__ bf16x4 vtr(const LAS unsigned char* p) { return __builtin_bit_cast(bf16x4, __builtin_amdgcn_ds_read_tr16_b64_v4i16((LAS v4i16_t*)p)); }
#define JOIN8(lo, hi) (bf16x8){lo[0], lo[1], lo[2], lo[3], hi[0], hi[1], hi[2], hi[3]}
__constant__ float INV_FREQ[16] = {1.000000000e+00f, 5.623413324e-01f, 3.162277639e-01f, 1.778279394e-01f, 1.000000015e-01f, 5.623413250e-02f, 3.162277490e-02f, 1.778279431e-02f,
                                   9.999999776e-03f, 5.623413250e-03f, 3.162277630e-03f, 1.778279431e-03f, 1.000000047e-03f, 5.623413017e-04f, 3.162277571e-04f, 1.778279402e-04f};

#define XB_TMO      128
#define XB_XCNT(j)  (256  + 64 * (j))
#define XB_XSUB(j)  (1280 + 64 * (j))
#define XB_XGEN(j)  (2304 + 64 * (j))
#define XB_TOP      3328
#define XB_TOPGEN   3392
#define XCD_BAR_WORDS 3456
#define XB_SPIN_CAP (1u << 18)

__device__ __forceinline__ unsigned xb_ld(unsigned* p)              { return __hip_atomic_load(p, __ATOMIC_RELAXED, __HIP_MEMORY_SCOPE_AGENT); }
__device__ __forceinline__ unsigned xb_add(unsigned* p, unsigned v) { return __hip_atomic_fetch_add(p, v, __ATOMIC_RELAXED, __HIP_MEMORY_SCOPE_AGENT); }
__device__ __forceinline__ unsigned xb_xcc_id() { return (unsigned)__builtin_amdgcn_s_getreg((3 << 11) | 20) & 0xFu; }
#define XB_SPIN(cond, bar) do { unsigned _sp = 0; while (cond) { __builtin_amdgcn_s_sleep(1); \
    if ((++_sp & 255u) == 0u) { if (xb_ld(&(bar)[XB_TMO])) break; if (_sp > XB_SPIN_CAP) { atomicAdd(&(bar)[XB_TMO], 1u); break; } } } } while (0)

struct XcdBarrier {
    unsigned* bar; unsigned x;
    volatile LAS unsigned* st;
};

__device__ __forceinline__ XcdBarrier xcd_barrier_post(unsigned* bar, volatile LAS unsigned* st) {
    XcdBarrier b; b.bar = bar; b.x = xb_xcc_id(); b.st = st;
    if (threadIdx.x == 0) (void)xb_add(&bar[XB_XCNT(b.x)], 1u);
    return b;
}
__device__ __forceinline__ void xcd_barrier_complete(unsigned* bar, unsigned x, unsigned& nloc, unsigned& nx) {
    const unsigned G = gridDim.x * gridDim.y * gridDim.z;
    unsigned sum, cnt, mine, sp = 0u;
    for (;;) {
        sum = 0u; cnt = 0u; mine = 0u;
#pragma unroll
        for (unsigned j = 0; j < 16; ++j) { const unsigned c = xb_ld(&bar[XB_XCNT(j)]); sum += c; cnt += (c > 0u) ? 1u : 0u; mine = (j == x) ? c : mine; }
        if (sum == G) break;
        __builtin_amdgcn_s_sleep(1);
        if ((++sp & 255u) == 0u) { if (xb_ld(&bar[XB_TMO])) break; if (sp > XB_SPIN_CAP) { atomicAdd(&bar[XB_TMO], 1u); break; } }
    }
    nloc = mine > 0u ? mine : 1u; nx = cnt > 0u ? cnt : 1u;
}

__device__ __forceinline__ void xcd_barrier(const XcdBarrier& b) {
    asm volatile("s_waitcnt vmcnt(0)" ::: "memory");
    __syncthreads();
    if (threadIdx.x == 0) {
        unsigned* bar = b.bar;
        __builtin_amdgcn_s_waitcnt(0);
        unsigned nloc = b.st[0], nx = b.st[1];
        if (nloc == 0u) { xcd_barrier_complete(bar, b.x, nloc, nx); b.st[0] = nloc; b.st[1] = nx; }
        const unsigned old = xb_add(&bar[XB_XSUB(b.x)], 1u);
        const unsigned gen = old / nloc;
        if (old + 1u == (gen + 1u) * nloc) {
            __builtin_amdgcn_fence(__ATOMIC_RELEASE, "agent");
            asm volatile("s_waitcnt vmcnt(0)" ::: "memory");
            const unsigned og = xb_add(&bar[XB_TOP], 1u);
            const unsigned tg = og / nx;
            if (og + 1u == (tg + 1u) * nx) xb_add(&bar[XB_TOPGEN], 1u);
            else XB_SPIN(xb_ld(&bar[XB_TOPGEN]) == tg, bar);
            __builtin_amdgcn_fence(__ATOMIC_ACQUIRE, "agent");
            xb_add(&bar[XB_XGEN(b.x)], 1u);
            asm volatile("s_waitcnt vmcnt(0)" ::: "memory");
        } else {
            XB_SPIN(xb_ld(&bar[XB_XGEN(b.x)]) == gen, bar);
            __builtin_amdgcn_fence(__ATOMIC_ACQUIRE, "agent");
            asm volatile("s_waitcnt vmcnt(0)" ::: "memory");
        }
    }
    __syncthreads();
}

struct Args { const void* in[N_IN]; float* out; unsigned char* ws; int ph_lo, ph_hi, li, pad; };
struct Ctx {
    LAS unsigned char* lds; int tid, lane, wave, vcu, G, gw, NGW;
    unsigned char* ws; float* out;
};

template <class FN> __device__ __forceinline__ void tr_item(const float* W, int srcN, bf16* WT, int K, int k0, int n0, LAS float* scr, int lane, FN srccol) {
    const int sc = srccol(n0 + (lane & 31));
    float tv[32];
#pragma unroll
    for (int i = 0; i < 32; ++i) { const int kk = 2 * i + (lane >> 5); tv[i] = sc >= 0 ? W[(size_t)(k0 + kk) * srcN + sc] : 0.f; }
#pragma unroll
    for (int i = 0; i < 32; ++i) { const int kk = 2 * i + (lane >> 5); scr[kk * 33 + (lane & 31)] = tv[i]; }
    LDS_WAIT(); asm volatile("" ::: "memory");
    const int c = lane & 7;
#pragma unroll
    for (int j = 0; j < 4; ++j) { const int n = (lane >> 3) + 8 * j; const LAS float* s = scr + (8 * c) * 33 + n;
        v4u o; o.x = pk2(s[0 * 33], s[1 * 33]); o.y = pk2(s[2 * 33], s[3 * 33]); o.z = pk2(s[4 * 33], s[5 * 33]); o.w = pk2(s[6 * 33], s[7 * 33]);
        *(GAS v4u*)(WT + (size_t)(n0 + n) * K + k0 + 8 * c) = o; }
    LDS_WAIT(); asm volatile("" ::: "memory");
}
__device__ __forceinline__ int win_src(int n) { return n < 384 ? n : n < 416 ? n + 256 : n < 448 ? n + 6400 : n < 512 ? -1 : n < 768 ? n - 128 : n < 6912 ? n - 96 : n - 64; }
__device__ __forceinline__ int wuq_src(int n) { const int h = n / 96, j = n - h * 96; if (j < 64) return n; const int jj = j - 64; return h * 96 + 64 + (jj >> 1) + 16 * (jj & 1); }
__device__ __forceinline__ int id_src(int n) { return n; }

__device__ __forceinline__ void ph0_prologue(const Ctx& X, const Args& a, const int part) {
    unsigned char* ws = X.ws;
    LAS float* scr = (LAS float*)(X.lds + RING_OFF + X.wave * 16384);
    constexpr int I0 = 16 * 280, I1 = 6 * 48, I2 = 4 * 32, I3 = 4 * 32, I4 = 16 * 32, I5 = 32 * 32, I6 = 16 * 32, I7 = 16 * 128, I8 = 64 * 32;
    constexpr int NITEMS = I0 + I1 + I2 + I3 + I4 + I5 + I6 + I7 + I8;
    constexpr int NEARLY = I0 + I1 + I2 + I3;
    for (int it = (part == 0 ? 0 : NEARLY) + X.gw; it < (part == 0 ? NEARLY : NITEMS); it += X.NGW) {
        int r = it;
        if (r < I0) { tr_item((const float*)a.in[I_WIN], 8896, (bf16*)(ws + WS_WIN), 1024, 64 * (r / 280), 32 * (r % 280), scr, X.lane, win_src); continue; } r -= I0;
        if (r < I1) { tr_item((const float*)a.in[I_WUQ], 1536, (bf16*)(ws + WS_WUQ), 384, 64 * (r / 48), 32 * (r % 48), scr, X.lane, wuq_src); continue; } r -= I1;
        if (r < I2) { tr_item((const float*)a.in[I_WUK], 1024, (bf16*)(ws + WS_WUKV), 256, 64 * (r / 32), 32 * (r % 32), scr, X.lane, id_src); continue; } r -= I2;
        if (r < I3) { tr_item((const float*)a.in[I_WUV], 1024, (bf16*)(ws + WS_WUKV) + (size_t)1024 * 256, 256, 64 * (r / 32), 32 * (r % 32), scr, X.lane, id_src); continue; } r -= I3;
        if (r < I4) { tr_item((const float*)a.in[I_WBRA], 1024, (bf16*)(ws + WS_WBRA), 1024, 64 * (r / 32), 32 * (r % 32), scr, X.lane, id_src); continue; } r -= I4;
        if (r < I5) { tr_item((const float*)a.in[I_WBRS], 1024, (bf16*)(ws + WS_WBRS), 2048, 64 * (r / 32), 32 * (r % 32), scr, X.lane, id_src); continue; } r -= I5;
        if (r < I6) { tr_item((const float*)a.in[I_WOUT], 1024, (bf16*)(ws + WS_WOUT), 1024, 64 * (r / 32), 32 * (r % 32), scr, X.lane, id_src); continue; } r -= I6;
        if (r < I7) { tr_item((const float*)a.in[I_WUP], 4096, (bf16*)(ws + WS_WUP), 1024, 64 * (r / 128), 32 * (r % 128), scr, X.lane, id_src); continue; } r -= I7;
        tr_item((const float*)a.in[I_WDN], 1024, (bf16*)(ws + WS_WDN), 4096, 64 * (r / 32), 32 * (r % 32), scr, X.lane, id_src);
    }
    if (part != 0) return;
    {
        const GAS f32x4* gp = (const GAS f32x4*)a.in[I_GPRE] + X.lane; f32x4 g[4];
#pragma unroll
        for (int j = 0; j < 4; ++j) g[j] = gp[64 * j];
        bf16* XN = (bf16*)(ws + WS_XN);
        for (int m0 = X.gw; m0 < MP; m0 += 2 * X.NGW) {
            int mm[2]; mm[0] = m0; mm[1] = m0 + X.NGW < MP ? m0 + X.NGW : m0;
            f32x4 v[2][4];
#pragma unroll
            for (int q = 0; q < 2; ++q) { const int m = mm[q];
                if (m < MR) { const float* xrow = m < MPR ? (const float*)a.in[I_XP] + (size_t)m * DM : (const float*)a.in[I_XS] + (size_t)(m - MPR) * DM;
                    const GAS f32x4* xr = (const GAS f32x4*)xrow + X.lane;
#pragma unroll
                    for (int j = 0; j < 4; ++j) v[q][j] = xr[64 * j]; }
                else {
#pragma unroll
                    for (int j = 0; j < 4; ++j) v[q][j] = (f32x4){0.f, 0.f, 0.f, 0.f}; } }
#pragma unroll
            for (int q = 0; q < 2; ++q) { const int m = mm[q]; float s = 0.f;
#pragma unroll
                for (int j = 0; j < 4; ++j) s += (v[q][j].x * v[q][j].x + v[q][j].y * v[q][j].y) + (v[q][j].z * v[q][j].z + v[q][j].w * v[q][j].w);
                const float rs = rsqrtf(wave_sum(s) * (1.f / DM) + EPS);
                GAS unsigned long long* o8 = (GAS unsigned long long*)(XN + (size_t)m * DM) + X.lane;
#pragma unroll
                for (int j = 0; j < 4; ++j) { const f32x4 t = v[q][j] * rs * g[j]; o8[64 * j] = (unsigned long long)pk2(t.x, t.y) | ((unsigned long long)pk2(t.z, t.w) << 32); } }
        }
    }
    {
        float* tab = (float*)(ws + WS_TAB);
        for (int e = X.gw * 64 + X.lane; e < 2049 * 16; e += X.NGW * 64) {
            const int pidx = e >> 4, i = e & 15; const float pos = (float)(pidx < 2048 ? pidx : PAST);
            float s, c; sincosf(pos * INV_FREQ[i], &s, &c);
            tab[2 * e] = c; tab[2 * e + 1] = s;
        }
    }
}

__device__ __forceinline__ float softplus(float x) { return x > 20.f ? x : log1pf(__expf(x)); }
__device__ __forceinline__ float silu(float x) { return x * pg8::sigm(x); }
__device__ __forceinline__ f32x2 silu2(f32x2 x) {
    const f32x2 t = x * (f32x2){-1.4426950408889634f, -1.4426950408889634f};
    const f32x2 d = (f32x2){__builtin_amdgcn_exp2f(t.x), __builtin_amdgcn_exp2f(t.y)} + (f32x2){1.f, 1.f};
    return x * (f32x2){__builtin_amdgcn_rcpf(d.x), __builtin_amdgcn_rcpf(d.y)};
}
__device__ __forceinline__ void ph2_token(const Ctx& X, const Args& a) {
    unsigned char* ws = X.ws; const int lane = X.lane;
    const bf16* PF = (const bf16*)(ws + WS_PF); const bf16* PB = (const bf16*)(ws + WS_PB);
    bf16* CQ = (bf16*)(ws + WS_CQ); bf16* CKV = (bf16*)(ws + WS_CKV); bf16* KPE = (bf16*)(ws + WS_KPE); float* DT = (float*)(ws + WS_DT); bf16* XBC = (bf16*)(ws + WS_XBC);
    const float* tab = (const float*)(ws + WS_TAB);
    {
        const float* gq = (const float*)a.in[I_GQ]; const float* gkv = (const float*)a.in[I_GKV]; const float* dtb = (const float*)a.in[I_DTB];
        f32x2 gqv[3];
#pragma unroll
        for (int j = 0; j < 3; ++j) gqv[j] = *(const f32x2*)(gq + 2 * lane + 128 * j);
        const f32x4 gk = *(const f32x4*)(gkv + 4 * lane);
        const float dbias = dtb[lane & 31];
        for (int row0 = X.gw; row0 < MR; row0 += 4 * X.NGW) {
            unsigned qw[4][3]; v2u kw[4]; bf16 vv[4]; f32x2 cs[4];
#pragma unroll
            for (int r = 0; r < 4; ++r) { const int row = row0 + r * X.NGW < MR ? row0 + r * X.NGW : row0; const bf16* pf = PF + (size_t)row * NPF;
#pragma unroll
                for (int j = 0; j < 3; ++j) qw[r][j] = *(const unsigned*)(pf + 2 * lane + 128 * j);
                kw[r] = *(const v2u*)(pf + 512 + 4 * lane); vv[r] = pf[384 + lane];
                cs[r] = *(const f32x2*)(tab + ((size_t)(row < MPR ? (row & (SEQ - 1)) : 2048) * 16 + (lane & 15)) * 2); }
#pragma unroll
            for (int r = 0; r < 4; ++r) {
                const int row = row0 + r * X.NGW;
                if (row < MR) {
                    f32x2 q[3]; float s = 0.f;
#pragma unroll
                    for (int j = 0; j < 3; ++j) { q[j] = (f32x2){bflo(qw[r][j]), bfhi(qw[r][j])}; s += q[j].x * q[j].x + q[j].y * q[j].y; }
                    const f32x4 k = (f32x4){bflo(kw[r].x), bfhi(kw[r].x), bflo(kw[r].y), bfhi(kw[r].y)};
                    const float v = bf1(vv[r]);
                    float s2 = (k.x * k.x + k.y * k.y) + (k.z * k.z + k.w * k.w);
#pragma unroll
                    for (int o = 1; o < 64; o <<= 1) { s += __shfl_xor(s, o); s2 += __shfl_xor(s2, o); }
                    const float rs = rsqrtf(s * (1.f / 384.f) + EPS), rs2 = rsqrtf(s2 * (1.f / 256.f) + EPS);
#pragma unroll
                    for (int j = 0; j < 3; ++j) *(unsigned*)(CQ + (size_t)row * 384 + 2 * lane + 128 * j) = pk2(q[j].x * rs * gqv[j].x, q[j].y * rs * gqv[j].y);
                    const f32x4 c = k * rs2 * gk;
                    float* okv = row < MPR ? X.out + O_KVP + (size_t)row * 256 : X.out + O_KVS + (size_t)(row - MPR) * 256;
                    *(f32x4*)(okv + 4 * lane) = c;
                    v2u cw; cw.x = pk2(c.x, c.y); cw.y = pk2(c.z, c.w); *(v2u*)(CKV + (size_t)row * 256 + 4 * lane) = cw;
                    const float partner = __shfl_xor(v, 16);
                    if (lane < 32) {
                        const int i = lane & 15;
                        const float o = lane < 16 ? v * cs[r].x - partner * cs[r].y : partner * cs[r].y + v * cs[r].x;
                        float* okr = row < MPR ? X.out + O_KRP + (size_t)row * 32 : X.out + O_KRS + (size_t)(row - MPR) * 32;
                        okr[lane] = o;
                        KPE[(size_t)row * 32 + 2 * i + (lane >> 4)] = (bf16)(pk2(o, 0.f) & 0xffffu);
                    } else {
                        DT[(size_t)row * 32 + (lane - 32)] = softplus(v + dbias);
                    }
                }
            }
        }
    }
    {
        const float* wc = (const float*)a.in[I_WCONV]; const float* bc = (const float*)a.in[I_BCONV];
        for (int item = X.gw; item < 2048 + 1024; item += X.NGW) {
            const bool smp = item >= 2048;
            const int sl = item & 7, ch = sl * 512 + 8 * lane;
            float w[4][8], bias[8];
#pragma unroll
            for (int k = 0; k < 4; ++k) { const f32x4 w0 = *(const f32x4*)(wc + k * 4096 + ch), w1 = *(const f32x4*)(wc + k * 4096 + ch + 4);
                w[k][0] = w0.x; w[k][1] = w0.y; w[k][2] = w0.z; w[k][3] = w0.w; w[k][4] = w1.x; w[k][5] = w1.y; w[k][6] = w1.z; w[k][7] = w1.w; }
            { const f32x4 b0 = *(const f32x4*)(bc + ch), b1 = *(const f32x4*)(bc + ch + 4); bias[0] = b0.x; bias[1] = b0.y; bias[2] = b0.z; bias[3] = b0.w; bias[4] = b1.x; bias[5] = b1.y; bias[6] = b1.z; bias[7] = b1.w; }
            float r3[8], r2[8], r1[8], cur[8], y[8];
            if (!smp) {
                const int row_s = (item >> 3) * 64;
                if ((row_s & (SEQ - 1)) == 0) {
#pragma unroll
                    for (int j = 0; j < 8; ++j) { r3[j] = 0.f; r2[j] = 0.f; r1[j] = 0.f; }
                } else {
                    const v4u h3 = *(const v4u*)(PB + (size_t)(row_s - 3) * NPB + PB_XBC + ch), h2 = *(const v4u*)(PB + (size_t)(row_s - 2) * NPB + PB_XBC + ch), h1 = *(const v4u*)(PB + (size_t)(row_s - 1) * NPB + PB_XBC + ch);
                    unpack8(h3, r3); unpack8(h2, r2); unpack8(h1, r1);
                }
                v4u rawv[2][8];
#pragma unroll
                for (int t = 0; t < 8; ++t) rawv[0][t] = *(const v4u*)(PB + (size_t)(row_s + t) * NPB + PB_XBC + ch);
#pragma unroll
                for (int bt = 0; bt < 8; ++bt) {
                    if (bt < 7) {
#pragma unroll
                        for (int t = 0; t < 8; ++t) rawv[(bt + 1) & 1][t] = *(const v4u*)(PB + (size_t)(row_s + 8 * (bt + 1) + t) * NPB + PB_XBC + ch);
                    }
#pragma unroll
                    for (int t = 0; t < 8; t += 4) asm volatile("" : "+v"(rawv[bt & 1][t]), "+v"(rawv[bt & 1][t + 1]), "+v"(rawv[bt & 1][t + 2]), "+v"(rawv[bt & 1][t + 3]) :: "memory");
#pragma unroll
                    for (int t = 0; t < 8; ++t) {
                        unpack8(rawv[bt & 1][t], cur);
#pragma unroll
                        for (int p = 0; p < 4; ++p) {
                            f32x2 acc = (f32x2){bias[2 * p], bias[2 * p + 1]};
                            acc = __builtin_elementwise_fma((f32x2){w[0][2 * p], w[0][2 * p + 1]}, (f32x2){r3[2 * p], r3[2 * p + 1]}, acc);
                            acc = __builtin_elementwise_fma((f32x2){w[1][2 * p], w[1][2 * p + 1]}, (f32x2){r2[2 * p], r2[2 * p + 1]}, acc);
                            acc = __builtin_elementwise_fma((f32x2){w[2][2 * p], w[2][2 * p + 1]}, (f32x2){r1[2 * p], r1[2 * p + 1]}, acc);
                            acc = __builtin_elementwise_fma((f32x2){w[3][2 * p], w[3][2 * p + 1]}, (f32x2){cur[2 * p], cur[2 * p + 1]}, acc);
                            const f32x2 tt = acc * (f32x2){-1.4426950408889634f, -1.4426950408889634f};
                            const f32x2 dd = (f32x2){__builtin_amdgcn_exp2f(tt.x), __builtin_amdgcn_exp2f(tt.y)} + (f32x2){1.f, 1.f};
                            const f32x2 yy = acc * (f32x2){__builtin_amdgcn_rcpf(dd.x), __builtin_amdgcn_rcpf(dd.y)};
                            y[2 * p] = yy.x; y[2 * p + 1] = yy.y;
                        }
#pragma unroll
                        for (int j = 0; j < 8; ++j) { r3[j] = r2[j]; r2[j] = r1[j]; r1[j] = cur[j]; }
                        *(v4u*)(XBC + (size_t)(row_s + 8 * bt + t) * 4096 + ch) = pack8(y);
                    }
                }
            } else {
                const int b = (item - 2048) >> 3, row = MPR + b;
                const float* sc = (const float*)a.in[I_CONV] + (size_t)b * 3 * 4096 + ch;
                float* oc = X.out + O_CVS + (size_t)b * 3 * 4096 + ch;
#pragma unroll
                for (int j = 0; j < 8; ++j) { r3[j] = sc[j]; r2[j] = sc[4096 + j]; r1[j] = sc[8192 + j]; }
                unpack8(*(const v4u*)(PB + (size_t)row * NPB + PB_XBC + ch), cur);
#pragma unroll
                for (int j = 0; j < 8; ++j) { const float acc = bias[j] + w[0][j] * r3[j] + w[1][j] * r2[j] + w[2][j] * r1[j] + w[3][j] * cur[j]; y[j] = silu(acc); oc[j] = r2[j]; oc[4096 + j] = r1[j]; oc[8192 + j] = cur[j]; }
                *(v4u*)(XBC + (size_t)row * 4096 + ch) = pack8(y);
            }
        }
        for (int item = X.gw; item < NBAT * 3 * 8; item += X.NGW) {
            const int sl = item & 7, k = (item >> 3) % 3, b = item / 24, ch = sl * 512 + 8 * lane;
            float cur[8]; unpack8(*(const v4u*)(PB + (size_t)(b * SEQ + SEQ - 3 + k) * NPB + PB_XBC + ch), cur);
            float* oc = X.out + O_CVP + (size_t)(b * 3 + k) * 4096 + ch;
            *(f32x4*)oc = (f32x4){cur[0], cur[1], cur[2], cur[3]}; *(f32x4*)(oc + 4) = (f32x4){cur[4], cur[5], cur[6], cur[7]};
        }
    }
}

__device__ __forceinline__ int tr_lane_off(int lane) { return (4 * (lane >> 5) + ((lane & 15) >> 2)) * 64 + ((lane >> 4) & 1) * 32 + (lane & 3) * 8; }
__device__ __forceinline__ bf16x8 tr_frag(const LAS unsigned char* piece, int lo) { const bf16x4 a = vtr(piece + lo), b = vtr(piece + lo + 512); return JOIN8(a, b); }
__device__ __forceinline__ void scan128(float v0, float v1, int lane, float& c0, float& c1, float& tot) {
    const float s = v0 + v1; float incl = s;
#pragma unroll
    for (int o = 1; o < 64; o <<= 1) { const float t = __shfl_up(incl, o); if (lane >= o) incl += t; }
    const float excl = incl - s; c0 = excl + v0; c1 = excl + s; tot = __shfl(incl, 63);
}

__device__ __forceinline__ void ssd_passA_all(const Ctx& X, const Args& a) {
    unsigned char* ws = X.ws; const int lane = X.lane, tid = X.tid, wave = X.wave;
    const bf16* XBC = (const bf16*)(ws + WS_XBC); const float* DT = (const float*)(ws + WS_DT); float* CS = (float*)(ws + WS_CS);
    LAS unsigned char* L = X.lds;
    LAS float* sc = (LAS float*)(X.lds + EXTRA_OFF);
    const int hh = wave >> 1, nh = wave & 1, lo = tr_lane_off(lane), hi = lane >> 5, r32 = lane & 31;
    unsigned voB = (unsigned)((tid >> 4) * 8192 + (tid & 15) * 16), voX = (unsigned)((tid >> 5) * 8192 + (tid & 31) * 16), voD = (unsigned)((2 * lane * 32 + (wave & 3)) * 4);
    v4u bv[4], xv[8]; float d0, d1, al;
#define PA_PREFETCH(item_) do { const int g_ = (item_) & 7, c_ = ((item_) >> 3) & 15, b_ = (item_) >> 7, row0_ = b_ * SEQ + c_ * 128; \
        const char* sb_ = (const char*)XBC + ((size_t)row0_ * 4096 + 2048 + g_ * 128) * 2; const char* sx_ = (const char*)XBC + ((size_t)row0_ * 4096 + g_ * 256) * 2; \
        _Pragma("unroll") for (int i = 0; i < 4; ++i) bv[i] = *(const v4u*)(sb_ + (size_t)i * 262144 + voB); \
        _Pragma("unroll") for (int i = 0; i < 8; ++i) xv[i] = *(const v4u*)(sx_ + (size_t)i * 131072 + voX); \
        const char* sd_ = (const char*)DT + ((size_t)row0_ * 32 + 4 * g_) * 4; d0 = *(const float*)(sd_ + voD); d1 = *(const float*)(sd_ + voD + 128); al = ((const float*)a.in[I_ALOG])[4 * g_ + (wave & 3)]; } while (0)
    { const int first = X.vcu < 1024 ? X.vcu : 0; PA_PREFETCH(first); }
    for (int item = X.vcu; item < 1024; item += X.G) {
        const int g = item & 7, c = (item >> 3) & 15, b = item >> 7, row0 = b * SEQ + c * 128;
        asm volatile("" : "+v"(voB), "+v"(voX), "+v"(voD));
        if (wave < 4) {
            const int h = 4 * g + wave; const float av = -__expf(al);
            float c0, c1, tot; scan128(d0 * av, d1 * av, lane, c0, c1, tot);
            sc[wave * 128 + 2 * lane] = __expf(tot - c0) * d0; sc[wave * 128 + 2 * lane + 1] = __expf(tot - c1) * d1;
            CS[(size_t)(row0 + 2 * lane) * 32 + h] = c0; CS[(size_t)(row0 + 2 * lane + 1) * 32 + h] = c1;
            if (lane == 0) ((float*)(ws + WS_CD))[(b * 16 + c) * 32 + h] = __expf(tot);
        }
        int tl = tid; asm volatile("" : "+v"(tl));
#pragma unroll
        for (int i = 0; i < 4; ++i) {
            const int q = tl + 512 * i, s_ = q >> 4, n = (q & 15) * 8;
            *(LAS v4u*)(L + ((n >> 5) * 8 + (s_ >> 4)) * 1024 + (s_ & 15) * 64 + (n & 31) * 2) = bv[i];
        }
        __syncthreads();
#pragma unroll
        for (int i = 0; i < 8; ++i) {
            const int q = tl + 512 * i, s_ = q >> 5, col = (q & 31) * 8, h_ = col >> 6, p = col & 63;
            float f[8]; unpack8(xv[i], f);
            const float scale = sc[h_ * 128 + s_];
#pragma unroll
            for (int j = 0; j < 8; ++j) f[j] *= scale;
            *(LAS v4u*)(L + 32768 + h_ * 16384 + ((p >> 5) * 8 + (s_ >> 4)) * 1024 + (s_ & 15) * 64 + (p & 31) * 2) = pack8(f);
        }
        __syncthreads();
        { const int nxt = item + X.G < 1024 ? item + X.G : item; PA_PREFETCH(nxt); }
        f32x16 acc[2][2];
#pragma unroll
        for (int i = 0; i < 2; ++i)
#pragma unroll
            for (int j = 0; j < 2; ++j)
#pragma unroll
                for (int r = 0; r < 16; ++r) acc[i][j][r] = 0.f;
#pragma unroll
        for (int ks = 0; ks < 8; ++ks) {
            const bf16x8 a0 = tr_frag(L + 32768 + hh * 16384 + (0 * 8 + ks) * 1024, lo), a1 = tr_frag(L + 32768 + hh * 16384 + (1 * 8 + ks) * 1024, lo);
            const bf16x8 b0 = tr_frag(L + ((2 * nh + 0) * 8 + ks) * 1024, lo), b1 = tr_frag(L + ((2 * nh + 1) * 8 + ks) * 1024, lo);
            acc[0][0] = __builtin_amdgcn_mfma_f32_32x32x16_bf16(a0, b0, acc[0][0], 0, 0, 0); acc[0][1] = __builtin_amdgcn_mfma_f32_32x32x16_bf16(a0, b1, acc[0][1], 0, 0, 0);
            acc[1][0] = __builtin_amdgcn_mfma_f32_32x32x16_bf16(a1, b0, acc[1][0], 0, 0, 0); acc[1][1] = __builtin_amdgcn_mfma_f32_32x32x16_bf16(a1, b1, acc[1][1], 0, 0, 0);
        }
        bf16* dst = (bf16*)(ws + WS_LOC) + (size_t)((b * 16 + c) * 32 + 4 * g + hh) * 8192;
#pragma unroll
        for (int pt = 0; pt < 2; ++pt)
#pragma unroll
            for (int nt = 0; nt < 2; ++nt)
#pragma unroll
                for (int r = 0; r < 16; ++r) dst[(32 * pt + crow(r, hi)) * 128 + 64 * nh + 32 * nt + r32] = (bf16)(pk2(acc[pt][nt][r], 0.f) & 0xffffu);
        __syncthreads();
    }
#undef PA_PREFETCH
}

__device__ __forceinline__ void ssd_passB(const Ctx& X) {
    unsigned char* ws = X.ws;
    const bf16* LOC = (const bf16*)(ws + WS_LOC); const float* CD = (const float*)(ws + WS_CD); bf16* PREV = (bf16*)(ws + WS_PREV);
    const int nthr = X.G * 512;
    const int NE = NBAT * 32 * 64 * 32;
    v2u lw[16]; float cd[16];
#define PB_LOAD(e_) do { const int n4_ = (e_) & 31, p_ = ((e_) >> 5) & 63, h_ = ((e_) >> 11) & 31, b_ = (e_) >> 16; \
        _Pragma("unroll") for (int c = 0; c < 16; ++c) { lw[c] = *(const v2u*)(LOC + (size_t)((b_ * 16 + c) * 32 + h_) * 8192 + p_ * 128 + 4 * n4_); cd[c] = CD[(b_ * 16 + c) * 32 + h_]; } } while (0)
    { const int e0 = X.vcu * 512 + X.tid; PB_LOAD(e0 < NE ? e0 : 0); }
    for (int e = X.vcu * 512 + X.tid; e < NE; e += nthr) {
        const int n4 = e & 31, p = (e >> 5) & 63, h = (e >> 11) & 31, b = e >> 16;
        f32x4 loc[16]; float cdc[16];
#pragma unroll
        for (int c = 0; c < 16; ++c) { loc[c] = (f32x4){bflo(lw[c].x), bfhi(lw[c].x), bflo(lw[c].y), bfhi(lw[c].y)}; cdc[c] = cd[c]; }
#pragma unroll
        for (int c = 0; c < 16; c += 4) asm volatile("" : "+v"(loc[c]), "+v"(loc[c + 1]), "+v"(loc[c + 2]), "+v"(loc[c + 3]), "+v"(cdc[c]), "+v"(cdc[c + 1]), "+v"(cdc[c + 2]), "+v"(cdc[c + 3]) :: "memory");
        { const int en = e + nthr < NE ? e + nthr : e; PB_LOAD(en); }
        f32x4 st = (f32x4){0.f, 0.f, 0.f, 0.f};
#pragma unroll
        for (int c = 0; c < 16; ++c) {
            v2u w; w.x = pk2(st.x, st.y); w.y = pk2(st.z, st.w);
            *(v2u*)(PREV + (size_t)((b * 16 + c) * 32 + h) * 8192 + p * 128 + 4 * n4) = w;
            st = st * cdc[c] + loc[c];
        }
        *(f32x4*)(X.out + O_SSP + (size_t)((b * 32 + h) * 64 + p) * 128 + 4 * n4) = st;
    }
#undef PB_LOAD
}

__device__ __forceinline__ void ssd_passC_all(const Ctx& X, const Args& a) {
    unsigned char* ws = X.ws; const int lane = X.lane, tid = X.tid, wave = X.wave;
    const bf16* XBC = (const bf16*)(ws + WS_XBC); const float* DT = (const float*)(ws + WS_DT); const bf16* PB = (const bf16*)(ws + WS_PB);
    const float* CS = (const float*)(ws + WS_CS); const bf16* PREV = (const bf16*)(ws + WS_PREV); bf16* OS = (bf16*)(ws + WS_OS);
    LAS unsigned char* L = X.lds;
    LAS float* cs = (LAS float*)(X.lds + EXTRA_OFF);
    LAS float* dts = cs + 512;
    const int hh = wave >> 1, wsel = wave & 1, lo = tr_lane_off(lane), hi = lane >> 5, r32 = lane & 31;
    const LAS float* csh = cs + hh * 128; const LAS float* dth = dts + hh * 128;
    const int lt_[2] = {wsel ? 1 : 0, wsel ? 2 : 3};
    v4u cbv[4], bbv[4], xv[8]; float csv, dtv;
    unsigned voCB = (unsigned)((tid >> 4) * 8192 + (tid & 15) * 16), voX = (unsigned)((tid >> 5) * 8192 + (tid & 31) * 16), voS = (unsigned)(((tid & 127) * 32 + (tid >> 7)) * 4), voP = (unsigned)((r32 * 128 + 8 * hi) * 2);
#define PC_PREFETCH(item_) do { const int g_ = (item_) & 7, c_ = ((item_) >> 3) & 15, b_ = (item_) >> 7, row0_ = b_ * SEQ + c_ * 128; \
        const char* sb_ = (const char*)XBC + ((size_t)row0_ * 4096 + g_ * 128) * 2; const char* sx_ = (const char*)XBC + ((size_t)row0_ * 4096 + g_ * 256) * 2; \
        _Pragma("unroll") for (int i = 0; i < 4; ++i) { cbv[i] = *(const v4u*)(sb_ + (size_t)i * 262144 + 6144 + voCB); bbv[i] = *(const v4u*)(sb_ + (size_t)i * 262144 + 4096 + voCB); } \
        _Pragma("unroll") for (int i = 0; i < 8; ++i) xv[i] = *(const v4u*)(sx_ + (size_t)i * 131072 + voX); \
        csv = *(const float*)((const char*)CS + ((size_t)row0_ * 32 + 4 * g_) * 4 + voS); dtv = *(const float*)((const char*)DT + ((size_t)row0_ * 32 + 4 * g_) * 4 + voS); \
        } while (0)
    { const int first = X.vcu < 1024 ? X.vcu : 0; PC_PREFETCH(first); }
    for (int item = X.vcu; item < 1024; item += X.G) {
        const int g = item & 7, c = (item >> 3) & 15, b = item >> 7, row0 = b * SEQ + c * 128;
        asm volatile("" : "+v"(voCB), "+v"(voX), "+v"(voS), "+v"(voP));
        const bf16* prev_ = (const bf16*)((const char*)(PREV + (size_t)((b * 16 + c) * 32 + 4 * g + hh) * 8192) + voP);
        bf16x8 pfa[4], pfb[4];
#pragma unroll
        for (int ks = 0; ks < 4; ++ks) { pfa[ks] = *(const bf16x8*)(prev_ + 16 * ks); pfb[ks] = *(const bf16x8*)(prev_ + 4096 + 16 * ks); }
        int tl = tid; asm volatile("" : "+v"(tl));
        cs[tl] = csv; dts[tl] = dtv;
#pragma unroll
        for (int i = 0; i < 4; ++i) { const int q = tl + 512 * i, s_ = q >> 4, ch = q & 15; *(LAS v4u*)(L + ch * 2048 + s_ * 16) = cbv[i]; *(LAS v4u*)(L + 32768 + ch * 2048 + s_ * 16) = bbv[i]; }
#pragma unroll
        for (int i = 0; i < 8; ++i) { const int q = tl + 512 * i, s_ = q >> 5, col = (q & 31) * 8, h_ = col >> 6, p = col & 63;
            *(LAS v4u*)(L + 65536 + h_ * 16384 + ((p >> 5) * 8 + (s_ >> 4)) * 1024 + (s_ & 15) * 64 + (p & 31) * 2) = xv[i]; }
        bf16x8 pfc[4], pfd[4];
#pragma unroll
        for (int ks = 0; ks < 4; ++ks) { pfc[ks] = *(const bf16x8*)(prev_ + 16 * (ks + 4)); pfd[ks] = *(const bf16x8*)(prev_ + 4096 + 16 * (ks + 4)); }
        __syncthreads();
        f32x16 Z[2][2];
#pragma unroll
        for (int i = 0; i < 2; ++i)
#pragma unroll
            for (int j = 0; j < 2; ++j)
#pragma unroll
                for (int r = 0; r < 16; ++r) Z[i][j][r] = 0.f;
        if (c > 0) {
#pragma unroll
            for (int ks = 0; ks < 8; ++ks) {
                const bf16x8 p0 = ks < 4 ? pfa[ks & 3] : pfc[ks & 3], p1 = ks < 4 ? pfb[ks & 3] : pfd[ks & 3];
#pragma unroll
                for (int li = 0; li < 2; ++li) {
                    const bf16x8 af = *(const LAS bf16x8*)(L + (2 * ks + hi) * 2048 + (32 * lt_[li] + r32) * 16);
                    Z[li][0] = __builtin_amdgcn_mfma_f32_32x32x16_bf16(af, p0, Z[li][0], 0, 0, 0); Z[li][1] = __builtin_amdgcn_mfma_f32_32x32x16_bf16(af, p1, Z[li][1], 0, 0, 0);
                }
            }
#pragma unroll
            for (int li = 0; li < 2; ++li)
#pragma unroll
                for (int q4 = 0; q4 < 4; ++q4) { const f32x4 cv = *(const LAS f32x4*)(csh + 32 * lt_[li] + 8 * q4 + 4 * hi);
#pragma unroll
                    for (int j = 0; j < 4; ++j) { const float e = __expf(cv[j]); Z[li][0][4 * q4 + j] *= e; Z[li][1][4 * q4 + j] *= e; } }
        }
#pragma unroll
        for (int li = 0; li < 2; ++li) {
            const int lt = lt_[li]; const float csl = csh[32 * lt + r32];
            for (int st = 0; st <= lt; ++st) {
                f32x16 Xt;
#pragma unroll
                for (int r = 0; r < 16; ++r) Xt[r] = 0.f;
#pragma unroll
                for (int ks = 0; ks < 8; ++ks) {
                    const bf16x8 af = *(const LAS bf16x8*)(L + 32768 + (2 * ks + hi) * 2048 + (32 * st + r32) * 16);
                    const bf16x8 bf = *(const LAS bf16x8*)(L + (2 * ks + hi) * 2048 + (32 * lt + r32) * 16);
                    Xt = __builtin_amdgcn_mfma_f32_32x32x16_bf16(af, bf, Xt, 0, 0, 0);
                }
#pragma unroll
                for (int q4 = 0; q4 < 4; ++q4) { const f32x4 cv = *(const LAS f32x4*)(csh + 32 * st + 8 * q4 + 4 * hi); const f32x4 dv = *(const LAS f32x4*)(dth + 32 * st + 8 * q4 + 4 * hi);
#pragma unroll
                    for (int j = 0; j < 4; ++j) { const int sl = 8 * q4 + 4 * hi + j; const float wgt = (st < lt || sl <= r32) ? __expf(csl - cv[j]) * dv[j] : 0.f; Xt[4 * q4 + j] *= wgt; } }
                v4u pw0, pw1;
                pw0.x = pk2(Xt[0], Xt[1]); pw0.y = pk2(Xt[2], Xt[3]); pw0.z = pk2(Xt[4], Xt[5]); pw0.w = pk2(Xt[6], Xt[7]);
                pw1.x = pk2(Xt[8], Xt[9]); pw1.y = pk2(Xt[10], Xt[11]); pw1.z = pk2(Xt[12], Xt[13]); pw1.w = pk2(Xt[14], Xt[15]);
                const bf16x8 pa0 = __builtin_bit_cast(bf16x8, pw0), pa1 = __builtin_bit_cast(bf16x8, pw1);
                const LAS unsigned char* xi = L + 65536 + hh * 16384;
#pragma unroll
                for (int pt = 0; pt < 2; ++pt) {
                    const bf16x8 v0 = tr_frag(xi + (pt * 8 + 2 * st) * 1024, lo), v1 = tr_frag(xi + (pt * 8 + 2 * st + 1) * 1024, lo);
                    Z[li][pt] = __builtin_amdgcn_mfma_f32_32x32x16_bf16(pa0, v0, Z[li][pt], 0, 0, 0);
                    Z[li][pt] = __builtin_amdgcn_mfma_f32_32x32x16_bf16(pa1, v1, Z[li][pt], 0, 0, 0);
                }
            }
        }
        __syncthreads();
        { const int nxt = item + X.G < 1024 ? item + X.G : item; PC_PREFETCH(nxt); }
        {
            const float dsk = ((const float*)a.in[I_DSKIP])[4 * g + (lane >> 4)];
            const f32x4 gs = *(const f32x4*)((const float*)a.in[I_GSSM] + g * 256 + 4 * lane);
            LAS float* Y = (LAS float*)L;
            const int xh = lane >> 4, xp = 4 * (lane & 15);
            v2u zv16[2][8];
#pragma unroll
            for (int i = 0; i < 8; ++i) zv16[0][i] = *(const v2u*)(PB + (size_t)(row0 + 8 * wave + i) * NPB + PB_Z + g * 256 + 4 * lane);
#pragma unroll
            for (int hb = 0; hb < 2; ++hb) {
#pragma unroll
                for (int pt = 0; pt < 2; ++pt)
#pragma unroll
                    for (int r = 0; r < 16; ++r) Y[(32 * (lt_[hb] & 1) + crow(r, hi)) * 256 + hh * 64 + 32 * pt + r32] = Z[hb][pt][r];
                if (hb == 0) {
#pragma unroll
                    for (int i = 0; i < 8; ++i) zv16[1][i] = *(const v2u*)(PB + (size_t)(row0 + 64 + 8 * wave + i) * NPB + PB_Z + g * 256 + 4 * lane);
                }
                __syncthreads();
#pragma unroll
                for (int i1 = 0; i1 < 8; ++i1) {
                    const int lr = 8 * wave + i1, l = 64 * hb + lr, row = row0 + l;
                    const v2u zv = zv16[hb][i1];
                    const f32x4 y = *(const LAS f32x4*)(Y + lr * 256 + 4 * lane);
                    const v2u xw = *(const LAS v2u*)(L + 65536 + xh * 16384 + ((xp >> 5) * 8 + (l >> 4)) * 1024 + (l & 15) * 64 + (xp & 31) * 2);
                    f32x4 v;
                    { const f32x2 s01 = silu2((f32x2){bflo(zv.x), bfhi(zv.x)}), s23 = silu2((f32x2){bflo(zv.y), bfhi(zv.y)});
                      v.x = (y.x + dsk * bflo(xw.x)) * s01.x; v.y = (y.y + dsk * bfhi(xw.x)) * s01.y; v.z = (y.z + dsk * bflo(xw.y)) * s23.x; v.w = (y.w + dsk * bfhi(xw.y)) * s23.y; }
                    const float ss = wave_sum((v.x * v.x + v.y * v.y) + (v.z * v.z + v.w * v.w));
                    const float rs = rsqrtf(ss * (1.f / 256.f) + EPS);
                    v2u o; o.x = pk2(v.x * rs * gs.x, v.y * rs * gs.y); o.y = pk2(v.z * rs * gs.z, v.w * rs * gs.w);
                    *(v2u*)(OS + (size_t)row * 2048 + g * 256 + 4 * lane) = o;
                }
                __syncthreads();
            }
        }
    }
#undef PC_PREFETCH
}

constexpr int AT_NSLOT = 4, AT_SLOT = 20480, AT_WS = AT_NSLOT * AT_SLOT  , AT_OST = 86016;
#define AT_WAIT_BAR(N) asm volatile("s_waitcnt vmcnt(" #N ") lgkmcnt(0)\n\ts_barrier" ::: "memory")
#define AT_SB() __builtin_amdgcn_sched_barrier(0)
__device__ __forceinline__ void attn_unit(const Ctx& X, int b, int h, int qb, int nqb, bf16x8 (&qn)[6], bool first) {
    unsigned char* ws = X.ws; int lane = X.lane, wave = X.wave; asm volatile("" : "+v"(lane)); asm volatile("" : "+s"(wave));
    const int r32 = lane & 31, hi = lane >> 5;
    const bf16* Q = (const bf16*)(ws + WS_Q); const bf16* KNV = (const bf16*)(ws + WS_KNV); const bf16* KPE = (const bf16*)(ws + WS_KPE); bf16* OA = (bf16*)(ws + WS_OA);
    const size_t rowbase = (size_t)b * SEQ; const int q0 = qb * 256, NT = 4 * (qb + 1);
    LAS unsigned char* L = X.lds; const unsigned lds0 = (unsigned)(uintptr_t)L;
    LAS float* wsf = (LAS float*)(L + AT_WS) + wave * 64;
    const bf16* ksrc = KNV + (rowbase + lane) * 2048 + h * 64 + wave * 8;
    const bf16* rsrc = KPE + (rowbase + lane) * 32 + (wave & 3) * 8;
    const bf16* vsrc = KNV + (rowbase + 16 * (wave & 3) + (lane >> 2)) * 2048 + 1024 + h * 64 + (wave >> 2) * 32 + (lane & 3) * 8;
    const unsigned kdst = lds0 + wave * 1024, rdst = lds0 + (8 + (wave & 3)) * 1024, vdst = lds0 + 12288 + wave * 1024;
#define AT_DMA(t, slot) do { const unsigned so_ = (unsigned)(slot) * AT_SLOT; \
        glds16(ksrc + (size_t)(t) * 64 * 2048, (unsigned)__builtin_amdgcn_readfirstlane(kdst + so_)); \
        glds16(rsrc + (size_t)(t) * 64 * 32, (unsigned)__builtin_amdgcn_readfirstlane(rdst + so_)); \
        glds16(vsrc + (size_t)(t) * 64 * 2048, (unsigned)__builtin_amdgcn_readfirstlane(vdst + so_)); } while (0)
    if (first) { AT_DMA(0, 0); AT_DMA(1, 1); }
    bf16x8 qr[6];
    { const bf16* qp = Q + (rowbase + q0 + wave * 32 + r32) * QW + h * 96 + hi * 8;
#pragma unroll
      for (int d0 = 0; d0 < 6; ++d0) qr[d0] = first ? *(const bf16x8*)(qp + d0 * 16) : qn[d0];
#pragma unroll
      for (int d0 = 0; d0 < 6; ++d0) asm volatile("" : "+v"(qr[d0])); }
    float mhat = 0.f, l_run = 0.f; f32x16 o[2], pC0, pC1, pP0, pP1, negm;
#pragma unroll
    for (int r = 0; r < 16; ++r) { o[0][r] = 0.f; o[1][r] = 0.f; pP0[r] = 0.f; pP1[r] = 0.f; negm[r] = 0.f; }
    const int qrow = q0 + wave * 32 + r32, qmax_w = q0 + wave * 32 + 31;
    const int Tw = (qmax_w >> 6) < NT - 1 ? (qmax_w >> 6) : NT - 1;
    const int lo = tr_lane_off(lane);
    int slot = 0, pslot = 0;
#define AT_KRD(dst0, dst1, Ks_, d0_) do { dst0 = *(const LAS bf16x8*)((Ks_) + (2 * (d0_) + hi) * 1024 + r32 * 16); dst1 = *(const LAS bf16x8*)((Ks_) + (2 * (d0_) + hi) * 1024 + 512 + r32 * 16); } while (0)
#define AT_MASK(C0, C1, t_) do { if (64 * (t_) + 63 > q0 + wave * 32) { const int kb_ = 64 * (t_) + 4 * hi; \
        _Pragma("unroll") for (int r = 0; r < 16; ++r) { const int kv_ = kb_ + (r & 3) + 8 * (r >> 2); if (kv_ > qrow) C0[r] = -INFINITY; if (kv_ + 32 > qrow) C1[r] = -INFINITY; } } } while (0)
#define AT_ROWMAX(C0, C1, rm_) do { asm("v_max_f32 %0, %1, %2" : "=v"(rm_) : "v"(C0[0]), "v"(C1[0]));   \
        _Pragma("unroll") for (int r = 1; r < 16; ++r) asm("v_max3_f32 %0, %0, %1, %2" : "+v"(rm_) : "v"(C0[r]), "v"(C1[r])); rm_ = fmaxf(rm_, __shfl_xor(rm_, 32)); } while (0)
#define AT_SUM8(P_, B_) ((((f32x2){P_[B_], P_[B_ + 1]} + (f32x2){P_[B_ + 2], P_[B_ + 3]})) + (((f32x2){P_[B_ + 4], P_[B_ + 5]} + (f32x2){P_[B_ + 6], P_[B_ + 7]})))
#define AT_PACK(w_, P_, B_) do { w_.x = pk2(P_[B_], P_[B_ + 1]); w_.y = pk2(P_[B_ + 2], P_[B_ + 3]); w_.z = pk2(P_[B_ + 4], P_[B_ + 5]); w_.w = pk2(P_[B_ + 6], P_[B_ + 7]); } while (0)
    for (int t = 0; t < NT; ++t) {
        if (t + 1 < NT) { AT_WAIT_BAR(3); } else { AT_WAIT_BAR(0); }
        if (t + 2 < NT) { const int s2 = (slot + 2) & 3; AT_DMA(t + 2, s2); }
        if (nqb >= 0 && t == NT - 1) { AT_DMA(0, 0); AT_DMA(1, 1); }
        if (t <= Tw) {
            const LAS unsigned char* Ks = L + slot * AT_SLOT;
            if (t == 0) {
                bf16x8 ka0, ka1;
#pragma unroll
                for (int r = 0; r < 16; ++r) { pP0[r] = 0.f; pP1[r] = 0.f; }
#pragma unroll
                for (int d0 = 0; d0 < 6; ++d0) { AT_KRD(ka0, ka1, Ks, d0); pP0 = __builtin_amdgcn_mfma_f32_32x32x16_bf16(ka0, qr[d0], pP0, 0, 0, 0); pP1 = __builtin_amdgcn_mfma_f32_32x32x16_bf16(ka1, qr[d0], pP1, 0, 0, 0); }
                AT_MASK(pP0, pP1, 0);
                float rm; AT_ROWMAX(pP0, pP1, rm);
                mhat = rm;
#pragma unroll
                for (int r = 0; r < 16; ++r) negm[r] = -rm;
#pragma unroll
                for (int r = 0; r < 16; ++r) { pP0[r] = __builtin_amdgcn_exp2f(pP0[r] - rm); pP1[r] = __builtin_amdgcn_exp2f(pP1[r] - rm); }
            } else {
                const LAS unsigned char* Vp = L + pslot * AT_SLOT + 12288;
                bf16x8 ka0, ka1, kb0, kb1, va0, va1, vb0, vb1; v4u pw0, pw1, pw2, pw3; f32x2 sacc2;
                AT_KRD(ka0, ka1, Ks, 0); AT_KRD(kb0, kb1, Ks, 1); AT_SB();
                pC0 = __builtin_amdgcn_mfma_f32_32x32x16_bf16(ka0, qr[0], negm, 0, 0, 0); pC1 = __builtin_amdgcn_mfma_f32_32x32x16_bf16(ka1, qr[0], negm, 0, 0, 0);
                AT_KRD(ka0, ka1, Ks, 2);
                sacc2 = AT_SUM8(pP0, 0); AT_PACK(pw0, pP0, 0); AT_SB();
                pC0 = __builtin_amdgcn_mfma_f32_32x32x16_bf16(kb0, qr[1], pC0, 0, 0, 0); pC1 = __builtin_amdgcn_mfma_f32_32x32x16_bf16(kb1, qr[1], pC1, 0, 0, 0);
                AT_KRD(kb0, kb1, Ks, 3);
                sacc2 += AT_SUM8(pP0, 8); AT_PACK(pw1, pP0, 8); AT_SB();
                pC0 = __builtin_amdgcn_mfma_f32_32x32x16_bf16(ka0, qr[2], pC0, 0, 0, 0); pC1 = __builtin_amdgcn_mfma_f32_32x32x16_bf16(ka1, qr[2], pC1, 0, 0, 0);
                AT_KRD(ka0, ka1, Ks, 4);
                sacc2 += AT_SUM8(pP1, 0); AT_PACK(pw2, pP1, 0); AT_SB();
                pC0 = __builtin_amdgcn_mfma_f32_32x32x16_bf16(kb0, qr[3], pC0, 0, 0, 0); pC1 = __builtin_amdgcn_mfma_f32_32x32x16_bf16(kb1, qr[3], pC1, 0, 0, 0);
                AT_KRD(kb0, kb1, Ks, 5);
                sacc2 += AT_SUM8(pP1, 8); AT_PACK(pw3, pP1, 8); AT_SB();
                pC0 = __builtin_amdgcn_mfma_f32_32x32x16_bf16(ka0, qr[4], pC0, 0, 0, 0); pC1 = __builtin_amdgcn_mfma_f32_32x32x16_bf16(ka1, qr[4], pC1, 0, 0, 0);
                pC0 = __builtin_amdgcn_mfma_f32_32x32x16_bf16(kb0, qr[5], pC0, 0, 0, 0); pC1 = __builtin_amdgcn_mfma_f32_32x32x16_bf16(kb1, qr[5], pC1, 0, 0, 0);
                l_run += sacc2.x + sacc2.y;
                AT_MASK(pC0, pC1, t);
                float rm; AT_ROWMAX(pC0, pC1, rm);
                bool resc = false;
                if (__any(rm > 0.f)) {
                    const float dl = fmaxf(rm, 0.f); mhat += dl;
#pragma unroll
                    for (int r = 0; r < 16; ++r) negm[r] -= dl;
#pragma unroll
                    for (int r = 0; r < 16; ++r) { pC0[r] -= dl; pC1[r] -= dl; }
                    const float f = __builtin_amdgcn_exp2f(-dl); l_run *= f; if (hi == 0) wsf[r32] = f; resc = true;
                }
                AT_SB();
#define AT_EX4(C_, B_) do { C_[B_] = __builtin_amdgcn_exp2f(C_[B_]); C_[B_ + 1] = __builtin_amdgcn_exp2f(C_[B_ + 1]); C_[B_ + 2] = __builtin_amdgcn_exp2f(C_[B_ + 2]); C_[B_ + 3] = __builtin_amdgcn_exp2f(C_[B_ + 3]); } while (0)
                va0 = tr_frag(Vp, lo); va1 = tr_frag(Vp + 4096, lo); vb0 = tr_frag(Vp + 1024, lo); vb1 = tr_frag(Vp + 4096 + 1024, lo); AT_SB();
                o[0] = __builtin_amdgcn_mfma_f32_32x32x16_bf16(__builtin_bit_cast(bf16x8, pw0), va0, o[0], 0, 0, 0); AT_EX4(pC0, 0); AT_SB();
                o[1] = __builtin_amdgcn_mfma_f32_32x32x16_bf16(__builtin_bit_cast(bf16x8, pw0), va1, o[1], 0, 0, 0); AT_EX4(pC0, 4); va0 = tr_frag(Vp + 2048, lo); va1 = tr_frag(Vp + 4096 + 2048, lo); AT_SB();
                o[0] = __builtin_amdgcn_mfma_f32_32x32x16_bf16(__builtin_bit_cast(bf16x8, pw1), vb0, o[0], 0, 0, 0); AT_EX4(pC0, 8); AT_SB();
                o[1] = __builtin_amdgcn_mfma_f32_32x32x16_bf16(__builtin_bit_cast(bf16x8, pw1), vb1, o[1], 0, 0, 0); AT_EX4(pC0, 12); vb0 = tr_frag(Vp + 3072, lo); vb1 = tr_frag(Vp + 4096 + 3072, lo); AT_SB();
                o[0] = __builtin_amdgcn_mfma_f32_32x32x16_bf16(__builtin_bit_cast(bf16x8, pw2), va0, o[0], 0, 0, 0); AT_EX4(pC1, 0); AT_SB();
                o[1] = __builtin_amdgcn_mfma_f32_32x32x16_bf16(__builtin_bit_cast(bf16x8, pw2), va1, o[1], 0, 0, 0); AT_EX4(pC1, 4); AT_SB();
                o[0] = __builtin_amdgcn_mfma_f32_32x32x16_bf16(__builtin_bit_cast(bf16x8, pw3), vb0, o[0], 0, 0, 0); AT_EX4(pC1, 8); AT_SB();
                o[1] = __builtin_amdgcn_mfma_f32_32x32x16_bf16(__builtin_bit_cast(bf16x8, pw3), vb1, o[1], 0, 0, 0); AT_EX4(pC1, 12); AT_SB();
#undef AT_EX4
                if (resc) {
                    LDS_WAIT();
#pragma unroll
                    for (int q4 = 0; q4 < 4; ++q4) { const f32x4 av = *(const LAS f32x4*)(wsf + 8 * q4 + 4 * hi);
#pragma unroll
                        for (int j = 0; j < 4; ++j) { o[0][4 * q4 + j] *= av[j]; o[1][4 * q4 + j] *= av[j]; } }
                }
                pP0 = pC0; pP1 = pC1;
            }
            if (t == Tw) {
                const LAS unsigned char* Vs = Ks + 12288;
                float sacc = 0.f;
#pragma unroll
                for (int r = 0; r < 16; ++r) sacc += pP0[r] + pP1[r];
                l_run += sacc;
                v4u pw[4]; AT_PACK(pw[0], pP0, 0); AT_PACK(pw[1], pP0, 8); AT_PACK(pw[2], pP1, 0); AT_PACK(pw[3], pP1, 8);
#pragma unroll
                for (int ks = 0; ks < 4; ++ks) {
                    const bf16x8 pa = __builtin_bit_cast(bf16x8, pw[ks]);
                    const bf16x8 v0 = tr_frag(Vs + ks * 1024, lo), v1 = tr_frag(Vs + 4096 + ks * 1024, lo);
                    o[0] = __builtin_amdgcn_mfma_f32_32x32x16_bf16(pa, v0, o[0], 0, 0, 0); o[1] = __builtin_amdgcn_mfma_f32_32x32x16_bf16(pa, v1, o[1], 0, 0, 0);
                }
            }
        }
        pslot = slot; slot = (slot + 1) & 3;
    }
    if (nqb >= 0) { const bf16* qp = Q + (rowbase + nqb * 256 + wave * 32 + r32) * QW + h * 96 + hi * 8;
#pragma unroll
      for (int d0 = 0; d0 < 6; ++d0) qn[d0] = *(const bf16x8*)(qp + d0 * 16); }
    l_run += __shfl_xor(l_run, 32);
    if (hi == 0) wsf[32 + r32] = l_run;
    LDS_WAIT();
    {
        LAS bf16* stg = (LAS bf16*)(L + AT_OST + wave * 4096);
#pragma unroll
        for (int q4 = 0; q4 < 4; ++q4) { const f32x4 lv = *(const LAS f32x4*)(wsf + 32 + 8 * q4 + 4 * hi);
#pragma unroll
            for (int j = 0; j < 4; ++j) { const float inv = __builtin_amdgcn_rcpf(lv[j]); const int orow = 8 * q4 + 4 * hi + j;
                stg[orow * 64 + r32] = (bf16)(pk2(o[0][4 * q4 + j] * inv, 0.f) & 0xffffu); stg[orow * 64 + 32 + r32] = (bf16)(pk2(o[1][4 * q4 + j] * inv, 0.f) & 0xffffu); } }
        LDS_WAIT();
        bf16* Ow = OA + (rowbase + q0 + wave * 32) * 1024 + h * 64;
#pragma unroll
        for (int i = 0; i < 4; ++i) { const int row = i * 8 + (lane >> 3), ch = lane & 7; const v4u v = *(const LAS v4u*)(stg + row * 64 + ch * 8); *(v4u*)(Ow + (size_t)row * 1024 + ch * 8) = v; }
    }
    if (nqb < 0) { AT_WAIT_BAR(0); }
#undef AT_DMA
#undef AT_KRD
#undef AT_MASK
#undef AT_ROWMAX
#undef AT_PACK
}
constexpr int PART_STRIDE = 4096 + 32;
__device__ __forceinline__ void decode_unit(const Ctx& X, const Args& a, int unit) {
    unsigned char* ws = X.ws; int lane = X.lane, tid = X.tid, wave = X.wave; asm volatile("" : "+v"(lane)); asm volatile("" : "+v"(tid)); asm volatile("" : "+s"(wave));
    const int b = unit >> 1, sp = unit & 1;
    const bf16* Q = (const bf16*)(ws + WS_Q) + (size_t)(MPR + b) * QW;
    LAS unsigned char* L = X.lds;
    LAS float* qf = (LAS float*)L;
    LAS bf16* Qp = (LAS bf16*)(L + 8192);
    float* QL = (float*)(ws + WS_QL) + (size_t)b * 16 * 288;
    const int* pt = (const int*)a.in[I_PT] + b * NPAGES + 32 * sp + 4 * wave;
    int pages[4];
#pragma unroll
    for (int i = 0; i < 4; ++i) pages[i] = pt[i];
    { bf16 q3[3];
#pragma unroll
      for (int i = 0; i < 3; ++i) q3[i] = Q[tid + 512 * i];
#pragma unroll
      for (int i = 0; i < 3; ++i) qf[tid + 512 * i] = bf1(q3[i]); }
    __syncthreads();
    {
        const int h = tid >> 5, r8 = (tid & 31) * 8; const bf16* wt = (const bf16*)(ws + WS_WUKV) + (size_t)(h * 64) * 256 + r8;
        float acc8[8];
#pragma unroll
        for (int j = 0; j < 8; ++j) acc8[j] = 0.f;
#pragma unroll 1
        for (int d0 = 0; d0 < 64; d0 += 16) {
            v4u wv[16];
#pragma unroll
            for (int d = 0; d < 16; ++d) wv[d] = *(const v4u*)(wt + (size_t)(d0 + d) * 256);
#pragma unroll
            for (int d = 0; d < 16; ++d) { const float q = qf[h * 96 + d0 + d]; float w[8]; unpack8(wv[d], w);
#pragma unroll
                for (int j = 0; j < 8; ++j) acc8[j] += q * w[j]; }
        }
#pragma unroll
        for (int j = 0; j < 8; ++j) { Qp[h * 288 + r8 + j] = (bf16)(pk2(acc8[j], 0.f) & 0xffffu); if (sp == 0) QL[h * 288 + r8 + j] = acc8[j]; }
        if (tid < 256) { const int hh = tid >> 4, i = tid & 15; const float x1 = qf[hh * 96 + 64 + 2 * i], x2 = qf[hh * 96 + 64 + 2 * i + 1];
            Qp[hh * 288 + 256 + i] = (bf16)(pk2(x1, 0.f) & 0xffffu); Qp[hh * 288 + 272 + i] = (bf16)(pk2(x2, 0.f) & 0xffffu);
            if (sp == 0) { QL[hh * 288 + 256 + i] = x1; QL[hh * 288 + 272 + i] = x2; } }
    }
    __syncthreads();
    const int kl = lane & 15, kq = lane >> 4;
    const LAS bf16* qfp = Qp + kl * 288 + 8 * kq;
    LAS unsigned char* Vt = L + 32768 + wave * 9216;
    f32x4 acc[16];
#pragma unroll
    for (int nb = 0; nb < 16; ++nb) acc[nb] = (f32x4){0.f, 0.f, 0.f, 0.f};
    float m_run = -INFINITY, l_run = 0.f;
    const float* ckv = (const float*)a.in[I_CKV]; const float* cpe = (const float*)a.in[I_CPE];
    const int vwoff = (lane >> 3) * 1024 + (lane & 7) * 8, vroff = (4 * kq + (kl >> 2)) * 64 + (kl & 3) * 8, kroff = kl * 64 + kq * 16;
#pragma unroll
    for (int i = 0; i < 4; ++i) pages[i] = __builtin_amdgcn_readfirstlane(pages[i]);
    f32x4 raw[18];
#define DC_ISSUE(blk_) do { const int pg_ = (blk_) >> 3; const int page_ = pg_ == 0 ? pages[0] : pg_ == 1 ? pages[1] : pg_ == 2 ? pages[2] : pages[3]; \
        const float* kp_ = ckv + ((size_t)page_ * PAGE + ((blk_) & 7) * 16) * 256 + 4 * lane; const float* pp_ = cpe + ((size_t)page_ * PAGE + ((blk_) & 7) * 16) * 32 + 4 * lane; \
        _Pragma("unroll") for (int r = 0; r < 16; ++r) raw[r] = __builtin_nontemporal_load((const f32x4*)(kp_ + r * 256)); \
        raw[16] = __builtin_nontemporal_load((const f32x4*)pp_); raw[17] = __builtin_nontemporal_load((const f32x4*)(pp_ + 256)); } while (0)
    DC_ISSUE(0);
    for (int blk = 0; blk < 32; ++blk) {
#pragma unroll
        for (int r = 0; r < 16; ++r) { v2u w; w.x = pk2(raw[r].x, raw[r].y); w.y = pk2(raw[r].z, raw[r].w); *(LAS v2u*)(Vt + vwoff + r * 64) = w; }
        { v2u w; w.x = pk2(raw[16].x, raw[16].y); w.y = pk2(raw[16].z, raw[16].w); *(LAS v2u*)(Vt + 8192 + (lane >> 3) * 64 + (lane & 7) * 8) = w;
          w.x = pk2(raw[17].x, raw[17].y); w.y = pk2(raw[17].z, raw[17].w); *(LAS v2u*)(Vt + 8192 + 512 + (lane >> 3) * 64 + (lane & 7) * 8) = w; }
        asm volatile("" ::: "memory");
        if (blk + 1 < 32) DC_ISSUE(blk + 1);
        asm volatile("" ::: "memory");
        f32x4 st = (f32x4){0.f, 0.f, 0.f, 0.f};
#pragma unroll
        for (int ks = 0; ks < 9; ++ks) st = __builtin_amdgcn_mfma_f32_16x16x32_bf16(*(const LAS bf16x8*)(Vt + ks * 1024 + kroff), *(const LAS bf16x8*)(qfp + 32 * ks), st, 0, 0, 0);
        float bm = fmaxf(fmaxf(st[0], st[1]), fmaxf(st[2], st[3]));
        bm = fmaxf(bm, __shfl_xor(bm, 16)); bm = fmaxf(bm, __shfl_xor(bm, 32));
        const float m_new = fmaxf(m_run, bm);
        if (__any(m_new > m_run)) { const float al = __builtin_amdgcn_exp2f(m_run - m_new); l_run *= al;
#pragma unroll
            for (int nb = 0; nb < 16; ++nb) acc[nb] = acc[nb] * al;
            m_run = m_new; }
        f32x4 p; p.x = __builtin_amdgcn_exp2f(st[0] - m_run); p.y = __builtin_amdgcn_exp2f(st[1] - m_run); p.z = __builtin_amdgcn_exp2f(st[2] - m_run); p.w = __builtin_amdgcn_exp2f(st[3] - m_run);
        l_run += (p.x + p.y) + (p.z + p.w);
        v2u pw; pw.x = pk2(p.x, p.y); pw.y = pk2(p.z, p.w); const bf16x4 pf = __builtin_bit_cast(bf16x4, pw);
#pragma unroll
        for (int nb = 0; nb < 16; ++nb) { const bf16x4 vf = vtr(Vt + (nb >> 1) * 1024 + vroff + (nb & 1) * 32);
            acc[nb] = __builtin_amdgcn_mfma_f32_16x16x16bf16_1k(vf, pf, acc[nb], 0, 0, 0); }
        asm volatile("" ::: "memory");
    }
#undef DC_ISSUE
    l_run += __shfl_xor(l_run, 16); l_run += __shfl_xor(l_run, 32);
    LAS float* mw = (LAS float*)(X.lds + EXTRA_OFF); LAS float* lw = mw + 128;
    if (lane < 16) { mw[wave * 16 + lane] = m_run; lw[wave * 16 + lane] = l_run; }
    __syncthreads();
    float M = mw[kl];
#pragma unroll
    for (int w = 1; w < 8; ++w) M = fmaxf(M, mw[w * 16 + kl]);
    const float sc = __builtin_amdgcn_exp2f(m_run - M);
    LAS float* Ow = (LAS float*)L + wave * 4096;
#pragma unroll
    for (int nb = 0; nb < 16; ++nb)
#pragma unroll
        for (int r = 0; r < 4; ++r) Ow[(16 * nb + 4 * kq + r) * 16 + kl] = acc[nb][r] * sc;
    __syncthreads();
    float* P = (float*)(ws + WS_PART) + (size_t)(b * 2 + sp) * PART_STRIDE;
#pragma unroll
    for (int i = 0; i < 8; ++i) { const int e = tid + 512 * i; float s = 0.f;
#pragma unroll
        for (int w = 0; w < 8; ++w) s += ((LAS float*)L)[w * 4096 + e];
        P[32 + (e & 15) * 256 + (e >> 4)] = s; }
    if (tid < 16) { float Mh = mw[tid];
#pragma unroll
        for (int w = 1; w < 8; ++w) Mh = fmaxf(Mh, mw[w * 16 + tid]);
        float Ls = 0.f;
#pragma unroll
        for (int w = 0; w < 8; ++w) Ls += lw[w * 16 + tid] * __builtin_amdgcn_exp2f(mw[w * 16 + tid] - Mh);
        P[tid] = Mh; P[16 + tid] = Ls; }
    __syncthreads();
}

__device__ __forceinline__ void decode_combine(const Ctx& X, const Args& a, int unit) {
    unsigned char* ws = X.ws; const int lane = X.lane, tid = X.tid, wave = X.wave, b = unit >> 1, h = 8 * (unit & 1) + wave;
    const float* P0 = (const float*)(ws + WS_PART) + (size_t)(b * 2) * PART_STRIDE; const float* P1 = P0 + PART_STRIDE;
    const float* QL = (const float*)(ws + WS_QL) + (size_t)b * 16 * 288 + h * 288;
    const float* ck = X.out + O_KVS + (size_t)b * 256; const float* kr = X.out + O_KRS + (size_t)b * 32;
    LAS float* ol = (LAS float*)X.lds + wave * 256;
    float s = 0.f;
#pragma unroll
    for (int j = 0; j < 4; ++j) s += QL[lane + 64 * j] * ck[lane + 64 * j];
    if (lane < 32) s += QL[256 + lane] * kr[lane];
    s = wave_sum(s);
    const float m0 = P0[h], m1 = P1[h], M = fmaxf(fmaxf(m0, m1), s);
    const float e0 = __builtin_amdgcn_exp2f(m0 - M), e1 = __builtin_amdgcn_exp2f(m1 - M), en = __builtin_amdgcn_exp2f(s - M);
    const float inv = 1.0f / (P0[16 + h] * e0 + P1[16 + h] * e1 + en);
    const float w0 = e0 * inv, w1 = e1 * inv, wn = en * inv;
#pragma unroll
    for (int j = 0; j < 4; ++j) { const int r = lane + 64 * j; ol[r] = P0[32 + h * 256 + r] * w0 + P1[32 + h * 256 + r] * w1 + ck[r] * wn; }
    LDS_WAIT(); asm volatile("" ::: "memory");
    const float* wp = (const float*)a.in[I_WUV] + h * 64 + lane; float o = 0.f;
#pragma unroll 1
    for (int r0 = 0; r0 < 256; r0 += 32) { float wv[32];
#pragma unroll
        for (int r = 0; r < 32; ++r) wv[r] = wp[(size_t)(r0 + r) * 1024];
#pragma unroll
        for (int r = 0; r < 32; ++r) o += ol[r0 + r] * wv[r]; }
    ((bf16*)(ws + WS_OA))[(size_t)(MPR + b) * 1024 + h * 64 + lane] = (bf16)(pk2(o, 0.f) & 0xffffu);
    LDS_WAIT(); asm volatile("" ::: "memory");
}

__device__ __forceinline__ void smp_ssm_item(const Ctx& X, const Args& a, int item) {
    unsigned char* ws = X.ws; const int lane = X.lane, wave = X.wave, g = item & 7, b = item >> 3, row = MPR + b;
    const bf16* XBC = (const bf16*)(ws + WS_XBC) + (size_t)row * 4096; const bf16* PB = (const bf16*)(ws + WS_PB) + (size_t)row * NPB;
    const int hh = wave >> 1, ph = wave & 1, h = 4 * g + hh, n4 = 4 * (lane & 31), prow = lane >> 5;
    const float dt = ((const float*)(ws + WS_DT))[(size_t)row * 32 + h], dA = __expf(-__expf(((const float*)a.in[I_ALOG])[h]) * dt);
    const v2u bw = *(const v2u*)(XBC + 2048 + g * 128 + n4), cw = *(const v2u*)(XBC + 3072 + g * 128 + n4);
    const f32x4 Bv = (f32x4){bflo(bw.x), bfhi(bw.x), bflo(bw.y), bfhi(bw.y)}, Cv = (f32x4){bflo(cw.x), bfhi(cw.x), bflo(cw.y), bfhi(cw.y)};
    const float* sin_ = (const float*)a.in[I_SSM] + (size_t)((b * 32 + h) * 64) * 128 + n4; float* sout = X.out + O_SSS + (size_t)((b * 32 + h) * 64) * 128 + n4;
    LAS float* ys = (LAS float*)(X.lds + EXTRA_OFF);
    const float dsk = ((const float*)a.in[I_DSKIP])[4 * g + (lane >> 4)]; const f32x4 gs = *(const f32x4*)((const float*)a.in[I_GSSM] + g * 256 + 4 * lane);
    const v2u xw = *(const v2u*)(XBC + g * 256 + 4 * lane), zw = *(const v2u*)(PB + PB_Z + g * 256 + 4 * lane);
    f32x4 st[16]; bf16 xr[16];
#pragma unroll
    for (int i = 0; i < 16; ++i) { st[i] = __builtin_nontemporal_load((const f32x4*)(sin_ + (size_t)(32 * ph + 2 * i + prow) * 128)); xr[i] = XBC[h * 64 + 32 * ph + 2 * i + prow]; }
#pragma unroll
    for (int i = 0; i < 16; ++i) { const int p = 32 * ph + 2 * i + prow; const float xv = bf1(xr[i]) * dt;
        const f32x4 nw = st[i] * dA + Bv * xv; __builtin_nontemporal_store(nw, (f32x4*)(sout + (size_t)p * 128));
        float part = (nw.x * Cv.x + nw.y * Cv.y) + (nw.z * Cv.z + nw.w * Cv.w);
#pragma unroll
        for (int o = 1; o < 32; o <<= 1) part += __shfl_xor(part, o);
        if ((lane & 31) == 0) ys[hh * 64 + p] = part; }
    __syncthreads();
    if (wave == 0) {
        const f32x4 y = *(const LAS f32x4*)(ys + 4 * lane);
        f32x4 v;
        v.x = (y.x + dsk * bflo(xw.x)) * silu(bflo(zw.x)); v.y = (y.y + dsk * bfhi(xw.x)) * silu(bfhi(zw.x));
        v.z = (y.z + dsk * bflo(xw.y)) * silu(bflo(zw.y)); v.w = (y.w + dsk * bfhi(xw.y)) * silu(bfhi(zw.y));
        const float ss = wave_sum((v.x * v.x + v.y * v.y) + (v.z * v.z + v.w * v.w)); const float rs = rsqrtf(ss * (1.f / 256.f) + EPS);
        v2u o; o.x = pk2(v.x * rs * gs.x, v.y * rs * gs.y); o.y = pk2(v.z * rs * gs.z, v.w * rs * gs.w);
        *(v2u*)((bf16*)(ws + WS_OS) + (size_t)row * 2048 + g * 256 + 4 * lane) = o;
    }
    __syncthreads();
}

__device__ __forceinline__ void ph_norm1(const Ctx& X, const Args& a) {
    unsigned char* ws = X.ws; const bf16* MIX = (const bf16*)(ws + WS_MIX); bf16* X1 = (bf16*)(ws + WS_X1); bf16* XN = (bf16*)(ws + WS_XN);
    const GAS f32x4* g1p = (const GAS f32x4*)a.in[I_GPOSTMIX] + X.lane; const GAS f32x4* g2p = (const GAS f32x4*)a.in[I_GPREMLP] + X.lane; f32x4 g1[4], g2[4];
#pragma unroll
    for (int j = 0; j < 4; ++j) { g1[j] = g1p[64 * j]; g2[j] = g2p[64 * j]; }
    for (int m0 = X.gw; m0 < MR; m0 += 2 * X.NGW) {
        int mm[2]; mm[0] = m0; mm[1] = m0 + X.NGW < MR ? m0 + X.NGW : m0;
        f32x4 v[2][4], x[2][4];
#pragma unroll
        for (int q = 0; q < 2; ++q) { const int m = mm[q];
            const float* xrow = m < MPR ? (const float*)a.in[I_XP] + (size_t)m * DM : (const float*)a.in[I_XS] + (size_t)(m - MPR) * DM;
            const GAS f32x4* xr = (const GAS f32x4*)xrow + X.lane; const GAS v2u* mr = (const GAS v2u*)(MIX + (size_t)m * DM) + X.lane;
#pragma unroll
            for (int j = 0; j < 4; ++j) { const v2u mw = mr[64 * j]; v[q][j] = (f32x4){bflo(mw.x), bfhi(mw.x), bflo(mw.y), bfhi(mw.y)}; x[q][j] = xr[64 * j]; } }
#pragma unroll
        for (int q = 0; q < 2; ++q) { const int m = mm[q]; float s = 0.f;
#pragma unroll
            for (int j = 0; j < 4; ++j) s += (v[q][j].x * v[q][j].x + v[q][j].y * v[q][j].y) + (v[q][j].z * v[q][j].z + v[q][j].w * v[q][j].w);
            const float rs = rsqrtf(wave_sum(s) * (1.f / DM) + EPS); float s2 = 0.f;
#pragma unroll
            for (int j = 0; j < 4; ++j) { x[q][j] = x[q][j] + v[q][j] * rs * g1[j]; s2 += (x[q][j].x * x[q][j].x + x[q][j].y * x[q][j].y) + (x[q][j].z * x[q][j].z + x[q][j].w * x[q][j].w); }
            const float rs2 = rsqrtf(wave_sum(s2) * (1.f / DM) + EPS);
            GAS unsigned long long* o4 = (GAS unsigned long long*)(X1 + (size_t)m * DM) + X.lane; GAS unsigned long long* o8 = (GAS unsigned long long*)(XN + (size_t)m * DM) + X.lane;
#pragma unroll
            for (int j = 0; j < 4; ++j) { o4[64 * j] = (unsigned long long)pk2(x[q][j].x, x[q][j].y) | ((unsigned long long)pk2(x[q][j].z, x[q][j].w) << 32); const f32x4 t = x[q][j] * rs2 * g2[j]; o8[64 * j] = (unsigned long long)pk2(t.x, t.y) | ((unsigned long long)pk2(t.z, t.w) << 32); }
        }
    }
}
__device__ __forceinline__ void ph_norm2(const Ctx& X, const Args& a) {
    unsigned char* ws = X.ws; const bf16* Fb = (const bf16*)(ws + WS_F); const bf16* X1 = (const bf16*)(ws + WS_X1);
    const GAS f32x4* gp = (const GAS f32x4*)a.in[I_GPOSTMLP] + X.lane; f32x4 g[4];
#pragma unroll
    for (int j = 0; j < 4; ++j) g[j] = gp[64 * j];
    for (int m0 = X.gw; m0 < MR; m0 += 2 * X.NGW) {
        int mm[2]; mm[0] = m0; mm[1] = m0 + X.NGW < MR ? m0 + X.NGW : m0;
        f32x4 v[2][4], x[2][4];
#pragma unroll
        for (int q = 0; q < 2; ++q) { const int m = mm[q];
            const GAS v2u* fr = (const GAS v2u*)(Fb + (size_t)m * DM) + X.lane; const GAS v2u* xr = (const GAS v2u*)(X1 + (size_t)m * DM) + X.lane;
#pragma unroll
            for (int j = 0; j < 4; ++j) { const v2u fw = fr[64 * j]; v[q][j] = (f32x4){bflo(fw.x), bfhi(fw.x), bflo(fw.y), bfhi(fw.y)}; const v2u xw = xr[64 * j]; x[q][j] = (f32x4){bflo(xw.x), bfhi(xw.x), bflo(xw.y), bfhi(xw.y)}; } }
#pragma unroll
        for (int q = 0; q < 2; ++q) { const int m = mm[q]; float s = 0.f;
#pragma unroll
            for (int j = 0; j < 4; ++j) s += (v[q][j].x * v[q][j].x + v[q][j].y * v[q][j].y) + (v[q][j].z * v[q][j].z + v[q][j].w * v[q][j].w);
            const float rs = rsqrtf(wave_sum(s) * (1.f / DM) + EPS);
            float* orow = m < MPR ? X.out + O_YP + (size_t)m * DM : X.out + O_YS + (size_t)(m - MPR) * DM;
            GAS f32x4* o4 = (GAS f32x4*)orow + X.lane;
#pragma unroll
            for (int j = 0; j < 4; ++j) o4[64 * j] = x[q][j] + v[q][j] * rs * g[j];
        }
    }
}

#ifndef MK_N_LAUNCHES
#define MK_N_LAUNCHES 1
#endif
constexpr int N_PHASES = 12;
constexpr int N_LAUNCHES = MK_N_LAUNCHES;
static_assert(N_LAUNCHES == 1 || N_LAUNCHES == N_PHASES, "MK_N_LAUNCHES is 1 or 12");

__global__ void __launch_bounds__(NWAVES * 64, 2) fwd_kernel(Args args) {
    extern __shared__ __attribute__((aligned(16))) unsigned char lds[];
    Ctx X;
    X.lds = (LAS unsigned char*)lds; X.tid = threadIdx.x; X.lane = X.tid & 63; X.wave = __builtin_amdgcn_readfirstlane(X.tid >> 6);
    X.G = gridDim.x; { const int bx = blockIdx.x; X.vcu = (X.G % 8 == 0) ? (bx % 8) * (X.G / 8) + bx / 8 : bx; }
    X.gw = X.vcu * NWAVES + X.wave; X.NGW = X.G * NWAVES; X.ws = args.ws; X.out = args.out;
    unsigned char* ws = args.ws;
    gu32* ctl = (gu32*)(ws + WS_CTL);
    volatile LAS unsigned* MISC = (volatile LAS unsigned*)(X.lds + MISC_OFF);
    for (int u = X.tid; u < (LDS_BYTES - LDSCTL_OFF) / 4; u += NWAVES * 64) ((LAS unsigned*)(X.lds + LDSCTL_OFF))[u] = 0u;
    __syncthreads();
    XcdBarrier bar; bar.bar = (unsigned*)(ctl + CW_BAR); bar.x = 0; bar.st = nullptr;
    if (N_LAUNCHES == 1) bar = xcd_barrier_post((unsigned*)(ctl + CW_BAR), MISC + 8);
#define GRID_BAR() do { if (N_LAUNCHES == 1) xcd_barrier(bar); } while (0)
    const int lo = args.ph_lo, hi = args.ph_hi;
#ifndef PH_MASK
#define PH_MASK 0xFFF
#endif
#define IN(k) (((PH_MASK >> (k)) & 1) && lo <= (k) && (k) < hi)
#define BOTH(k) (IN(k) && IN((k) + 1))
    const pg8::bf16_t* XN = (const pg8::bf16_t*)(ws + WS_XN);
    const int cb = (int)blockIdx.x;

    if (IN(0)) { ph0_prologue(X, args, 0); if (BOTH(0)) GRID_BAR(); }

    if (IN(1)) {
        pg8::Gemm g{XN, (const pg8::bf16_t*)(ws + WS_WIN), MP, NIN, 1024, 1024, 1024}; pg8::StaticOrder S; S.init(MP, NIN, X.G, cb);
        pg8::Epi<pg8::EM_P1> E{(void*)(ws + WS_PF), NPF, (void*)(ws + WS_PB), NPB, nullptr, 0, nullptr};
        const int grpW = X.vcu >= (X.G >> 1) ? 1 : 0;
        if (grpW == 0) { ph0_prologue(X, args, 1); __syncthreads(); }
        pg8::gemm_phase<pg8::Epi<pg8::EM_P1>, pg8::StaticOrder, true, true>(X.lds + RING_OFF, g, S, E);
        if (grpW != 0) { ph0_prologue(X, args, 1); }
        if (BOTH(1)) GRID_BAR();
    }
    if (IN(2)) { ph2_token(X, args); if (BOTH(2)) GRID_BAR(); }

    if (IN(3)) {
        const int grp3 = (X.vcu >> 1) & 1;
        if (grp3 == 0) { for (int it = X.vcu; it < 1024; it += X.G) smp_ssm_item(X, args, it); }
        { pg8::Gemm g{(const pg8::bf16_t*)(ws + WS_CQ), (const pg8::bf16_t*)(ws + WS_WUQ), MP, QW, 384, 384, 384}; pg8::StaticOrder S; S.init(MP, QW, X.G, cb);
          pg8::Epi<pg8::EM_Q> E{(void*)(ws + WS_Q), QW, nullptr, 0, nullptr, 0, (const float*)(ws + WS_TAB)};
          pg8::gemm_phase<pg8::Epi<pg8::EM_Q>, pg8::StaticOrder, true, true>(X.lds + RING_OFF, g, S, E); }
        { pg8::Gemm g{(const pg8::bf16_t*)(ws + WS_CKV), (const pg8::bf16_t*)(ws + WS_WUKV), MPR, 2048, 256, 256, 256}; pg8::StaticOrder S; S.init(MPR, 2048, X.G, cb);
          pg8::Epi<pg8::EM_BF16> E{(void*)(ws + WS_KNV), 2048, nullptr, 0, nullptr, 0, nullptr};
          pg8::gemm_phase<pg8::Epi<pg8::EM_BF16>, pg8::StaticOrder, true, true>(X.lds + RING_OFF, g, S, E); }
        ssd_passA_all(X, args);
        if (grp3 != 0) { for (int it = X.vcu; it < 1024; it += X.G) smp_ssm_item(X, args, it); }
        if (BOTH(3)) GRID_BAR();
    }
    if (IN(4)) {
        const int grp = (X.vcu >> 1) & 1;
        if (grp == 0) { for (int u = X.vcu; u < 256; u += X.G) decode_unit(X, args, u); }
        for (int j = X.vcu; j < 256; j += X.G) {
            const int bh = j >> 1, b = bh >> 4, h = bh & 15;
            bf16x8 qn[6];
            if (j & 1) { attn_unit(X, b, h, 5, 4, qn, true); attn_unit(X, b, h, 4, 3, qn, false); attn_unit(X, b, h, 3, 2, qn, false); attn_unit(X, b, h, 2, -1, qn, false); }
            else       { attn_unit(X, b, h, 7, 6, qn, true); attn_unit(X, b, h, 6, 1, qn, false); attn_unit(X, b, h, 1, 0, qn, false); attn_unit(X, b, h, 0, -1, qn, false); }
        }
        ssd_passB(X);
        if (grp != 0) { for (int u = X.vcu; u < 256; u += X.G) decode_unit(X, args, u); }
        if (BOTH(4)) GRID_BAR();
    }
    if (IN(5)) {
        const int grp5 = (X.vcu >> 1) & 1;
        pg8::Epi<pg8::EM_G1> E1{(void*)(ws + WS_MG1), 1024, nullptr, 0, (const pg8::bf16_t*)(ws + WS_PB) + PB_GA, NPB, nullptr};
        if (grp5 == 0) {
            { pg8::Gemm g{(const pg8::bf16_t*)(ws + WS_OA), (const pg8::bf16_t*)(ws + WS_WBRA), MPR, 1024, 1024, 1024, 1024}; pg8::StaticOrder S; S.init(MPR, 1024, X.G, cb);
              pg8::gemm_phase<pg8::Epi<pg8::EM_G1>, pg8::StaticOrder, false, true>(X.lds + RING_OFF, g, S, E1); }
        }
        ssd_passC_all(X, args);
        if (grp5 != 0) {
            { pg8::Gemm g{(const pg8::bf16_t*)(ws + WS_OA), (const pg8::bf16_t*)(ws + WS_WBRA), MPR, 1024, 1024, 1024, 1024}; pg8::StaticOrder S; S.init(MPR, 1024, X.G, cb);
              pg8::gemm_phase<pg8::Epi<pg8::EM_G1>, pg8::StaticOrder, false, true>(X.lds + RING_OFF, g, S, E1); }
        }
        for (int u = X.vcu; u < 2 * NSB; u += X.G) decode_combine(X, args, u);
        __syncthreads();
        if (BOTH(5)) GRID_BAR();
    }
    if (IN(6)) {
        const pg8::bf16_t* PBh = (const pg8::bf16_t*)(ws + WS_PB);
        pg8::Epi<pg8::EM_G1> E1{(void*)(ws + WS_MG1), 1024, nullptr, 0, PBh + PB_GA, NPB, nullptr};
        pg8::Epi<pg8::EM_G2> E2{(void*)(ws + WS_MG), 1024, (void*)(ws + WS_MG1), 1024, PBh + PB_GB, NPB, nullptr};
        for (int u = X.vcu; u < 128; u += X.G) {
            pg8::skinny_unit<pg8::EM_G1>(X.lds, (const pg8::bf16_t*)(ws + WS_OA), 1024, (const pg8::bf16_t*)(ws + WS_WBRA), 1024, 1024, 32 * (u >> 2), E1, MPR + 32 * (u & 3));
            pg8::skinny_unit<pg8::EM_G2>(X.lds, (const pg8::bf16_t*)(ws + WS_OS), 2048, (const pg8::bf16_t*)(ws + WS_WBRS), 2048, 2048, 32 * (u >> 2), E2, MPR + 32 * (u & 3));
        }
        { pg8::Gemm g{(const pg8::bf16_t*)(ws + WS_OS), (const pg8::bf16_t*)(ws + WS_WBRS), MPR, 1024, 2048, 2048, 2048}; pg8::StaticOrder S; S.init(MPR, 1024, X.G, cb);
          pg8::gemm_phase<pg8::Epi<pg8::EM_G2>, pg8::StaticOrder, false, true>(X.lds + RING_OFF, g, S, E2); }
        if (BOTH(6)) GRID_BAR();
    }
    if (IN(7)) {
        pg8::Epi<pg8::EM_BF16> E{(void*)(ws + WS_MIX), 1024, nullptr, 0, nullptr, 0, nullptr};
        for (int u = X.vcu; u < 128; u += X.G) pg8::skinny_unit<pg8::EM_BF16>(X.lds, (const pg8::bf16_t*)(ws + WS_MG), 1024, (const pg8::bf16_t*)(ws + WS_WOUT), 1024, 1024, 32 * (u >> 2), E, MPR + 32 * (u & 3));
        { pg8::Gemm g{(const pg8::bf16_t*)(ws + WS_MG), (const pg8::bf16_t*)(ws + WS_WOUT), MPR, 1024, 1024, 1024, 1024}; pg8::StaticOrder S; S.init(MPR, 1024, X.G, cb);
          pg8::gemm_phase<pg8::Epi<pg8::EM_BF16>, pg8::StaticOrder, false, true>(X.lds + RING_OFF, g, S, E); }
        if (BOTH(7)) GRID_BAR();
    }
    if (IN(8)) { ph_norm1(X, args); if (BOTH(8)) GRID_BAR(); }
    if (IN(9)) {
        pg8::Epi<pg8::EM_UP> E{(void*)(ws + WS_U), 4096, nullptr, 0, nullptr, 0, nullptr};
        const int grp9 = X.vcu >= (X.G >> 1) ? 1 : 0;
        if (grp9 == 0) { for (int u = X.vcu; u < 512; u += X.G) pg8::skinny_unit<pg8::EM_UP>(X.lds, XN, 1024, (const pg8::bf16_t*)(ws + WS_WUP), 1024, 1024, 32 * (u >> 2), E, MPR + 32 * (u & 3)); }
        { pg8::Gemm g{XN, (const pg8::bf16_t*)(ws + WS_WUP), MPR, 4096, 1024, 1024, 1024}; pg8::StaticOrder S; S.init(MPR, 4096, X.G, cb);
          pg8::gemm_phase<pg8::Epi<pg8::EM_UP>, pg8::StaticOrder, true, true>(X.lds + RING_OFF, g, S, E); }
        if (grp9 != 0) { for (int u = X.vcu; u < 512; u += X.G) pg8::skinny_unit<pg8::EM_UP>(X.lds, XN, 1024, (const pg8::bf16_t*)(ws + WS_WUP), 1024, 1024, 32 * (u >> 2), E, MPR + 32 * (u & 3)); }
        if (BOTH(9)) GRID_BAR();
    }
    if (IN(10)) {
        pg8::Epi<pg8::EM_BF16> E{(void*)(ws + WS_F), 1024, nullptr, 0, nullptr, 0, nullptr};
        for (int u = X.vcu; u < 128; u += X.G) pg8::skinny_unit<pg8::EM_BF16>(X.lds, (const pg8::bf16_t*)(ws + WS_U), 4096, (const pg8::bf16_t*)(ws + WS_WDN), 4096, 4096, 32 * (u >> 2), E, MPR + 32 * (u & 3));
        { pg8::Gemm g{(const pg8::bf16_t*)(ws + WS_U), (const pg8::bf16_t*)(ws + WS_WDN), MPR, 1024, 4096, 4096, 4096}; pg8::StaticOrder S; S.init(MPR, 1024, X.G, cb);
          pg8::gemm_phase<pg8::Epi<pg8::EM_BF16>, pg8::StaticOrder, false, true>(X.lds + RING_OFF, g, S, E); }
        if (BOTH(10)) GRID_BAR();
    }
    if (IN(11)) { ph_norm2(X, args); }
#undef IN
#undef BOTH
#undef GRID_BAR
}

extern "C" void kernel_launch(void* const* d_in, const int* in_sizes, int n_in, void* d_out, int out_size, void* d_ws, size_t ws_size, hipStream_t stream) {
    static int grid = 0;
    if (grid == 0) {
        if (n_in != N_IN || (size_t)out_size != O_END || ws_size < WS_END) { fprintf(stderr, "kernel_launch: unexpected problem: n_in %d out %d ws %zu; nothing launched\n", n_in, out_size, ws_size); grid = -1; return; }
        int dev = 0, cus = 0, per_cu = 0;
        if (hipGetDevice(&dev) != hipSuccess || hipDeviceGetAttribute(&cus, hipDeviceAttributeMultiprocessorCount, dev) != hipSuccess) { fprintf(stderr, "kernel_launch: device query failed\n"); grid = -1; return; }
        if (hipFuncSetAttribute((const void*)fwd_kernel, hipFuncAttributeMaxDynamicSharedMemorySize, LDS_BYTES) != hipSuccess) { fprintf(stderr, "kernel_launch: hipFuncSetAttribute failed\n"); grid = -1; return; }
        if (hipOccupancyMaxActiveBlocksPerMultiprocessor(&per_cu, (const void*)fwd_kernel, NWAVES * 64, LDS_BYTES) != hipSuccess || per_cu < 1) { fprintf(stderr, "kernel_launch: occupancy query reports %d blocks per CU\n", per_cu); }
        (void)hipGetLastError();
        grid = cus;
    }
    if (grid < 0) return;
    if (hipMemsetAsync((char*)d_ws + WS_CTL, 0, CTL_ZERO_BYTES, stream) != hipSuccess) { fprintf(stderr, "kernel_launch: memset failed\n"); return; }
    Args a{};
    for (int i = 0; i < N_IN; ++i) a.in[i] = d_in[i];
    a.out = (float*)d_out; a.ws = (unsigned char*)d_ws;
    for (int li = 0; li < N_LAUNCHES; ++li) {
        a.ph_lo = (N_LAUNCHES == 1) ? 0 : li; a.ph_hi = (N_LAUNCHES == 1) ? N_PHASES : li + 1; a.li = li; a.pad = 0;
        hipLaunchKernelGGL(fwd_kernel, dim3(grid), dim3(NWAVES * 64), LDS_BYTES, stream, a);
        const hipError_t le = hipPeekAtLastError();
        if (le != hipSuccess) { fprintf(stderr, "kernel_launch: launch %d failed: %s\n", li, hipGetErrorName(le)); break; }
    }
}
```

```cpp
#define MK_N_LAUNCHES 1
#include <hip/hip_runtime.h>
#include <hip/hip_bf16.h>
#include <cstdio>
#include <cstdint>
#include <cmath>

namespace pg8 {
#define PG8_LAS __attribute__((address_space(3)))
typedef unsigned short bf16_t;
typedef short bf16x8 __attribute__((ext_vector_type(8)));
typedef float f32x4 __attribute__((ext_vector_type(4)));
typedef unsigned u32x4 __attribute__((ext_vector_type(4)));
typedef unsigned u32x2 __attribute__((ext_vector_type(2)));
constexpr int BM = 256, BK = 64, HALF = 128, HTB = HALF * BK * 2  , STAGE_BYTES = 8 * HTB, NXCD = 8, WGM = 8;

__host__ __device__ __forceinline__ int lds_byte(int r, int c) { const int st = (r >> 4) * 2 + (c >> 5), rr = r & 15, cc = c & 31, ob = rr * 64 + cc * 2; return st * 1024 + (ob ^ (((ob >> 9) & 1) << 5)); }
__host__ __device__ __forceinline__ void stage_rc(int b, int& R, int& C) { const int st = b / 1024, sb = b % 1024, swz = sb ^ (((sb >> 9) & 1) << 5); R = (st >> 1) * 16 + swz / 64; C = (st & 1) * 32 + (swz % 64) / 2; }
__host__ __device__ __forceinline__ int perm32(int rho) { const int n = rho >> 4, i = rho & 15; return 8 * (i >> 2) + 4 * n + (i & 3); }

struct Unit { int pm, pn; };
struct Gemm { const bf16_t* A; const bf16_t* Bt; int M, N, K, lda, ldb; };

struct StaticOrder {
    int nM, nN, nwg, G, c;
    __host__ __device__ void init(int M, int N, int G_, int c_) { nM = M / BM; nN = N / BM; nwg = nM * nN; G = G_; c = c_; }
    __host__ __device__ bool next(int i, Unit& u) const {
        const long L = (long)i * G + c; if (L >= nwg) return false;
        int wgid = (int)L; { const int q = nwg / NXCD, r = nwg % NXCD, xcd = wgid % NXCD, off = wgid / NXCD; wgid = (xcd < r ? xcd * (q + 1) : r * (q + 1) + (xcd - r) * q) + off; }
        const int nig = WGM * nN, gid = wgid / nig, fm = gid * WGM, gsz = (nM - fm) < WGM ? (nM - fm) : WGM;
        u.pm = fm + ((wgid % nig) % gsz); u.pn = (wgid % nig) / gsz; return true;
    }
    __device__ __forceinline__ void a_ready(const Unit&) const {}
    __device__ __forceinline__ void done(const Unit&) const {}
};

__device__ __forceinline__ unsigned cvt_pk_bf16(float lo, float hi) { unsigned r; asm volatile("v_cvt_pk_bf16_f32 %0, %1, %2" : "=v"(r) : "v"(lo), "v"(hi)); return r; }
__device__ __forceinline__ float bflo(unsigned w) { return __uint_as_float(w << 16); }
__device__ __forceinline__ float bfhi(unsigned w) { return __uint_as_float(w & 0xffff0000u); }
__device__ __forceinline__ float sigm(float x) { return __builtin_amdgcn_rcpf(1.0f + __expf(-x)); }

enum { EM_P1 = 0, EM_Q = 1, EM_BF16 = 2, EM_G1 = 3, EM_G2 = 4, EM_F32 = 5, EM_UP = 6 };
constexpr float QSCALE = 0.10540925533894598f * 1.4426950408889634f;
template <int MODE> struct Epi {
    static constexpr bool PERM = true, AFTER_DRAIN = false;
    void* o0; int ld0;
    void* o1; int ld1;
    const bf16_t* gate; int ldg;
    const float* tab;
    __device__ __forceinline__ void operator()(const f32x4 (&acc)[2][2][4][2], const Unit& u, int wr, int wc, int fr, int fq) const {
        const int row0 = u.pm * BM + wr * 64 + fr;
#pragma unroll
        for (int ai = 0; ai < 2; ++ai) {
            u32x4 gq[4][2], mq[4][2]; f32x4 tq[4][2];
            if constexpr (MODE == EM_G1 || MODE == EM_G2) {
#pragma unroll
                for (int m = 0; m < 4; ++m)
#pragma unroll
                    for (int bj = 0; bj < 2; ++bj) { const size_t go = (size_t)(row0 + ai * HALF + m * 16) * ldg + u.pn * BM + bj * HALF + wc * 32 + 8 * fq;
                        gq[m][bj] = *(const u32x4*)(gate + go);
                        if constexpr (MODE == EM_G2) mq[m][bj] = *(const u32x4*)((const bf16_t*)o1 + (size_t)(row0 + ai * HALF + m * 16) * ld1 + u.pn * BM + bj * HALF + wc * 32 + 8 * fq); }
            }
            if constexpr (MODE == EM_Q) {
#pragma unroll
                for (int m = 0; m < 4; ++m) { const int row = row0 + ai * HALF + m * 16; const int pidx = row < 16384 ? (row & 2047) : 2048;
                    const float* tp = tab + ((size_t)pidx * 16 + 4 * fq) * 2; tq[m][0] = *(const f32x4*)tp; tq[m][1] = *(const f32x4*)(tp + 4); }
            }
#pragma unroll
            for (int m = 0; m < 4; ++m) {
                const int row = row0 + ai * HALF + m * 16;
#pragma unroll
                for (int bj = 0; bj < 2; ++bj) {
                    const int col = u.pn * BM + bj * HALF + wc * 32 + 8 * fq;
                    f32x4 v0 = acc[ai][bj][m][0], v1 = acc[ai][bj][m][1];
                    if constexpr (MODE == EM_P1) {
                        if (u.pn < 3) { u32x4 w; w.x = cvt_pk_bf16(v0[0], v0[1]); w.y = cvt_pk_bf16(v0[2], v0[3]); w.z = cvt_pk_bf16(v1[0], v1[1]); w.w = cvt_pk_bf16(v1[2], v1[3]);
                               *(u32x4*)((bf16_t*)o0 + (size_t)row * ld0 + col) = w; }
                        else { u32x4 w; w.x = cvt_pk_bf16(v0[0], v0[1]); w.y = cvt_pk_bf16(v0[2], v0[3]); w.z = cvt_pk_bf16(v1[0], v1[1]); w.w = cvt_pk_bf16(v1[2], v1[3]);
                               *(u32x4*)((bf16_t*)o1 + (size_t)row * ld1 + (col - 768)) = w; }
                    } else if constexpr (MODE == EM_Q) {
                        const int g32 = col >> 5;
                        if ((g32 % 3) == 2) {
                            const f32x4 t0 = tq[m][0], t1 = tq[m][1];
                            f32x4 r0, r1;
                            r0[0] = v0[0] * t0[0] - v0[1] * t0[1]; r0[1] = v0[0] * t0[1] + v0[1] * t0[0];
                            r0[2] = v0[2] * t0[2] - v0[3] * t0[3]; r0[3] = v0[2] * t0[3] + v0[3] * t0[2];
                            r1[0] = v1[0] * t1[0] - v1[1] * t1[1]; r1[1] = v1[0] * t1[1] + v1[1] * t1[0];
                            r1[2] = v1[2] * t1[2] - v1[3] * t1[3]; r1[3] = v1[2] * t1[3] + v1[3] * t1[2];
                            v0 = r0; v1 = r1;
                        }
                        v0 = v0 * QSCALE; v1 = v1 * QSCALE;
                        u32x4 w; w.x = cvt_pk_bf16(v0[0], v0[1]); w.y = cvt_pk_bf16(v0[2], v0[3]); w.z = cvt_pk_bf16(v1[0], v1[1]); w.w = cvt_pk_bf16(v1[2], v1[3]);
                        *(u32x4*)((bf16_t*)o0 + (size_t)row * ld0 + col) = w;
                    } else if constexpr (MODE == EM_BF16) {
                        u32x4 w; w.x = cvt_pk_bf16(v0[0], v0[1]); w.y = cvt_pk_bf16(v0[2], v0[3]); w.z = cvt_pk_bf16(v1[0], v1[1]); w.w = cvt_pk_bf16(v1[2], v1[3]);
                        *(u32x4*)((bf16_t*)o0 + (size_t)row * ld0 + col) = w;
                    } else if constexpr (MODE == EM_G1) {
                        const u32x4 gw = gq[m][bj];
                        v0[0] *= sigm(bflo(gw.x)); v0[1] *= sigm(bfhi(gw.x)); v0[2] *= sigm(bflo(gw.y)); v0[3] *= sigm(bfhi(gw.y));
                        v1[0] *= sigm(bflo(gw.z)); v1[1] *= sigm(bfhi(gw.z)); v1[2] *= sigm(bflo(gw.w)); v1[3] *= sigm(bfhi(gw.w));
                        u32x4 w; w.x = cvt_pk_bf16(v0[0], v0[1]); w.y = cvt_pk_bf16(v0[2], v0[3]); w.z = cvt_pk_bf16(v1[0], v1[1]); w.w = cvt_pk_bf16(v1[2], v1[3]);
                        *(u32x4*)((bf16_t*)o0 + (size_t)row * ld0 + col) = w;
                    } else if constexpr (MODE == EM_G2) {
                        const u32x4 gw = gq[m][bj];
                        const u32x4 mw = mq[m][bj];
                        const f32x4 a0 = (f32x4){bflo(mw.x), bfhi(mw.x), bflo(mw.y), bfhi(mw.y)}, a1 = (f32x4){bflo(mw.z), bfhi(mw.z), bflo(mw.w), bfhi(mw.w)};
                        v0[0] = a0[0] + v0[0] * sigm(bflo(gw.x)); v0[1] = a0[1] + v0[1] * sigm(bfhi(gw.x)); v0[2] = a0[2] + v0[2] * sigm(bflo(gw.y)); v0[3] = a0[3] + v0[3] * sigm(bfhi(gw.y));
                        v1[0] = a1[0] + v1[0] * sigm(bflo(gw.z)); v1[1] = a1[1] + v1[1] * sigm(bfhi(gw.z)); v1[2] = a1[2] + v1[2] * sigm(bflo(gw.w)); v1[3] = a1[3] + v1[3] * sigm(bfhi(gw.w));
                        u32x4 w; w.x = cvt_pk_bf16(v0[0], v0[1]); w.y = cvt_pk_bf16(v0[2], v0[3]); w.z = cvt_pk_bf16(v1[0], v1[1]); w.w = cvt_pk_bf16(v1[2], v1[3]);
                        *(u32x4*)((bf16_t*)o0 + (size_t)row * ld0 + col) = w;
                    } else if constexpr (MODE == EM_F32) {
                        float* p = (float*)o0 + (size_t)row * ld0 + col; *(f32x4*)p = v0; *(f32x4*)(p + 4) = v1;
                    } else {
#pragma unroll
                        for (int j = 0; j < 4; ++j) { float a, b; asm("v_max_f32 %0, 0, %1" : "=v"(a) : "v"(v0[j])); asm("v_max_f32 %0, 0, %1" : "=v"(b) : "v"(v1[j])); v0[j] = a * a; v1[j] = b * b; }
                        u32x4 w; w.x = cvt_pk_bf16(v0[0], v0[1]); w.y = cvt_pk_bf16(v0[2], v0[3]); w.z = cvt_pk_bf16(v1[0], v1[1]); w.w = cvt_pk_bf16(v1[2], v1[3]);
                        *(u32x4*)((bf16_t*)o0 + (size_t)row * ld0 + col) = w;
                    }
                }
            }
        }
    }
};

template <class Epi, class Sched, bool ALIGN_EPI = false, bool SP2 = false>
__device__ __forceinline__ void gemm_phase(PG8_LAS unsigned char* lds, const Gemm g, const Sched& S, const Epi& E) {
    const int tid = threadIdx.x, wid = __builtin_amdgcn_readfirstlane(tid >> 6), lane = tid & 63, wr = wid >> 2, wc = wid & 3, fr = lane & 15, fq = lane >> 4;
    int K = g.K; asm volatile("" : "+s"(K)); const int nt = K / BK;
    unsigned voffA[2], voffB[2];
#pragma unroll
    for (int i = 0; i < 2; ++i) { int R, C; stage_rc(tid * 16 + i * 8192, R, C); const int Rb = Epi::PERM ? ((R & ~31) + perm32(R & 31)) : R;
        voffA[i] = (unsigned)(R * g.lda + C) * 2u; voffB[i] = (unsigned)(Rb * g.ldb + C) * 2u; }
    const size_t kstep = (size_t)(BK * 2);
    const size_t hstepA = (size_t)HALF * g.lda * 2, hstepB = (size_t)HALF * g.ldb * 2;
    const size_t tstepA = 2 * hstepA, tstepB = 2 * hstepB;
    const unsigned ldsw = (unsigned)wid * 1024u;
    const int aoff = lds_byte(wr * 64 + fr, fq * 8), boff = lds_byte(wc * 32 + fr, fq * 8);
#define PG8_SA(b, h) (((b) * 2 + (h)) * HTB)
#define PG8_SB(b, h) ((4 + (b) * 2 + (h)) * HTB)
#define PG8_STAGE(bufoff, gbase, voff) do { _Pragma("unroll") for (int _i = 0; _i < 2; ++_i) \
        __builtin_amdgcn_global_load_lds((const unsigned*)((const char*)(gbase) + (voff)[_i]), (PG8_LAS unsigned*)(lds + (bufoff) + ldsw + _i * 8192), 16, 0, 0); } while (0)
#define PG8_LDA(dst, b, h) do { _Pragma("unroll") for (int m = 0; m < 4; ++m) _Pragma("unroll") for (int k = 0; k < 2; ++k) dst[m][k] = *(const PG8_LAS bf16x8*)(lds + PG8_SA(b, h) + aoff + m * 2048 + k * 1024); } while (0)
#define PG8_LDB(dst, b, h) do { _Pragma("unroll") for (int n = 0; n < 2; ++n) _Pragma("unroll") for (int k = 0; k < 2; ++k) dst[n][k] = *(const PG8_LAS bf16x8*)(lds + PG8_SB(b, h) + boff + n * 2048 + k * 1024); } while (0)
#define PG8_MMA(ai, bj, At, Bt) do { __builtin_amdgcn_s_setprio(1); _Pragma("unroll") for (int m = 0; m < 4; ++m) _Pragma("unroll") for (int n = 0; n < 2; ++n) _Pragma("unroll") for (int k = 0; k < 2; ++k) \
        acc[ai][bj][m][n] = __builtin_amdgcn_mfma_f32_16x16x32_bf16(Bt[n][k], At[m][k], acc[ai][bj][m][n], 0, 0, 0); __builtin_amdgcn_s_setprio(0); } while (0)
#define PG8_WAIT_V(n) asm volatile("s_waitcnt vmcnt(" #n ")" ::: "memory")
#define PG8_WAIT_L(n) asm volatile("s_waitcnt lgkmcnt(" #n ")" ::: "memory")
#define PG8_BAR __builtin_amdgcn_s_barrier()
#define PG8_SCHED __builtin_amdgcn_sched_barrier(0)
    Unit cur, nxt; int ui = 0;
    if (!S.next(0, cur)) return;
    f32x4 acc[2][2][4][2];
#pragma unroll
    for (int a = 0; a < 2; ++a)
#pragma unroll
        for (int b = 0; b < 2; ++b)
#pragma unroll
            for (int m = 0; m < 4; ++m)
#pragma unroll
                for (int n = 0; n < 2; ++n) acc[a][b][m][n] = (f32x4){0.f, 0.f, 0.f, 0.f};
    bf16x8 At[4][2], B0[2][2], B1[2][2];
    const char* cA = (const char*)g.A + (size_t)cur.pm * tstepA; const char* cB = (const char*)g.Bt + (size_t)cur.pn * tstepB;
    S.a_ready(cur);
    if constexpr (SP2) {
        PG8_STAGE(PG8_SB(0, 0), cB, voffB); PG8_STAGE(PG8_SB(0, 1), cB + hstepB, voffB); PG8_STAGE(PG8_SA(0, 0), cA, voffA); PG8_STAGE(PG8_SA(0, 1), cA + hstepA, voffA);
        if (wr == 1) PG8_BAR;
        PG8_WAIT_V(2); PG8_BAR;
        PG8_STAGE(PG8_SB(1, 0), cB + kstep, voffB); PG8_STAGE(PG8_SA(1, 0), cA + kstep, voffA); PG8_STAGE(PG8_SB(1, 1), cB + hstepB + kstep, voffB);
        PG8_WAIT_V(6); PG8_BAR;
    } else {
        PG8_STAGE(PG8_SB(0, 0), cB, voffB); PG8_STAGE(PG8_SA(0, 0), cA, voffA); PG8_STAGE(PG8_SB(0, 1), cB + hstepB, voffB); PG8_STAGE(PG8_SA(0, 1), cA + hstepA, voffA);
        if (wr == 1) PG8_BAR;
        PG8_WAIT_V(4); PG8_BAR;
        PG8_STAGE(PG8_SB(1, 0), cB + kstep, voffB); PG8_STAGE(PG8_SA(1, 0), cA + kstep, voffA); PG8_STAGE(PG8_SB(1, 1), cB + hstepB + kstep, voffB);
        PG8_WAIT_V(6); PG8_BAR;
    }
    for (;;) {
        const bool has_next = S.next(ui + 1, nxt);
        const char* nA = has_next ? (const char*)g.A + (size_t)nxt.pm * tstepA : cA; const char* nB = has_next ? (const char*)g.Bt + (size_t)nxt.pn * tstepB : cB;
        for (int t = 0; t < nt; t += 2) {
            const bool last = (t == nt - 2);
            const char* a1 = cA + (size_t)(t + 1) * kstep;
            const char* a2 = last ? nA : cA + (size_t)(t + 2) * kstep; const char* b2 = last ? nB : cB + (size_t)(t + 2) * kstep;
            const char* a3 = a2 + kstep; const char* b3 = b2 + kstep;
            if (last && has_next) S.a_ready(nxt);
            if constexpr (SP2) {
            PG8_LDB(B0, 0, 0); PG8_LDB(B1, 0, 1); PG8_SCHED; PG8_LDA(At, 0, 0); PG8_STAGE(PG8_SA(1, 1), a1 + hstepA, voffA);
            PG8_WAIT_V(8); PG8_WAIT_L(0); PG8_BAR; PG8_MMA(0, 0, At, B0); PG8_MMA(0, 1, At, B1); PG8_BAR; PG8_SCHED;
            PG8_LDA(At, 0, 1); PG8_STAGE(PG8_SB(0, 0), b2, voffB); PG8_STAGE(PG8_SB(0, 1), b2 + hstepB, voffB); PG8_STAGE(PG8_SA(0, 0), a2, voffA);
            PG8_WAIT_V(8); PG8_WAIT_L(0); PG8_BAR; PG8_MMA(1, 0, At, B0); PG8_MMA(1, 1, At, B1); PG8_BAR; PG8_SCHED;
            PG8_LDB(B0, 1, 0); PG8_LDB(B1, 1, 1); PG8_SCHED; PG8_LDA(At, 1, 0); PG8_STAGE(PG8_SA(0, 1), a2 + hstepA, voffA);
            PG8_WAIT_V(8); PG8_WAIT_L(0); PG8_BAR; PG8_MMA(0, 0, At, B0); PG8_MMA(0, 1, At, B1); PG8_BAR; PG8_SCHED;
            PG8_LDA(At, 1, 1); PG8_STAGE(PG8_SB(1, 0), b3, voffB); PG8_STAGE(PG8_SB(1, 1), b3 + hstepB, voffB); PG8_STAGE(PG8_SA(1, 0), a3, voffA);
            PG8_WAIT_V(8); PG8_WAIT_L(0); PG8_BAR; PG8_MMA(1, 0, At, B0); PG8_MMA(1, 1, At, B1); PG8_BAR; PG8_SCHED;
            } else {
            PG8_LDB(B0, 0, 0); PG8_SCHED; PG8_LDA(At, 0, 0); PG8_STAGE(PG8_SA(1, 1), a1 + hstepA, voffA);
            PG8_WAIT_L(8); PG8_BAR; PG8_WAIT_L(0); PG8_MMA(0, 0, At, B0); PG8_BAR; PG8_SCHED;
            PG8_LDB(B1, 0, 1); PG8_STAGE(PG8_SB(0, 0), b2, voffB);
            PG8_BAR; PG8_WAIT_L(0); PG8_MMA(0, 1, At, B1); PG8_BAR;
            PG8_LDA(At, 0, 1); PG8_STAGE(PG8_SA(0, 0), a2, voffA);
            PG8_BAR; PG8_WAIT_L(0); PG8_MMA(1, 0, At, B0); PG8_BAR; PG8_SCHED;
            PG8_STAGE(PG8_SB(0, 1), b2 + hstepB, voffB);
            PG8_WAIT_V(6); PG8_BAR; PG8_MMA(1, 1, At, B1); PG8_BAR;
            PG8_LDB(B0, 1, 0); PG8_SCHED; PG8_LDA(At, 1, 0); PG8_STAGE(PG8_SA(0, 1), a2 + hstepA, voffA);
            PG8_WAIT_L(8); PG8_BAR; PG8_WAIT_L(0); PG8_MMA(0, 0, At, B0); PG8_BAR; PG8_SCHED;
            PG8_LDB(B1, 1, 1); PG8_STAGE(PG8_SB(1, 0), b3, voffB);
            PG8_BAR; PG8_WAIT_L(0); PG8_MMA(0, 1, At, B1); PG8_BAR;
            PG8_LDA(At, 1, 1); PG8_STAGE(PG8_SA(1, 0), a3, voffA);
            PG8_BAR; PG8_WAIT_L(0); PG8_MMA(1, 0, At, B0); PG8_BAR; PG8_SCHED;
            PG8_STAGE(PG8_SB(1, 1), b3 + hstepB, voffB);
            PG8_WAIT_V(6); PG8_BAR; PG8_MMA(1, 1, At, B1); PG8_BAR;
            }
        }
        if constexpr (ALIGN_EPI) { if (wr == 0) PG8_BAR; }
        if constexpr (!Epi::AFTER_DRAIN) { E(acc, cur, wr, wc, fr, fq); S.done(cur); }
        if (!has_next) break;
#pragma unroll
        for (int a = 0; a < 2; ++a)
#pragma unroll
            for (int b = 0; b < 2; ++b)
#pragma unroll
                for (int m = 0; m < 4; ++m)
#pragma unroll
                    for (int n = 0; n < 2; ++n) acc[a][b][m][n] = (f32x4){0.f, 0.f, 0.f, 0.f};
        cur = nxt; cA = nA; cB = nB; ++ui;
        if constexpr (ALIGN_EPI) { if (wr == 1) PG8_BAR; }
    }
    PG8_WAIT_V(0);
    if constexpr (!ALIGN_EPI) { if (wr == 0) PG8_BAR; }
    PG8_BAR;
    if constexpr (Epi::AFTER_DRAIN) { E.fused(acc, cur, wr, wc, fr, fq, lds, wid, lane); S.done(cur); }
#undef PG8_SA
#undef PG8_SB
#undef PG8_STAGE
#undef PG8_LDA
#undef PG8_LDB
#undef PG8_MMA
#undef PG8_WAIT_V
#undef PG8_WAIT_L
#undef PG8_BAR
#undef PG8_SCHED
}

template <int MODE> __device__ __forceinline__ void epi4(const Epi<MODE>& E, int row, int col, f32x4 v) {
    if constexpr (MODE == EM_G1) {
        const u32x2 gw = *(const u32x2*)(E.gate + (size_t)row * E.ldg + col);
        v[0] *= sigm(bflo(gw.x)); v[1] *= sigm(bfhi(gw.x)); v[2] *= sigm(bflo(gw.y)); v[3] *= sigm(bfhi(gw.y));
        { u32x2 w; w.x = cvt_pk_bf16(v[0], v[1]); w.y = cvt_pk_bf16(v[2], v[3]); *(u32x2*)((bf16_t*)E.o0 + (size_t)row * E.ld0 + col) = w; }
    } else if constexpr (MODE == EM_G2) {
        const u32x2 gw = *(const u32x2*)(E.gate + (size_t)row * E.ldg + col);
        const u32x2 mw = *(const u32x2*)((const bf16_t*)E.o1 + (size_t)row * E.ld1 + col);
        const f32x4 a = (f32x4){bflo(mw.x), bfhi(mw.x), bflo(mw.y), bfhi(mw.y)};
        v[0] = a[0] + v[0] * sigm(bflo(gw.x)); v[1] = a[1] + v[1] * sigm(bfhi(gw.x)); v[2] = a[2] + v[2] * sigm(bflo(gw.y)); v[3] = a[3] + v[3] * sigm(bfhi(gw.y));
        u32x2 w; w.x = cvt_pk_bf16(v[0], v[1]); w.y = cvt_pk_bf16(v[2], v[3]);
        *(u32x2*)((bf16_t*)E.o0 + (size_t)row * E.ld0 + col) = w;
    } else if constexpr (MODE == EM_F32) {
        *(f32x4*)((float*)E.o0 + (size_t)row * E.ld0 + col) = v;
    } else if constexpr (MODE == EM_BF16) {
        u32x2 w; w.x = cvt_pk_bf16(v[0], v[1]); w.y = cvt_pk_bf16(v[2], v[3]);
        *(u32x2*)((bf16_t*)E.o0 + (size_t)row * E.ld0 + col) = w;
    } else {
#pragma unroll
        for (int j = 0; j < 4; ++j) { const float a = fmaxf(v[j], 0.f); v[j] = a * a; }
        u32x2 w; w.x = cvt_pk_bf16(v[0], v[1]); w.y = cvt_pk_bf16(v[2], v[3]);
        *(u32x2*)((bf16_t*)E.o0 + (size_t)row * E.ld0 + col) = w;
    }
}
template <int MODE> __device__ __forceinline__ void skinny_unit(PG8_LAS unsigned char* lds, const bf16_t* A, int lda, const bf16_t* Bt, int ldb, int K, int n0, const Epi<MODE>& E, int rbase) {
    const int tid = threadIdx.x, wid = __builtin_amdgcn_readfirstlane(tid >> 6), lane = tid & 63, fr = lane & 15, fq = lane >> 4;
    const int klen = K >> 3, k0 = wid * klen;
    f32x4 acc[2][2];
#pragma unroll
    for (int mt = 0; mt < 2; ++mt) { acc[mt][0] = (f32x4){0.f, 0.f, 0.f, 0.f}; acc[mt][1] = (f32x4){0.f, 0.f, 0.f, 0.f}; }
    const bf16_t* ap = A + (size_t)(rbase + fr) * lda + k0 + 8 * fq;
    const bf16_t* bp = Bt + (size_t)(n0 + fr) * ldb + k0 + 8 * fq;
    bf16x8 bq[2][4][2], aq[2][4][2];
#define SK_LOAD(buf_, kk_) do { _Pragma("unroll") for (int u = 0; u < 4; ++u) { bq[buf_][u][0] = *(const bf16x8*)(bp + (kk_) + 32 * u); bq[buf_][u][1] = *(const bf16x8*)(bp + (size_t)16 * ldb + (kk_) + 32 * u); \
            aq[buf_][u][0] = *(const bf16x8*)(ap + (kk_) + 32 * u); aq[buf_][u][1] = *(const bf16x8*)(ap + (size_t)16 * lda + (kk_) + 32 * u); } } while (0)
    SK_LOAD(0, 0);
#pragma unroll
    for (int kk = 0; kk < klen; kk += 128) {
        const int cb = (kk >> 7) & 1;
        if (kk + 128 < klen) SK_LOAD(cb ^ 1, kk + 128);
#pragma unroll
        for (int u = 0; u < 4; ++u) asm volatile("" : "+v"(bq[cb][u][0]), "+v"(bq[cb][u][1]), "+v"(aq[cb][u][0]), "+v"(aq[cb][u][1]) :: "memory");
#pragma unroll
        for (int u = 0; u < 4; ++u)
#pragma unroll
            for (int mt = 0; mt < 2; ++mt) {
                acc[mt][0] = __builtin_amdgcn_mfma_f32_16x16x32_bf16(bq[cb][u][0], aq[cb][u][mt], acc[mt][0], 0, 0, 0);
                acc[mt][1] = __builtin_amdgcn_mfma_f32_16x16x32_bf16(bq[cb][u][1], aq[cb][u][mt], acc[mt][1], 0, 0, 0);
            }
    }
#undef SK_LOAD
    PG8_LAS float* P = (PG8_LAS float*)lds + wid * 1024;
#pragma unroll
    for (int mt = 0; mt < 2; ++mt) { *(PG8_LAS f32x4*)(P + (16 * mt + fr) * 32 + 4 * fq) = acc[mt][0]; *(PG8_LAS f32x4*)(P + (16 * mt + fr) * 32 + 16 + 4 * fq) = acc[mt][1]; }
    __syncthreads();
    if (tid < 256) {
        const int e = tid * 4, m = e >> 5, c4 = e & 31;
        f32x4 s = *(PG8_LAS f32x4*)((PG8_LAS float*)lds + e);
#pragma unroll
        for (int w = 1; w < 8; ++w) s += *(PG8_LAS f32x4*)((PG8_LAS float*)lds + w * 1024 + e);
        epi4<MODE>(E, rbase + m, n0 + c4, s);
    }
    __syncthreads();
}
}

constexpr int NWAVES = 8;
constexpr int DM = 1024, SEQ = 2048, NBAT = 8, MPR = NBAT * SEQ  , NSB = 128  , MR = MPR + NSB  , MP = 16640  ;
constexpr int NIN = 8960;
constexpr int NPF = 768, NPB = 8192;
constexpr int PB_Z = 0, PB_XBC = 2048, PB_GA = 6144, PB_GB = 7168;
constexpr int QW = 1536;
constexpr int PAST = 8192, PAGE = 128, NPAGES = 64;
constexpr float EPS = 1e-6f;
enum { I_XP = 0, I_XS, I_CKV, I_CPE, I_SSM, I_CONV, I_PT, I_WIN, I_GPRE, I_GQ, I_WUQ, I_GKV, I_WUK, I_WUV, I_WCONV, I_BCONV, I_DTB, I_ALOG, I_DSKIP, I_GSSM,
       I_WBRA, I_WBRS, I_WOUT, I_GPOSTMIX, I_GPREMLP, I_WUP, I_WDN, I_GPOSTMLP, N_IN };
constexpr size_t O_YP = 0, O_YS = 16777216, O_KVP = 16908288, O_KRP = 21102592, O_SSP = 21626880, O_CVP = 23724032, O_KVS = 23822336, O_KRS = 23855104, O_SSS = 23859200, O_CVS = 57413632, O_END = 58986496;

constexpr size_t MiB = 1u << 20;
constexpr size_t WS_CTL = 0, CTL_ZERO_BYTES = 64 * 1024;
constexpr size_t WS_WIN = 2 * MiB, WS_WUQ = 20 * MiB, WS_WUKV = 22 * MiB, WS_WBRA = 24 * MiB, WS_WBRS = 26 * MiB, WS_WOUT = 30 * MiB, WS_WUP = 32 * MiB, WS_WDN = 40 * MiB;
constexpr size_t WS_TAB = 48 * MiB, WS_CD = 49 * MiB, WS_PART = 50 * MiB, WS_QL = 56 * MiB, WS_CS = 60 * MiB  ;
constexpr size_t WS_XN = 64 * MiB, WS_PF = 98 * MiB, WS_PB = 148 * MiB, WS_CQ = 408 * MiB, WS_CKV = 422 * MiB, WS_KPE = 432 * MiB, WS_DT = 434 * MiB, WS_XBC = 438 * MiB;
constexpr size_t WS_Q = 568 * MiB, WS_KNV = 618 * MiB, WS_OA = 682 * MiB, WS_OS = 716 * MiB, WS_LOC = 782 * MiB, WS_PREV = 910 * MiB, WS_MG1 = 974 * MiB, WS_MG = 1040 * MiB;
constexpr size_t WS_MIX = 1074 * MiB, WS_X1 = 1140 * MiB, WS_U = 1206 * MiB, WS_F = 1336 * MiB, WS_END = 1402 * MiB;
static_assert(WS_WIN + (size_t)NIN * 1024 * 2 <= WS_WUQ && WS_XN + (size_t)MP * 1024 * 2 <= WS_PF && WS_PF + (size_t)MP * NPF * 4 <= WS_PB && WS_PB + (size_t)MP * NPB * 2 <= WS_CQ, "ws map 1");
static_assert(WS_CQ + (size_t)MP * 384 * 2 <= WS_CKV && WS_CKV + (size_t)MP * 256 * 2 <= WS_KPE && WS_KPE + (size_t)MP * 32 * 2 <= WS_DT && WS_DT + (size_t)MP * 32 * 4 <= WS_XBC && WS_XBC + (size_t)MP * 4096 * 2 <= WS_Q, "ws map 2");
static_assert(WS_Q + (size_t)MP * QW * 2 <= WS_KNV && WS_KNV + (size_t)MPR * 2048 * 2 <= WS_OA && WS_OA + (size_t)MP * 1024 * 2 <= WS_OS && WS_OS + (size_t)MP * 2048 * 2 <= WS_LOC, "ws map 3");
static_assert(WS_LOC + (size_t)MPR / 128 * 32 * 8192 * 4 <= WS_PREV && WS_PREV + (size_t)MPR / 128 * 32 * 8192 * 2 <= WS_MG1 && WS_MG1 + (size_t)MP * 1024 * 4 <= WS_MG && WS_MG + (size_t)MP * 1024 * 2 <= WS_MIX, "ws map 4");
static_assert(WS_MIX + (size_t)MP * 1024 * 4 <= WS_X1 && WS_X1 + (size_t)MP * 1024 * 4 <= WS_U && WS_U + (size_t)MP * 4096 * 2 <= WS_F && WS_F + (size_t)MP * 1024 * 4 <= WS_END, "ws map 5");
constexpr int CW_TMO = 0, CW_CODE = 1, CW_BAR = 4096;
constexpr int RING_OFF = 0, RING_BYTES = 131072, EXTRA_OFF = 131072  , LDSCTL_OFF = 139264, MISC_OFF = LDSCTL_OFF + 320;
constexpr int LDS_BYTES = 147456;
static_assert(MISC_OFF + 128 <= LDS_BYTES, "LDS map");

#define GAS __attribute__((address_space(1)))
#define LAS __attribute__((address_space(3)))
typedef unsigned short bf16;
typedef unsigned v4u __attribute__((ext_vector_type(4)));
typedef unsigned v2u __attribute__((ext_vector_type(2)));
typedef float f32x4 __attribute__((ext_vector_type(4)));
typedef float f32x2 __attribute__((ext_vector_type(2)));
typedef float f32x16 __attribute__((ext_vector_type(16)));
typedef short bf16x8 __attribute__((ext_vector_type(8)));
typedef short bf16x4 __attribute__((ext_vector_type(4)));
typedef short v4i16_t __attribute__((ext_vector_type(4)));
typedef GAS unsigned gu32;
#define RLX_AGENT __ATOMIC_RELAXED, __HIP_MEMORY_SCOPE_AGENT
#define LDS_WAIT() asm volatile("s_waitcnt lgkmcnt(0)" ::: "memory")
#define VM_WAIT() asm volatile("s_waitcnt vmcnt(0)" ::: "memory")
__device__ __forceinline__ unsigned pk2(float lo, float hi) { return pg8::cvt_pk_bf16(lo, hi); }
__device__ __forceinline__ float bflo(unsigned w) { return __uint_as_float(w << 16); }
__device__ __forceinline__ float bfhi(unsigned w) { return __uint_as_float(w & 0xffff0000u); }
__device__ __forceinline__ float bf1(bf16 b) { return __uint_as_float((unsigned)b << 16); }
__device__ __forceinline__ float wave_sum(float v) {
#pragma unroll
    for (int o = 1; o < 64; o <<= 1) v += __shfl_xor(v, o);
    return v;
}
__device__ __forceinline__ int crow(int r, int hi) { return (r & 3) + 8 * (r >> 2) + 4 * hi; }
__device__ __forceinline__ void unpack8(const v4u w, float (&f)[8]) { f[0] = bflo(w.x); f[1] = bfhi(w.x); f[2] = bflo(w.y); f[3] = bfhi(w.y); f[4] = bflo(w.z); f[5] = bfhi(w.z); f[6] = bflo(w.w); f[7] = bfhi(w.w); }
__device__ __forceinline__ v4u pack8(const float (&f)[8]) { v4u w; w.x = pk2(f[0], f[1]); w.y = pk2(f[2], f[3]); w.z = pk2(f[4], f[5]); w.w = pk2(f[6], f[7]); return w; }
__device__ __forceinline__ void glds16(const void* gsrc, unsigned lds_dst) { unsigned keep;
    asm volatile("s_mov_b32 %0, m0\n\ts_mov_b32 m0, %2\n\ts_nop 0\n\tglobal_load_lds_dwordx4 %1, off\n\ts_mov_b32 m0, %0" : "=&s"(keep) : "v"(gsrc), "s"(lds_dst) : "memory"); }
__device__ __forceinline__ bf16x4 vtr(const LAS unsigned char* p) { return __builtin_bit_cast(bf16x4, __builtin_amdgcn_ds_read_tr16_b64_v4i16((LAS v4i16_t*)p)); }
#define JOIN8(lo, hi) (bf16x8){lo[0], lo[1], lo[2], lo[3], hi[0], hi[1], hi[2], hi[3]}
__constant__ float INV_FREQ[16] = {1.000000000e+00f, 5.623413324e-01f, 3.162277639e-01f, 1.778279394e-01f, 1.000000015e-01f, 5.623413250e-02f, 3.162277490e-02f, 1.778279431e-02f,
                                   9.999999776e-03f, 5.623413250e-03f, 3.162277630e-03f, 1.778279431e-03f, 1.000000047e-03f, 5.623413017e-04f, 3.162277571e-04f, 1.778279402e-04f};

#define XB_TMO      128
#define XB_XCNT(j)  (256  + 64 * (j))
#define XB_XSUB(j)  (1280 + 64 * (j))
#define XB_XGEN(j)  (2304 + 64 * (j))
#define XB_TOP      3328
#define XB_TOPGEN   3392
#define XCD_BAR_WORDS 3456
#define XB_SPIN_CAP (1u << 18)

__device__ __forceinline__ unsigned xb_ld(unsigned* p)              { return __hip_atomic_load(p, __ATOMIC_RELAXED, __HIP_MEMORY_SCOPE_AGENT); }
__device__ __forceinline__ unsigned xb_add(unsigned* p, unsigned v) { return __hip_atomic_fetch_add(p, v, __ATOMIC_RELAXED, __HIP_MEMORY_SCOPE_AGENT); }
__device__ __forceinline__ unsigned xb_xcc_id() { return (unsigned)__builtin_amdgcn_s_getreg((3 << 11) | 20) & 0xFu; }
#define XB_SPIN(cond, bar) do { unsigned _sp = 0; while (cond) { __builtin_amdgcn_s_sleep(1); \
    if ((++_sp & 255u) == 0u) { if (xb_ld(&(bar)[XB_TMO])) break; if (_sp > XB_SPIN_CAP) { atomicAdd(&(bar)[XB_TMO], 1u); break; } } } } while (0)

struct XcdBarrier {
    unsigned* bar; unsigned x;
    volatile LAS unsigned* st;
};

__device__ __forceinline__ XcdBarrier xcd_barrier_post(unsigned* bar, volatile LAS unsigned* st) {
    XcdBarrier b; b.bar = bar; b.x = xb_xcc_id(); b.st = st;
    if (threadIdx.x == 0) (void)xb_add(&bar[XB_XCNT(b.x)], 1u);
    return b;
}
__device__ __forceinline__ void xcd_barrier_complete(unsigned* bar, unsigned x, unsigned& nloc, unsigned& nx) {
    const unsigned G = gridDim.x * gridDim.y * gridDim.z;
    unsigned sum, cnt, mine, sp = 0u;
    for (;;) {
        sum = 0u; cnt = 0u; mine = 0u;
#pragma unroll
        for (unsigned j = 0; j < 16; ++j) { const unsigned c = xb_ld(&bar[XB_XCNT(j)]); sum += c; cnt += (c > 0u) ? 1u : 0u; mine = (j == x) ? c : mine; }
        if (sum == G) break;
        __builtin_amdgcn_s_sleep(1);
        if ((++sp & 255u) == 0u) { if (xb_ld(&bar[XB_TMO])) break; if (sp > XB_SPIN_CAP) { atomicAdd(&bar[XB_TMO], 1u); break; } }
    }
    nloc = mine > 0u ? mine : 1u; nx = cnt > 0u ? cnt : 1u;
}

__device__ __forceinline__ void xcd_barrier(const XcdBarrier& b) {
    asm volatile("s_waitcnt vmcnt(0)" ::: "memory");
    __syncthreads();
    if (threadIdx.x == 0) {
        unsigned* bar = b.bar;
        __builtin_amdgcn_s_waitcnt(0);
        unsigned nloc = b.st[0], nx = b.st[1];
        if (nloc == 0u) { xcd_barrier_complete(bar, b.x, nloc, nx); b.st[0] = nloc; b.st[1] = nx; }
        const unsigned old = xb_add(&bar[XB_XSUB(b.x)], 1u);
        const unsigned gen = old / nloc;
        if (old + 1u == (gen + 1u) * nloc) {
            __builtin_amdgcn_fence(__ATOMIC_RELEASE, "agent");
            asm volatile("s_waitcnt vmcnt(0)" ::: "memory");
            const unsigned og = xb_add(&bar[XB_TOP], 1u);
            const unsigned tg = og / nx;
            if (og + 1u == (tg + 1u) * nx) xb_add(&bar[XB_TOPGEN], 1u);
            else XB_SPIN(xb_ld(&bar[XB_TOPGEN]) == tg, bar);
            __builtin_amdgcn_fence(__ATOMIC_ACQUIRE, "agent");
            xb_add(&bar[XB_XGEN(b.x)], 1u);
            asm volatile("s_waitcnt vmcnt(0)" ::: "memory");
        } else {
            XB_SPIN(xb_ld(&bar[XB_XGEN(b.x)]) == gen, bar);
            __builtin_amdgcn_fence(__ATOMIC_ACQUIRE, "agent");
            asm volatile("s_waitcnt vmcnt(0)" ::: "memory");
        }
    }
    __syncthreads();
}

struct Args { const void* in[N_IN]; float* out; unsigned char* ws; int ph_lo, ph_hi, li, pad; };
struct Ctx {
    LAS unsigned char* lds; int tid, lane, wave, vcu, G, gw, NGW;
    unsigned char* ws; float* out;
};

template <class FN> __device__ __forceinline__ void tr_item(const float* W, int srcN, bf16* WT, int K, int k0, int n0, LAS float* scr, int lane, FN srccol) {
    const int sc = srccol(n0 + (lane & 31));
    float tv[32];
#pragma unroll
    for (int i = 0; i < 32; ++i) { const int kk = 2 * i + (lane >> 5); tv[i] = sc >= 0 ? W[(size_t)(k0 + kk) * srcN + sc] : 0.f; }
#pragma unroll
    for (int i = 0; i < 32; ++i) { const int kk = 2 * i + (lane >> 5); scr[kk * 33 + (lane & 31)] = tv[i]; }
    LDS_WAIT(); asm volatile("" ::: "memory");
    const int c = lane & 7;
#pragma unroll
    for (int j = 0; j < 4; ++j) { const int n = (lane >> 3) + 8 * j; const LAS float* s = scr + (8 * c) * 33 + n;
        v4u o; o.x = pk2(s[0 * 33], s[1 * 33]); o.y = pk2(s[2 * 33], s[3 * 33]); o.z = pk2(s[4 * 33], s[5 * 33]); o.w = pk2(s[6 * 33], s[7 * 33]);
        *(GAS v4u*)(WT + (size_t)(n0 + n) * K + k0 + 8 * c) = o; }
    LDS_WAIT(); asm volatile("" ::: "memory");
}
__device__ __forceinline__ int win_src(int n) { return n < 384 ? n : n < 416 ? n + 256 : n < 448 ? n + 6400 : n < 512 ? -1 : n < 768 ? n - 128 : n < 6912 ? n - 96 : n - 64; }
__device__ __forceinline__ int wuq_src(int n) { const int h = n / 96, j = n - h * 96; if (j < 64) return n; const int jj = j - 64; return h * 96 + 64 + (jj >> 1) + 16 * (jj & 1); }
__device__ __forceinline__ int id_src(int n) { return n; }

__device__ __forceinline__ void ph0_prologue(const Ctx& X, const Args& a, const int part) {
    unsigned char* ws = X.ws;
    LAS float* scr = (LAS float*)(X.lds + RING_OFF + X.wave * 16384);
    constexpr int I0 = 16 * 280, I1 = 6 * 48, I2 = 4 * 32, I3 = 4 * 32, I4 = 16 * 32, I5 = 32 * 32, I6 = 16 * 32, I7 = 16 * 128, I8 = 64 * 32;
    constexpr int NITEMS = I0 + I1 + I2 + I3 + I4 + I5 + I6 + I7 + I8;
    constexpr int NEARLY = I0 + I1 + I2 + I3;
    for (int it = (part == 0 ? 0 : NEARLY) + X.gw; it < (part == 0 ? NEARLY : NITEMS); it += X.NGW) {
        int r = it;
        if (r < I0) { tr_item((const float*)a.in[I_WIN], 8896, (bf16*)(ws + WS_WIN), 1024, 64 * (r / 280), 32 * (r % 280), scr, X.lane, win_src); continue; } r -= I0;
        if (r < I1) { tr_item((const float*)a.in[I_WUQ], 1536, (bf16*)(ws + WS_WUQ), 384, 64 * (r / 48), 32 * (r % 48), scr, X.lane, wuq_src); continue; } r -= I1;
        if (r < I2) { tr_item((const float*)a.in[I_WUK], 1024, (bf16*)(ws + WS_WUKV), 256, 64 * (r / 32), 32 * (r % 32), scr, X.lane, id_src); continue; } r -= I2;
        if (r < I3) { tr_item((const float*)a.in[I_WUV], 1024, (bf16*)(ws + WS_WUKV) + (size_t)1024 * 256, 256, 64 * (r / 32), 32 * (r % 32), scr, X.lane, id_src); continue; } r -= I3;
        if (r < I4) { tr_item((const float*)a.in[I_WBRA], 1024, (bf16*)(ws + WS_WBRA), 1024, 64 * (r / 32), 32 * (r % 32), scr, X.lane, id_src); continue; } r -= I4;
        if (r < I5) { tr_item((const float*)a.in[I_WBRS], 1024, (bf16*)(ws + WS_WBRS), 2048, 64 * (r / 32), 32 * (r % 32), scr, X.lane, id_src); continue; } r -= I5;
        if (r < I6) { tr_item((const float*)a.in[I_WOUT], 1024, (bf16*)(ws + WS_WOUT), 1024, 64 * (r / 32), 32 * (r % 32), scr, X.lane, id_src); continue; } r -= I6;
        if (r < I7) { tr_item((const float*)a.in[I_WUP], 4096, (bf16*)(ws + WS_WUP), 1024, 64 * (r / 128), 32 * (r % 128), scr, X.lane, id_src); continue; } r -= I7;
        tr_item((const float*)a.in[I_WDN], 1024, (bf16*)(ws + WS_WDN), 4096, 64 * (r / 32), 32 * (r % 32), scr, X.lane, id_src);
    }
    if (part != 0) return;
    {
        const GAS f32x4* gp = (const GAS f32x4*)a.in[I_GPRE] + X.lane; f32x4 g[4];
#pragma unroll
        for (int j = 0; j < 4; ++j) g[j] = gp[64 * j];
        bf16* XN = (bf16*)(ws + WS_XN);
        for (int m0 = X.gw; m0 < MP; m0 += 2 * X.NGW) {
            int mm[2]; mm[0] = m0; mm[1] = m0 + X.NGW < MP ? m0 + X.NGW : m0;
            f32x4 v[2][4];
#pragma unroll
            for (int q = 0; q < 2; ++q) { const int m = mm[q];
                if (m < MR) { const float* xrow = m < MPR ? (const float*)a.in[I_XP] + (size_t)m * DM : (const float*)a.in[I_XS] + (size_t)(m - MPR) * DM;
                    const GAS f32x4* xr = (const GAS f32x4*)xrow + X.lane;
#pragma unroll
                    for (int j = 0; j < 4; ++j) v[q][j] = xr[64 * j]; }
                else {
#pragma unroll
                    for (int j = 0; j < 4; ++j) v[q][j] = (f32x4){0.f, 0.f, 0.f, 0.f}; } }
#pragma unroll
            for (int q = 0; q < 2; ++q) { const int m = mm[q]; float s = 0.f;
#pragma unroll
                for (int j = 0; j < 4; ++j) s += (v[q][j].x * v[q][j].x + v[q][j].y * v[q][j].y) + (v[q][j].z * v[q][j].z + v[q][j].w * v[q][j].w);
                const float rs = rsqrtf(wave_sum(s) * (1.f / DM) + EPS);
                GAS unsigned long long* o8 = (GAS unsigned long long*)(XN + (size_t)m * DM) + X.lane;
#pragma unroll
                for (int j = 0; j < 4; ++j) { const f32x4 t = v[q][j] * rs * g[j]; o8[64 * j] = (unsigned long long)pk2(t.x, t.y) | ((unsigned long long)pk2(t.z, t.w) << 32); } }
        }
    }
    {
        float* tab = (float*)(ws + WS_TAB);
        for (int e = X.gw * 64 + X.lane; e < 2049 * 16; e += X.NGW * 64) {
            const int pidx = e >> 4, i = e & 15; const float pos = (float)(pidx < 2048 ? pidx : PAST);
            float s, c; sincosf(pos * INV_FREQ[i], &s, &c);
            tab[2 * e] = c; tab[2 * e + 1] = s;
        }
    }
}

__device__ __forceinline__ float softplus(float x) { return x > 20.f ? x : log1pf(__expf(x)); }
__device__ __forceinline__ float silu(float x) { return x * pg8::sigm(x); }
__device__ __forceinline__ f32x2 silu2(f32x2 x) {
    const f32x2 t = x * (f32x2){-1.4426950408889634f, -1.4426950408889634f};
    const f32x2 d = (f32x2){__builtin_amdgcn_exp2f(t.x), __builtin_amdgcn_exp2f(t.y)} + (f32x2){1.f, 1.f};
    return x * (f32x2){__builtin_amdgcn_rcpf(d.x), __builtin_amdgcn_rcpf(d.y)};
}
__device__ __forceinline__ void ph2_token(const Ctx& X, const Args& a) {
    unsigned char* ws = X.ws; const int lane = X.lane;
    const bf16* PF = (const bf16*)(ws + WS_PF); const bf16* PB = (const bf16*)(ws + WS_PB);
    bf16* CQ = (bf16*)(ws + WS_CQ); bf16* CKV = (bf16*)(ws + WS_CKV); bf16* KPE = (bf16*)(ws + WS_KPE); float* DT = (float*)(ws + WS_DT); bf16* XBC = (bf16*)(ws + WS_XBC);
    const float* tab = (const float*)(ws + WS_TAB);
    {
        const float* gq = (const float*)a.in[I_GQ]; const float* gkv = (const float*)a.in[I_GKV]; const float* dtb = (const float*)a.in[I_DTB];
        f32x2 gqv[3];
#pragma unroll
        for (int j = 0; j < 3; ++j) gqv[j] = *(const f32x2*)(gq + 2 * lane + 128 * j);
        const f32x4 gk = *(const f32x4*)(gkv + 4 * lane);
        const float dbias = dtb[lane & 31];
        for (int row0 = X.gw; row0 < MR; row0 += 4 * X.NGW) {
            unsigned qw[4][3]; v2u kw[4]; bf16 vv[4]; f32x2 cs[4];
#pragma unroll
            for (int r = 0; r < 4; ++r) { const int row = row0 + r * X.NGW < MR ? row0 + r * X.NGW : row0; const bf16* pf = PF + (size_t)row * NPF;
#pragma unroll
                for (int j = 0; j < 3; ++j) qw[r][j] = *(const unsigned*)(pf + 2 * lane + 128 * j);
                kw[r] = *(const v2u*)(pf + 512 + 4 * lane); vv[r] = pf[384 + lane];
                cs[r] = *(const f32x2*)(tab + ((size_t)(row < MPR ? (row & (SEQ - 1)) : 2048) * 16 + (lane & 15)) * 2); }
#pragma unroll
            for (int r = 0; r < 4; ++r) {
                const int row = row0 + r * X.NGW;
                if (row < MR) {
                    f32x2 q[3]; float s = 0.f;
#pragma unroll
                    for (int j = 0; j < 3; ++j) { q[j] = (f32x2){bflo(qw[r][j]), bfhi(qw[r][j])}; s += q[j].x * q[j].x + q[j].y * q[j].y; }
                    const f32x4 k = (f32x4){bflo(kw[r].x), bfhi(kw[r].x), bflo(kw[r].y), bfhi(kw[r].y)};
                    const float v = bf1(vv[r]);
                    float s2 = (k.x * k.x + k.y * k.y) + (k.z * k.z + k.w * k.w);
#pragma unroll
                    for (int o = 1; o < 64; o <<= 1) { s += __shfl_xor(s, o); s2 += __shfl_xor(s2, o); }
                    const float rs = rsqrtf(s * (1.f / 384.f) + EPS), rs2 = rsqrtf(s2 * (1.f / 256.f) + EPS);
#pragma unroll
                    for (int j = 0; j < 3; ++j) *(unsigned*)(CQ + (size_t)row * 384 + 2 * lane + 128 * j) = pk2(q[j].x * rs * gqv[j].x, q[j].y * rs * gqv[j].y);
                    const f32x4 c = k * rs2 * gk;
                    float* okv = row < MPR ? X.out + O_KVP + (size_t)row * 256 : X.out + O_KVS + (size_t)(row - MPR) * 256;
                    *(f32x4*)(okv + 4 * lane) = c;
                    v2u cw; cw.x = pk2(c.x, c.y); cw.y = pk2(c.z, c.w); *(v2u*)(CKV + (size_t)row * 256 + 4 * lane) = cw;
                    const float partner = __shfl_xor(v, 16);
                    if (lane < 32) {
                        const int i = lane & 15;
                        const float o = lane < 16 ? v * cs[r].x - partner * cs[r].y : partner * cs[r].y + v * cs[r].x;
                        float* okr = row < MPR ? X.out + O_KRP + (size_t)row * 32 : X.out + O_KRS + (size_t)(row - MPR) * 32;
                        okr[lane] = o;
                        KPE[(size_t)row * 32 + 2 * i + (lane >> 4)] = (bf16)(pk2(o, 0.f) & 0xffffu);
                    } else {
                        DT[(size_t)row * 32 + (lane - 32)] = softplus(v + dbias);
                    }
                }
            }
        }
    }
    {
        const float* wc = (const float*)a.in[I_WCONV]; const float* bc = (const float*)a.in[I_BCONV];
        for (int item = X.gw; item < 2048 + 1024; item += X.NGW) {
            const bool smp = item >= 2048;
            const int sl = item & 7, ch = sl * 512 + 8 * lane;
            float w[4][8], bias[8];
#pragma unroll
            for (int k = 0; k < 4; ++k) { const f32x4 w0 = *(const f32x4*)(wc + k * 4096 + ch), w1 = *(const f32x4*)(wc + k * 4096 + ch + 4);
                w[k][0] = w0.x; w[k][1] = w0.y; w[k][2] = w0.z; w[k][3] = w0.w; w[k][4] = w1.x; w[k][5] = w1.y; w[k][6] = w1.z; w[k][7] = w1.w; }
            { const f32x4 b0 = *(const f32x4*)(bc + ch), b1 = *(const f32x4*)(bc + ch + 4); bias[0] = b0.x; bias[1] = b0.y; bias[2] = b0.z; bias[3] = b0.w; bias[4] = b1.x; bias[5] = b1.y; bias[6] = b1.z; bias[7] = b1.w; }
            float r3[8], r2[8], r1[8], cur[8], y[8];
            if (!smp) {
                const int row_s = (item >> 3) * 64;
                if ((row_s & (SEQ - 1)) == 0) {
#pragma unroll
                    for (int j = 0; j < 8; ++j) { r3[j] = 0.f; r2[j] = 0.f; r1[j] = 0.f; }
                } else {
                    const v4u h3 = *(const v4u*)(PB + (size_t)(row_s - 3) * NPB + PB_XBC + ch), h2 = *(const v4u*)(PB + (size_t)(row_s - 2) * NPB + PB_XBC + ch), h1 = *(const v4u*)(PB + (size_t)(row_s - 1) * NPB + PB_XBC + ch);
                    unpack8(h3, r3); unpack8(h2, r2); unpack8(h1, r1);
                }
                v4u rawv[2][8];
#pragma unroll
                for (int t = 0; t < 8; ++t) rawv[0][t] = *(const v4u*)(PB + (size_t)(row_s + t) * NPB + PB_XBC + ch);
#pragma unroll
                for (int bt = 0; bt < 8; ++bt) {
                    if (bt < 7) {
#pragma unroll
                        for (int t = 0; t < 8; ++t) rawv[(bt + 1) & 1][t] = *(const v4u*)(PB + (size_t)(row_s + 8 * (bt + 1) + t) * NPB + PB_XBC + ch);
                    }
#pragma unroll
                    for (int t = 0; t < 8; t += 4) asm volatile("" : "+v"(rawv[bt & 1][t]), "+v"(rawv[bt & 1][t + 1]), "+v"(rawv[bt & 1][t + 2]), "+v"(rawv[bt & 1][t + 3]) :: "memory");
#pragma unroll
                    for (int t = 0; t < 8; ++t) {
                        unpack8(rawv[bt & 1][t], cur);
#pragma unroll
                        for (int p = 0; p < 4; ++p) {
                            f32x2 acc = (f32x2){bias[2 * p], bias[2 * p + 1]};
                            acc = __builtin_elementwise_fma((f32x2){w[0][2 * p], w[0][2 * p + 1]}, (f32x2){r3[2 * p], r3[2 * p + 1]}, acc);
                            acc = __builtin_elementwise_fma((f32x2){w[1][2 * p], w[1][2 * p + 1]}, (f32x2){r2[2 * p], r2[2 * p + 1]}, acc);
                            acc = __builtin_elementwise_fma((f32x2){w[2][2 * p], w[2][2 * p + 1]}, (f32x2){r1[2 * p], r1[2 * p + 1]}, acc);
                            acc = __builtin_elementwise_fma((f32x2){w[3][2 * p], w[3][2 * p + 1]}, (f32x2){cur[2 * p], cur[2 * p + 1]}, acc);
                            const f32x2 tt = acc * (f32x2){-1.4426950408889634f, -1.4426950408889634f};
                            const f32x2 dd = (f32x2){__builtin_amdgcn_exp2f(tt.x), __builtin_amdgcn_exp2f(tt.y)} + (f32x2){1.f, 1.f};
                            const f32x2 yy = acc * (f32x2){__builtin_amdgcn_rcpf(dd.x), __builtin_amdgcn_rcpf(dd.y)};
                            y[2 * p] = yy.x; y[2 * p + 1] = yy.y;
                        }
#pragma unroll
                        for (int j = 0; j < 8; ++j) { r3[j] = r2[j]; r2[j] = r1[j]; r1[j] = cur[j]; }
                        *(v4u*)(XBC + (size_t)(row_s + 8 * bt + t) * 4096 + ch) = pack8(y);
                    }
                }
            } else {
                const int b = (item - 2048) >> 3, row = MPR + b;
                const float* sc = (const float*)a.in[I_CONV] + (size_t)b * 3 * 4096 + ch;
                float* oc = X.out + O_CVS + (size_t)b * 3 * 4096 + ch;
#pragma unroll
                for (int j = 0; j < 8; ++j) { r3[j] = sc[j]; r2[j] = sc[4096 + j]; r1[j] = sc[8192 + j]; }
                unpack8(*(const v4u*)(PB + (size_t)row * NPB + PB_XBC + ch), cur);
#pragma unroll
                for (int j = 0; j < 8; ++j) { const float acc = bias[j] + w[0][j] * r3[j] + w[1][j] * r2[j] + w[2][j] * r1[j] + w[3][j] * cur[j]; y[j] = silu(acc); oc[j] = r2[j]; oc[4096 + j] = r1[j]; oc[8192 + j] = cur[j]; }
                *(v4u*)(XBC + (size_t)row * 4096 + ch) = pack8(y);
            }
        }
        for (int item = X.gw; item < NBAT * 3 * 8; item += X.NGW) {
            const int sl = item & 7, k = (item >> 3) % 3, b = item / 24, ch = sl * 512 + 8 * lane;
            float cur[8]; unpack8(*(const v4u*)(PB + (size_t)(b * SEQ + SEQ - 3 + k) * NPB + PB_XBC + ch), cur);
            float* oc = X.out + O_CVP + (size_t)(b * 3 + k) * 4096 + ch;
            *(f32x4*)oc = (f32x4){cur[0], cur[1], cur[2], cur[3]}; *(f32x4*)(oc + 4) = (f32x4){cur[4], cur[5], cur[6], cur[7]};
        }
    }
}

__device__ __forceinline__ int tr_lane_off(int lane) { return (4 * (lane >> 5) + ((lane & 15) >> 2)) * 64 + ((lane >> 4) & 1) * 32 + (lane & 3) * 8; }
__device__ __forceinline__ bf16x8 tr_frag(const LAS unsigned char* piece, int lo) { const bf16x4 a = vtr(piece + lo), b = vtr(piece + lo + 512); return JOIN8(a, b); }
__device__ __forceinline__ void scan128(float v0, float v1, int lane, float& c0, float& c1, float& tot) {
    const float s = v0 + v1; float incl = s;
#pragma unroll
    for (int o = 1; o < 64; o <<= 1) { const float t = __shfl_up(incl, o); if (lane >= o) incl += t; }
    const float excl = incl - s; c0 = excl + v0; c1 = excl + s; tot = __shfl(incl, 63);
}

__device__ __forceinline__ void ssd_passA_all(const Ctx& X, const Args& a) {
    unsigned char* ws = X.ws; const int lane = X.lane, tid = X.tid, wave = X.wave;
    const bf16* XBC = (const bf16*)(ws + WS_XBC); const float* DT = (const float*)(ws + WS_DT); float* CS = (float*)(ws + WS_CS);
    LAS unsigned char* L = X.lds;
    LAS float* sc = (LAS float*)(X.lds + EXTRA_OFF);
    const int hh = wave >> 1, nh = wave & 1, lo = tr_lane_off(lane), hi = lane >> 5, r32 = lane & 31;
    unsigned voB = (unsigned)((tid >> 4) * 8192 + (tid & 15) * 16), voX = (unsigned)((tid >> 5) * 8192 + (tid & 31) * 16), voD = (unsigned)((2 * lane * 32 + (wave & 3)) * 4);
    v4u bv[4], xv[8]; float d0, d1, al;
#define PA_PREFETCH(item_) do { const int g_ = (item_) & 7, c_ = ((item_) >> 3) & 15, b_ = (item_) >> 7, row0_ = b_ * SEQ + c_ * 128; \
        const char* sb_ = (const char*)XBC + ((size_t)row0_ * 4096 + 2048 + g_ * 128) * 2; const char* sx_ = (const char*)XBC + ((size_t)row0_ * 4096 + g_ * 256) * 2; \
        _Pragma("unroll") for (int i = 0; i < 4; ++i) bv[i] = *(const v4u*)(sb_ + (size_t)i * 262144 + voB); \
        _Pragma("unroll") for (int i = 0; i < 8; ++i) xv[i] = *(const v4u*)(sx_ + (size_t)i * 131072 + voX); \
        const char* sd_ = (const char*)DT + ((size_t)row0_ * 32 + 4 * g_) * 4; d0 = *(const float*)(sd_ + voD); d1 = *(const float*)(sd_ + voD + 128); al = ((const float*)a.in[I_ALOG])[4 * g_ + (wave & 3)]; } while (0)
    { const int first = X.vcu < 1024 ? X.vcu : 0; PA_PREFETCH(first); }
    for (int item = X.vcu; item < 1024; item += X.G) {
        const int g = item & 7, c = (item >> 3) & 15, b = item >> 7, row0 = b * SEQ + c * 128;
        asm volatile("" : "+v"(voB), "+v"(voX), "+v"(voD));
        if (wave < 4) {
            const int h = 4 * g + wave; const float av = -__expf(al);
            float c0, c1, tot; scan128(d0 * av, d1 * av, lane, c0, c1, tot);
            sc[wave * 128 + 2 * lane] = __expf(tot - c0) * d0; sc[wave * 128 + 2 * lane + 1] = __expf(tot - c1) * d1;
            CS[(size_t)(row0 + 2 * lane) * 32 + h] = c0; CS[(size_t)(row0 + 2 * lane + 1) * 32 + h] = c1;
            if (lane == 0) ((float*)(ws + WS_CD))[(b * 16 + c) * 32 + h] = __expf(tot);
        }
        int tl = tid; asm volatile("" : "+v"(tl));
#pragma unroll
        for (int i = 0; i < 4; ++i) {
            const int q = tl + 512 * i, s_ = q >> 4, n = (q & 15) * 8;
            *(LAS v4u*)(L + ((n >> 5) * 8 + (s_ >> 4)) * 1024 + (s_ & 15) * 64 + (n & 31) * 2) = bv[i];
        }
        __syncthreads();
#pragma unroll
        for (int i = 0; i < 8; ++i) {
            const int q = tl + 512 * i, s_ = q >> 5, col = (q & 31) * 8, h_ = col >> 6, p = col & 63;
            float f[8]; unpack8(xv[i], f);
            const float scale = sc[h_ * 128 + s_];
#pragma unroll
            for (int j = 0; j < 8; ++j) f[j] *= scale;
            *(LAS v4u*)(L + 32768 + h_ * 16384 + ((p >> 5) * 8 + (s_ >> 4)) * 1024 + (s_ & 15) * 64 + (p & 31) * 2) = pack8(f);
        }
        __syncthreads();
        { const int nxt = item + X.G < 1024 ? item + X.G : item; PA_PREFETCH(nxt); }
        f32x16 acc[2][2];
#pragma unroll
        for (int i = 0; i < 2; ++i)
#pragma unroll
            for (int j = 0; j < 2; ++j)
#pragma unroll
                for (int r = 0; r < 16; ++r) acc[i][j][r] = 0.f;
#pragma unroll
        for (int ks = 0; ks < 8; ++ks) {
            const bf16x8 a0 = tr_frag(L + 32768 + hh * 16384 + (0 * 8 + ks) * 1024, lo), a1 = tr_frag(L + 32768 + hh * 16384 + (1 * 8 + ks) * 1024, lo);
            const bf16x8 b0 = tr_frag(L + ((2 * nh + 0) * 8 + ks) * 1024, lo), b1 = tr_frag(L + ((2 * nh + 1) * 8 + ks) * 1024, lo);
            acc[0][0] = __builtin_amdgcn_mfma_f32_32x32x16_bf16(a0, b0, acc[0][0], 0, 0, 0); acc[0][1] = __builtin_amdgcn_mfma_f32_32x32x16_bf16(a0, b1, acc[0][1], 0, 0, 0);
            acc[1][0] = __builtin_amdgcn_mfma_f32_32x32x16_bf16(a1, b0, acc[1][0], 0, 0, 0); acc[1][1] = __builtin_amdgcn_mfma_f32_32x32x16_bf16(a1, b1, acc[1][1], 0, 0, 0);
        }
        bf16* dst = (bf16*)(ws + WS_LOC) + (size_t)((b * 16 + c) * 32 + 4 * g + hh) * 8192;
#pragma unroll
        for (int pt = 0; pt < 2; ++pt)
#pragma unroll
            for (int nt = 0; nt < 2; ++nt)
#pragma unroll
                for (int r = 0; r < 16; ++r) dst[(32 * pt + crow(r, hi)) * 128 + 64 * nh + 32 * nt + r32] = (bf16)(pk2(acc[pt][nt][r], 0.f) & 0xffffu);
        __syncthreads();
    }
#undef PA_PREFETCH
}

__device__ __forceinline__ void ssd_passB(const Ctx& X) {
    unsigned char* ws = X.ws;
    const bf16* LOC = (const bf16*)(ws + WS_LOC); const float* CD = (const float*)(ws + WS_CD); bf16* PREV = (bf16*)(ws + WS_PREV);
    const int nthr = X.G * 512;
    const int NE = NBAT * 32 * 64 * 32;
    v2u lw[16]; float cd[16];
#define PB_LOAD(e_) do { const int n4_ = (e_) & 31, p_ = ((e_) >> 5) & 63, h_ = ((e_) >> 11) & 31, b_ = (e_) >> 16; \
        _Pragma("unroll") for (int c = 0; c < 16; ++c) { lw[c] = *(const v2u*)(LOC + (size_t)((b_ * 16 + c) * 32 + h_) * 8192 + p_ * 128 + 4 * n4_); cd[c] = CD[(b_ * 16 + c) * 32 + h_]; } } while (0)
    { const int e0 = X.vcu * 512 + X.tid; PB_LOAD(e0 < NE ? e0 : 0); }
    for (int e = X.vcu * 512 + X.tid; e < NE; e += nthr) {
        const int n4 = e & 31, p = (e >> 5) & 63, h = (e >> 11) & 31, b = e >> 16;
        f32x4 loc[16]; float cdc[16];
#pragma unroll
        for (int c = 0; c < 16; ++c) { loc[c] = (f32x4){bflo(lw[c].x), bfhi(lw[c].x), bflo(lw[c].y), bfhi(lw[c].y)}; cdc[c] = cd[c]; }
#pragma unroll
        for (int c = 0; c < 16; c += 4) asm volatile("" : "+v"(loc[c]), "+v"(loc[c + 1]), "+v"(loc[c + 2]), "+v"(loc[c + 3]), "+v"(cdc[c]), "+v"(cdc[c + 1]), "+v"(cdc[c + 2]), "+v"(cdc[c + 3]) :: "memory");
        { const int en = e + nthr < NE ? e + nthr : e; PB_LOAD(en); }
        f32x4 st = (f32x4){0.f, 0.f, 0.f, 0.f};
#pragma unroll
        for (int c = 0; c < 16; ++c) {
            v2u w; w.x = pk2(st.x, st.y); w.y = pk2(st.z, st.w);
            *(v2u*)(PREV + (size_t)((b * 16 + c) * 32 + h) * 8192 + p * 128 + 4 * n4) = w;
            st = st * cdc[c] + loc[c];
        }
        *(f32x4*)(X.out + O_SSP + (size_t)((b * 32 + h) * 64 + p) * 128 + 4 * n4) = st;
    }
#undef PB_LOAD
}

__device__ __forceinline__ void ssd_passC_all(const Ctx& X, const Args& a) {
    unsigned char* ws = X.ws; const int lane = X.lane, tid = X.tid, wave = X.wave;
    const bf16* XBC = (const bf16*)(ws + WS_XBC); const float* DT = (const float*)(ws + WS_DT); const bf16* PB = (const bf16*)(ws + WS_PB);
    const float* CS = (const float*)(ws + WS_CS); const bf16* PREV = (const bf16*)(ws + WS_PREV); bf16* OS = (bf16*)(ws + WS_OS);
    LAS unsigned char* L = X.lds;
    LAS float* cs = (LAS float*)(X.lds + EXTRA_OFF);
    LAS float* dts = cs + 512;
    const int hh = wave >> 1, wsel = wave & 1, lo = tr_lane_off(lane), hi = lane >> 5, r32 = lane & 31;
    const LAS float* csh = cs + hh * 128; const LAS float* dth = dts + hh * 128;
    const int lt_[2] = {wsel ? 1 : 0, wsel ? 2 : 3};
    v4u cbv[4], bbv[4], xv[8]; float csv, dtv;
    unsigned voCB = (unsigned)((tid >> 4) * 8192 + (tid & 15) * 16), voX = (unsigned)((tid >> 5) * 8192 + (tid & 31) * 16), voS = (unsigned)(((tid & 127) * 32 + (tid >> 7)) * 4), voP = (unsigned)((r32 * 128 + 8 * hi) * 2);
#define PC_PREFETCH(item_) do { const int g_ = (item_) & 7, c_ = ((item_) >> 3) & 15, b_ = (item_) >> 7, row0_ = b_ * SEQ + c_ * 128; \
        const char* sb_ = (const char*)XBC + ((size_t)row0_ * 4096 + g_ * 128) * 2; const char* sx_ = (const char*)XBC + ((size_t)row0_ * 4096 + g_ * 256) * 2; \
        _Pragma("unroll") for (int i = 0; i < 4; ++i) { cbv[i] = *(const v4u*)(sb_ + (size_t)i * 262144 + 6144 + voCB); bbv[i] = *(const v4u*)(sb_ + (size_t)i * 262144 + 4096 + voCB); } \
        _Pragma("unroll") for (int i = 0; i < 8; ++i) xv[i] = *(const v4u*)(sx_ + (size_t)i * 131072 + voX); \
        csv = *(const float*)((const char*)CS + ((size_t)row0_ * 32 + 4 * g_) * 4 + voS); dtv = *(const float*)((const char*)DT + ((size_t)row0_ * 32 + 4 * g_) * 4 + voS); \
        } while (0)
    { const int first = X.vcu < 1024 ? X.vcu : 0; PC_PREFETCH(first); }
    for (int item = X.vcu; item < 1024; item += X.G) {
        const int g = item & 7, c = (item >> 3) & 15, b = item >> 7, row0 = b * SEQ + c * 128;
        asm volatile("" : "+v"(voCB), "+v"(voX), "+v"(voS), "+v"(voP));
        const bf16* prev_ = (const bf16*)((const char*)(PREV + (size_t)((b * 16 + c) * 32 + 4 * g + hh) * 8192) + voP);
        bf16x8 pfa[4], pfb[4];
#pragma unroll
        for (int ks = 0; ks < 4; ++ks) { pfa[ks] = *(const bf16x8*)(prev_ + 16 * ks); pfb[ks] = *(const bf16x8*)(prev_ + 4096 + 16 * ks); }
        int tl = tid; asm volatile("" : "+v"(tl));
        cs[tl] = csv; dts[tl] = dtv;
#pragma unroll
        for (int i = 0; i < 4; ++i) { const int q = tl + 512 * i, s_ = q >> 4, ch = q & 15; *(LAS v4u*)(L + ch * 2048 + s_ * 16) = cbv[i]; *(LAS v4u*)(L + 32768 + ch * 2048 + s_ * 16) = bbv[i]; }
#pragma unroll
        for (int i = 0; i < 8; ++i) { const int q = tl + 512 * i, s_ = q >> 5, col = (q & 31) * 8, h_ = col >> 6, p = col & 63;
            *(LAS v4u*)(L + 65536 + h_ * 16384 + ((p >> 5) * 8 + (s_ >> 4)) * 1024 + (s_ & 15) * 64 + (p & 31) * 2) = xv[i]; }
        bf16x8 pfc[4], pfd[4];
#pragma unroll
        for (int ks = 0; ks < 4; ++ks) { pfc[ks] = *(const bf16x8*)(prev_ + 16 * (ks + 4)); pfd[ks] = *(const bf16x8*)(prev_ + 4096 + 16 * (ks + 4)); }
        __syncthreads();
        f32x16 Z[2][2];
#pragma unroll
        for (int i = 0; i < 2; ++i)
#pragma unroll
            for (int j = 0; j < 2; ++j)
#pragma unroll
                for (int r = 0; r < 16; ++r) Z[i][j][r] = 0.f;
        if (c > 0) {
#pragma unroll
            for (int ks = 0; ks < 8; ++ks) {
                const bf16x8 p0 = ks < 4 ? pfa[ks & 3] : pfc[ks & 3], p1 = ks < 4 ? pfb[ks & 3] : pfd[ks & 3];
#pragma unroll
                for (int li = 0; li < 2; ++li) {
                    const bf16x8 af = *(const LAS bf16x8*)(L + (2 * ks + hi) * 2048 + (32 * lt_[li] + r32) * 16);
                    Z[li][0] = __builtin_amdgcn_mfma_f32_32x32x16_bf16(af, p0, Z[li][0], 0, 0, 0); Z[li][1] = __builtin_amdgcn_mfma_f32_32x32x16_bf16(af, p1, Z[li][1], 0, 0, 0);
                }
            }
#pragma unroll
            for (int li = 0; li < 2; ++li)
#pragma unroll
                for (int q4 = 0; q4 < 4; ++q4) { const f32x4 cv = *(const LAS f32x4*)(csh + 32 * lt_[li] + 8 * q4 + 4 * hi);
#pragma unroll
                    for (int j = 0; j < 4; ++j) { const float e = __expf(cv[j]); Z[li][0][4 * q4 + j] *= e; Z[li][1][4 * q4 + j] *= e; } }
        }
#pragma unroll
        for (int li = 0; li < 2; ++li) {
            const int lt = lt_[li]; const float csl = csh[32 * lt + r32];
            for (int st = 0; st <= lt; ++st) {
                f32x16 Xt;
#pragma unroll
                for (int r = 0; r < 16; ++r) Xt[r] = 0.f;
#pragma unroll
                for (int ks = 0; ks < 8; ++ks) {
                    const bf16x8 af = *(const LAS bf16x8*)(L + 32768 + (2 * ks + hi) * 2048 + (32 * st + r32) * 16);
                    const bf16x8 bf = *(const LAS bf16x8*)(L + (2 * ks + hi) * 2048 + (32 * lt + r32) * 16);
                    Xt = __builtin_amdgcn_mfma_f32_32x32x16_bf16(af, bf, Xt, 0, 0, 0);
                }
#pragma unroll
                for (int q4 = 0; q4 < 4; ++q4) { const f32x4 cv = *(const LAS f32x4*)(csh + 32 * st + 8 * q4 + 4 * hi); const f32x4 dv = *(const LAS f32x4*)(dth + 32 * st + 8 * q4 + 4 * hi);
#pragma unroll
                    for (int j = 0; j < 4; ++j) { const int sl = 8 * q4 + 4 * hi + j; const float wgt = (st < lt || sl <= r32) ? __expf(csl - cv[j]) * dv[j] : 0.f; Xt[4 * q4 + j] *= wgt; } }
                v4u pw0, pw1;
                pw0.x = pk2(Xt[0], Xt[1]); pw0.y = pk2(Xt[2], Xt[3]); pw0.z = pk2(Xt[4], Xt[5]); pw0.w = pk2(Xt[6], Xt[7]);
                pw1.x = pk2(Xt[8], Xt[9]); pw1.y = pk2(Xt[10], Xt[11]); pw1.z = pk2(Xt[12], Xt[13]); pw1.w = pk2(Xt[14], Xt[15]);
                const bf16x8 pa0 = __builtin_bit_cast(bf16x8, pw0), pa1 = __builtin_bit_cast(bf16x8, pw1);
                const LAS unsigned char* xi = L + 65536 + hh * 16384;
#pragma unroll
                for (int pt = 0; pt < 2; ++pt) {
                    const bf16x8 v0 = tr_frag(xi + (pt * 8 + 2 * st) * 1024, lo), v1 = tr_frag(xi + (pt * 8 + 2 * st + 1) * 1024, lo);
                    Z[li][pt] = __builtin_amdgcn_mfma_f32_32x32x16_bf16(pa0, v0, Z[li][pt], 0, 0, 0);
                    Z[li][pt] = __builtin_amdgcn_mfma_f32_32x32x16_bf16(pa1, v1, Z[li][pt], 0, 0, 0);
                }
            }
        }
        __syncthreads();
        { const int nxt = item + X.G < 1024 ? item + X.G : item; PC_PREFETCH(nxt); }
        {
            const float dsk = ((const float*)a.in[I_DSKIP])[4 * g + (lane >> 4)];
            const f32x4 gs = *(const f32x4*)((const float*)a.in[I_GSSM] + g * 256 + 4 * lane);
            LAS float* Y = (LAS float*)L;
            const int xh = lane >> 4, xp = 4 * (lane & 15);
            v2u zv16[2][8];
#pragma unroll
            for (int i = 0; i < 8; ++i) zv16[0][i] = *(const v2u*)(PB + (size_t)(row0 + 8 * wave + i) * NPB + PB_Z + g * 256 + 4 * lane);
#pragma unroll
            for (int hb = 0; hb < 2; ++hb) {
#pragma unroll
                for (int pt = 0; pt < 2; ++pt)
#pragma unroll
                    for (int r = 0; r < 16; ++r) Y[(32 * (lt_[hb] & 1) + crow(r, hi)) * 256 + hh * 64 + 32 * pt + r32] = Z[hb][pt][r];
                if (hb == 0) {
#pragma unroll
                    for (int i = 0; i < 8; ++i) zv16[1][i] = *(const v2u*)(PB + (size_t)(row0 + 64 + 8 * wave + i) * NPB + PB_Z + g * 256 + 4 * lane);
                }
                __syncthreads();
#pragma unroll
                for (int i1 = 0; i1 < 8; ++i1) {
                    const int lr = 8 * wave + i1, l = 64 * hb + lr, row = row0 + l;
                    const v2u zv = zv16[hb][i1];
                    const f32x4 y = *(const LAS f32x4*)(Y + lr * 256 + 4 * lane);
                    const v2u xw = *(const LAS v2u*)(L + 65536 + xh * 16384 + ((xp >> 5) * 8 + (l >> 4)) * 1024 + (l & 15) * 64 + (xp & 31) * 2);
                    f32x4 v;
                    { const f32x2 s01 = silu2((f32x2){bflo(zv.x), bfhi(zv.x)}), s23 = silu2((f32x2){bflo(zv.y), bfhi(zv.y)});
                      v.x = (y.x + dsk * bflo(xw.x)) * s01.x; v.y = (y.y + dsk * bfhi(xw.x)) * s01.y; v.z = (y.z + dsk * bflo(xw.y)) * s23.x; v.w = (y.w + dsk * bfhi(xw.y)) * s23.y; }
                    const float ss = wave_sum((v.x * v.x + v.y * v.y) + (v.z * v.z + v.w * v.w));
                    const float rs = rsqrtf(ss * (1.f / 256.f) + EPS);
                    v2u o; o.x = pk2(v.x * rs * gs.x, v.y * rs * gs.y); o.y = pk2(v.z * rs * gs.z, v.w * rs * gs.w);
                    *(v2u*)(OS + (size_t)row * 2048 + g * 256 + 4 * lane) = o;
                }
                __syncthreads();
            }
        }
    }
#undef PC_PREFETCH
}

constexpr int AT_NSLOT = 4, AT_SLOT = 20480, AT_WS = AT_NSLOT * AT_SLOT  , AT_OST = 86016;
#define AT_WAIT_BAR(N) asm volatile("s_waitcnt vmcnt(" #N ") lgkmcnt(0)\n\ts_barrier" ::: "memory")
#define AT_SB() __builtin_amdgcn_sched_barrier(0)
__device__ __forceinline__ void attn_unit(const Ctx& X, int b, int h, int qb, int nqb, bf16x8 (&qn)[6], bool first) {
    unsigned char* ws = X.ws; int lane = X.lane, wave = X.wave; asm volatile("" : "+v"(lane)); asm volatile("" : "+s"(wave));
    const int r32 = lane & 31, hi = lane >> 5;
    const bf16* Q = (const bf16*)(ws + WS_Q); const bf16* KNV = (const bf16*)(ws + WS_KNV); const bf16* KPE = (const bf16*)(ws + WS_KPE); bf16* OA = (bf16*)(ws + WS_OA);
    const size_t rowbase = (size_t)b * SEQ; const int q0 = qb * 256, NT = 4 * (qb + 1);
    LAS unsigned char* L = X.lds; const unsigned lds0 = (unsigned)(uintptr_t)L;
    LAS float* wsf = (LAS float*)(L + AT_WS) + wave * 64;
    const bf16* ksrc = KNV + (rowbase + lane) * 2048 + h * 64 + wave * 8;
    const bf16* rsrc = KPE + (rowbase + lane) * 32 + (wave & 3) * 8;
    const bf16* vsrc = KNV + (rowbase + 16 * (wave & 3) + (lane >> 2)) * 2048 + 1024 + h * 64 + (wave >> 2) * 32 + (lane & 3) * 8;
    const unsigned kdst = lds0 + wave * 1024, rdst = lds0 + (8 + (wave & 3)) * 1024, vdst = lds0 + 12288 + wave * 1024;
#define AT_DMA(t, slot) do { const unsigned so_ = (unsigned)(slot) * AT_SLOT; \
        glds16(ksrc + (size_t)(t) * 64 * 2048, (unsigned)__builtin_amdgcn_readfirstlane(kdst + so_)); \
        glds16(rsrc + (size_t)(t) * 64 * 32, (unsigned)__builtin_amdgcn_readfirstlane(rdst + so_)); \
        glds16(vsrc + (size_t)(t) * 64 * 2048, (unsigned)__builtin_amdgcn_readfirstlane(vdst + so_)); } while (0)
    if (first) { AT_DMA(0, 0); AT_DMA(1, 1); }
    bf16x8 qr[6];
    { const bf16* qp = Q + (rowbase + q0 + wave * 32 + r32) * QW + h * 96 + hi * 8;
#pragma unroll
      for (int d0 = 0; d0 < 6; ++d0) qr[d0] = first ? *(const bf16x8*)(qp + d0 * 16) : qn[d0];
#pragma unroll
      for (int d0 = 0; d0 < 6; ++d0) asm volatile("" : "+v"(qr[d0])); }
    float mhat = 0.f, l_run = 0.f; f32x16 o[2], pC0, pC1, pP0, pP1, negm;
#pragma unroll
    for (int r = 0; r < 16; ++r) { o[0][r] = 0.f; o[1][r] = 0.f; pP0[r] = 0.f; pP1[r] = 0.f; negm[r] = 0.f; }
    const int qrow = q0 + wave * 32 + r32, qmax_w = q0 + wave * 32 + 31;
    const int Tw = (qmax_w >> 6) < NT - 1 ? (qmax_w >> 6) : NT - 1;
    const int lo = tr_lane_off(lane);
    int slot = 0, pslot = 0;
#define AT_KRD(dst0, dst1, Ks_, d0_) do { dst0 = *(const LAS bf16x8*)((Ks_) + (2 * (d0_) + hi) * 1024 + r32 * 16); dst1 = *(const LAS bf16x8*)((Ks_) + (2 * (d0_) + hi) * 1024 + 512 + r32 * 16); } while (0)
#define AT_MASK(C0, C1, t_) do { if (64 * (t_) + 63 > q0 + wave * 32) { const int kb_ = 64 * (t_) + 4 * hi; \
        _Pragma("unroll") for (int r = 0; r < 16; ++r) { const int kv_ = kb_ + (r & 3) + 8 * (r >> 2); if (kv_ > qrow) C0[r] = -INFINITY; if (kv_ + 32 > qrow) C1[r] = -INFINITY; } } } while (0)
#define AT_ROWMAX(C0, C1, rm_) do { asm("v_max_f32 %0, %1, %2" : "=v"(rm_) : "v"(C0[0]), "v"(C1[0]));   \
        _Pragma("unroll") for (int r = 1; r < 16; ++r) asm("v_max3_f32 %0, %0, %1, %2" : "+v"(rm_) : "v"(C0[r]), "v"(C1[r])); rm_ = fmaxf(rm_, __shfl_xor(rm_, 32)); } while (0)
#define AT_SUM8(P_, B_) ((((f32x2){P_[B_], P_[B_ + 1]} + (f32x2){P_[B_ + 2], P_[B_ + 3]})) + (((f32x2){P_[B_ + 4], P_[B_ + 5]} + (f32x2){P_[B_ + 6], P_[B_ + 7]})))
#define AT_PACK(w_, P_, B_) do { w_.x = pk2(P_[B_], P_[B_ + 1]); w_.y = pk2(P_[B_ + 2], P_[B_ + 3]); w_.z = pk2(P_[B_ + 4], P_[B_ + 5]); w_.w = pk2(P_[B_ + 6], P_[B_ + 7]); } while (0)
    for (int t = 0; t < NT; ++t) {
        if (t + 1 < NT) { AT_WAIT_BAR(3); } else { AT_WAIT_BAR(0); }
        if (t + 2 < NT) { const int s2 = (slot + 2) & 3; AT_DMA(t + 2, s2); }
        if (nqb >= 0 && t == NT - 1) { AT_DMA(0, 0); AT_DMA(1, 1); }
        if (t <= Tw) {
            const LAS unsigned char* Ks = L + slot * AT_SLOT;
            if (t == 0) {
                bf16x8 ka0, ka1;
#pragma unroll
                for (int r = 0; r < 16; ++r) { pP0[r] = 0.f; pP1[r] = 0.f; }
#pragma unroll
                for (int d0 = 0; d0 < 6; ++d0) { AT_KRD(ka0, ka1, Ks, d0); pP0 = __builtin_amdgcn_mfma_f32_32x32x16_bf16(ka0, qr[d0], pP0, 0, 0, 0); pP1 = __builtin_amdgcn_mfma_f32_32x32x16_bf16(ka1, qr[d0], pP1, 0, 0, 0); }
                AT_MASK(pP0, pP1, 0);
                float rm; AT_ROWMAX(pP0, pP1, rm);
                mhat = rm;
#pragma unroll
                for (int r = 0; r < 16; ++r) negm[r] = -rm;
#pragma unroll
                for (int r = 0; r < 16; ++r) { pP0[r] = __builtin_amdgcn_exp2f(pP0[r] - rm); pP1[r] = __builtin_amdgcn_exp2f(pP1[r] - rm); }
            } else {
                const LAS unsigned char* Vp = L + pslot * AT_SLOT + 12288;
                bf16x8 ka0, ka1, kb0, kb1, va0, va1, vb0, vb1; v4u pw0, pw1, pw2, pw3; f32x2 sacc2;
                AT_KRD(ka0, ka1, Ks, 0); AT_KRD(kb0, kb1, Ks, 1); AT_SB();
                pC0 = __builtin_amdgcn_mfma_f32_32x32x16_bf16(ka0, qr[0], negm, 0, 0, 0); pC1 = __builtin_amdgcn_mfma_f32_32x32x16_bf16(ka1, qr[0], negm, 0, 0, 0);
                AT_KRD(ka0, ka1, Ks, 2);
                sacc2 = AT_SUM8(pP0, 0); AT_PACK(pw0, pP0, 0); AT_SB();
                pC0 = __builtin_amdgcn_mfma_f32_32x32x16_bf16(kb0, qr[1], pC0, 0, 0, 0); pC1 = __builtin_amdgcn_mfma_f32_32x32x16_bf16(kb1, qr[1], pC1, 0, 0, 0);
                AT_KRD(kb0, kb1, Ks, 3);
                sacc2 += AT_SUM8(pP0, 8); AT_PACK(pw1, pP0, 8); AT_SB();
                pC0 = __builtin_amdgcn_mfma_f32_32x32x16_bf16(ka0, qr[2], pC0, 0, 0, 0); pC1 = __builtin_amdgcn_mfma_f32_32x32x16_bf16(ka1, qr[2], pC1, 0, 0, 0);
                AT_KRD(ka0, ka1, Ks, 4);
                sacc2 += AT_SUM8(pP1, 0); AT_PACK(pw2, pP1, 0); AT_SB();
                pC0 = __builtin_amdgcn_mfma_f32_32x32x16_bf16(kb0, qr[3], pC0, 0, 0, 0); pC1 = __builtin_amdgcn_mfma_f32_32x32x16_bf16(kb1, qr[3], pC1, 0, 0, 0);
                AT_KRD(kb0, kb1, Ks, 5);
                sacc2 += AT_SUM8(pP1, 8); AT_PACK(pw3, pP1, 8); AT_SB();
                pC0 = __builtin_amdgcn_mfma_f32_32x32x16_bf16(ka0, qr[4], pC0, 0, 0, 0); pC1 = __builtin_amdgcn_mfma_f32_32x32x16_bf16(ka1, qr[4], pC1, 0, 0, 0);
                pC0 = __builtin_amdgcn_mfma_f32_32x32x16_bf16(kb0, qr[5], pC0, 0, 0, 0); pC1 = __builtin_amdgcn_mfma_f32_32x32x16_bf16(kb1, qr[5], pC1, 0, 0, 0);
                l_run += sacc2.x + sacc2.y;
                AT_MASK(pC0, pC1, t);
                float rm; AT_ROWMAX(pC0, pC1, rm);
                bool resc = false;
                if (__any(rm > 0.f)) {
                    const float dl = fmaxf(rm, 0.f); mhat += dl;
#pragma unroll
                    for (int r = 0; r < 16; ++r) negm[r] -= dl;
#pragma unroll
                    for (int r = 0; r < 16; ++r) { pC0[r] -= dl; pC1[r] -= dl; }
                    const float f = __builtin_amdgcn_exp2f(-dl); l_run *= f; if (hi == 0) wsf[r32] = f; resc = true;
                }
                AT_SB();
#define AT_EX4(C_, B_) do { C_[B_] = __builtin_amdgcn_exp2f(C_[B_]); C_[B_ + 1] = __builtin_amdgcn_exp2f(C_[B_ + 1]); C_[B_ + 2] = __builtin_amdgcn_exp2f(C_[B_ + 2]); C_[B_ + 3] = __builtin_amdgcn_exp2f(C_[B_ + 3]); } while (0)
                va0 = tr_frag(Vp, lo); va1 = tr_frag(Vp + 4096, lo); vb0 = tr_frag(Vp + 1024, lo); vb1 = tr_frag(Vp + 4096 + 1024, lo); AT_SB();
                o[0] = __builtin_amdgcn_mfma_f32_32x32x16_bf16(__builtin_bit_cast(bf16x8, pw0), va0, o[0], 0, 0, 0); AT_EX4(pC0, 0); AT_SB();
                o[1] = __builtin_amdgcn_mfma_f32_32x32x16_bf16(__builtin_bit_cast(bf16x8, pw0), va1, o[1], 0, 0, 0); AT_EX4(pC0, 4); va0 = tr_frag(Vp + 2048, lo); va1 = tr_frag(Vp + 4096 + 2048, lo); AT_SB();
                o[0] = __builtin_amdgcn_mfma_f32_32x32x16_bf16(__builtin_bit_cast(bf16x8, pw1), vb0, o[0], 0, 0, 0); AT_EX4(pC0, 8); AT_SB();
                o[1] = __builtin_amdgcn_mfma_f32_32x32x16_bf16(__builtin_bit_cast(bf16x8, pw1), vb1, o[1], 0, 0, 0); AT_EX4(pC0, 12); vb0 = tr_frag(Vp + 3072, lo); vb1 = tr_frag(Vp + 4096 + 3072, lo); AT_SB();
                o[0] = __builtin_amdgcn_mfma_f32_32x32x16_bf16(__builtin_bit_cast(bf16x8, pw2), va0, o[0], 0, 0, 0); AT_EX4(pC1, 0); AT_SB();
                o[1] = __builtin_amdgcn_mfma_f32_32x32x16_bf16(__builtin_bit_cast(bf16x8, pw2), va1, o[1], 0, 0, 0); AT_EX4(pC1, 4); AT_SB();
                o[0] = __builtin_amdgcn_mfma_f32_32x32x16_bf16(__builtin_bit_cast(bf16x8, pw3), vb0, o[0], 0, 0, 0); AT_EX4(pC1, 8); AT_SB();
                o[1] = __builtin_amdgcn_mfma_f32_32x32x16_bf16(__builtin_bit_cast(bf16x8, pw3), vb1, o[1], 0, 0, 0); AT_EX4(pC1, 12); AT_SB();
#undef AT_EX4
                if (resc) {
                    LDS_WAIT();
#pragma unroll
                    for (int q4 = 0; q4 < 4; ++q4) { const f32x4 av = *(const LAS f32x4*)(wsf + 8 * q4 + 4 * hi);
#pragma unroll
                        for (int j = 0; j < 4; ++j) { o[0][4 * q4 + j] *= av[j]; o[1][4 * q4 + j] *= av[j]; } }
                }
                pP0 = pC0; pP1 = pC1;
            }
            if (t == Tw) {
                const LAS unsigned char* Vs = Ks + 12288;
                float sacc = 0.f;
#pragma unroll
                for (int r = 0; r < 16; ++r) sacc += pP0[r] + pP1[r];
                l_run += sacc;
                v4u pw[4]; AT_PACK(pw[0], pP0, 0); AT_PACK(pw[1], pP0, 8); AT_PACK(pw[2], pP1, 0); AT_PACK(pw[3], pP1, 8);
#pragma unroll
                for (int ks = 0; ks < 4; ++ks) {
                    const bf16x8 pa = __builtin_bit_cast(bf16x8, pw[ks]);
                    const bf16x8 v0 = tr_frag(Vs + ks * 1024, lo), v1 = tr_frag(Vs + 4096 + ks * 1024, lo);
                    o[0] = __builtin_amdgcn_mfma_f32_32x32x16_bf16(pa, v0, o[0], 0, 0, 0); o[1] = __builtin_amdgcn_mfma_f32_32x32x16_bf16(pa, v1, o[1], 0, 0, 0);
                }
            }
        }
        pslot = slot; slot = (slot + 1) & 3;
    }
    if (nqb >= 0) { const bf16* qp = Q + (rowbase + nqb * 256 + wave * 32 + r32) * QW + h * 96 + hi * 8;
#pragma unroll
      for (int d0 = 0; d0 < 6; ++d0) qn[d0] = *(const bf16x8*)(qp + d0 * 16); }
    l_run += __shfl_xor(l_run, 32);
    if (hi == 0) wsf[32 + r32] = l_run;
    LDS_WAIT();
    {
        LAS bf16* stg = (LAS bf16*)(L + AT_OST + wave * 4096);
#pragma unroll
        for (int q4 = 0; q4 < 4; ++q4) { const f32x4 lv = *(const LAS f32x4*)(wsf + 32 + 8 * q4 + 4 * hi);
#pragma unroll
            for (int j = 0; j < 4; ++j) { const float inv = __builtin_amdgcn_rcpf(lv[j]); const int orow = 8 * q4 + 4 * hi + j;
                stg[orow * 64 + r32] = (bf16)(pk2(o[0][4 * q4 + j] * inv, 0.f) & 0xffffu); stg[orow * 64 + 32 + r32] = (bf16)(pk2(o[1][4 * q4 + j] * inv, 0.f) & 0xffffu); } }
        LDS_WAIT();
        bf16* Ow = OA + (rowbase + q0 + wave * 32) * 1024 + h * 64;
#pragma unroll
        for (int i = 0; i < 4; ++i) { const int row = i * 8 + (lane >> 3), ch = lane & 7; const v4u v = *(const LAS v4u*)(stg + row * 64 + ch * 8); *(v4u*)(Ow + (size_t)row * 1024 + ch * 8) = v; }
    }
    if (nqb < 0) { AT_WAIT_BAR(0); }
#undef AT_DMA
#undef AT_KRD
#undef AT_MASK
#undef AT_ROWMAX
#undef AT_PACK
}
constexpr int PART_STRIDE = 4096 + 32;
__device__ __forceinline__ void decode_unit(const Ctx& X, const Args& a, int unit) {
    unsigned char* ws = X.ws; int lane = X.lane, tid = X.tid, wave = X.wave; asm volatile("" : "+v"(lane)); asm volatile("" : "+v"(tid)); asm volatile("" : "+s"(wave));
    const int b = unit >> 1, sp = unit & 1;
    const bf16* Q = (const bf16*)(ws + WS_Q) + (size_t)(MPR + b) * QW;
    LAS unsigned char* L = X.lds;
    LAS float* qf = (LAS float*)L;
    LAS bf16* Qp = (LAS bf16*)(L + 8192);
    float* QL = (float*)(ws + WS_QL) + (size_t)b * 16 * 288;
    const int* pt = (const int*)a.in[I_PT] + b * NPAGES + 32 * sp + 4 * wave;
    int pages[4];
#pragma unroll
    for (int i = 0; i < 4; ++i) pages[i] = pt[i];
    { bf16 q3[3];
#pragma unroll
      for (int i = 0; i < 3; ++i) q3[i] = Q[tid + 512 * i];
#pragma unroll
      for (int i = 0; i < 3; ++i) qf[tid + 512 * i] = bf1(q3[i]); }
    __syncthreads();
    {
        const int h = tid >> 5, r8 = (tid & 31) * 8; const bf16* wt = (const bf16*)(ws + WS_WUKV) + (size_t)(h * 64) * 256 + r8;
        float acc8[8];
#pragma unroll
        for (int j = 0; j < 8; ++j) acc8[j] = 0.f;
#pragma unroll 1
        for (int d0 = 0; d0 < 64; d0 += 16) {
            v4u wv[16];
#pragma unroll
            for (int d = 0; d < 16; ++d) wv[d] = *(const v4u*)(wt + (size_t)(d0 + d) * 256);
#pragma unroll
            for (int d = 0; d < 16; ++d) { const float q = qf[h * 96 + d0 + d]; float w[8]; unpack8(wv[d], w);
#pragma unroll
                for (int j = 0; j < 8; ++j) acc8[j] += q * w[j]; }
        }
#pragma unroll
        for (int j = 0; j < 8; ++j) { Qp[h * 288 + r8 + j] = (bf16)(pk2(acc8[j], 0.f) & 0xffffu); if (sp == 0) QL[h * 288 + r8 + j] = acc8[j]; }
        if (tid < 256) { const int hh = tid >> 4, i = tid & 15; const float x1 = qf[hh * 96 + 64 + 2 * i], x2 = qf[hh * 96 + 64 + 2 * i + 1];
            Qp[hh * 288 + 256 + i] = (bf16)(pk2(x1, 0.f) & 0xffffu); Qp[hh * 288 + 272 + i] = (bf16)(pk2(x2, 0.f) & 0xffffu);
            if (sp == 0) { QL[hh * 288 + 256 + i] = x1; QL[hh * 288 + 272 + i] = x2; } }
    }
    __syncthreads();
    const int kl = lane & 15, kq = lane >> 4;
    const LAS bf16* qfp = Qp + kl * 288 + 8 * kq;
    LAS unsigned char* Vt = L + 32768 + wave * 9216;
    f32x4 acc[16];
#pragma unroll
    for (int nb = 0; nb < 16; ++nb) acc[nb] = (f32x4){0.f, 0.f, 0.f, 0.f};
    float m_run = -INFINITY, l_run = 0.f;
    const float* ckv = (const float*)a.in[I_CKV]; const float* cpe = (const float*)a.in[I_CPE];
    const int vwoff = (lane >> 3) * 1024 + (lane & 7) * 8, vroff = (4 * kq + (kl >> 2)) * 64 + (kl & 3) * 8, kroff = kl * 64 + kq * 16;
#pragma unroll
    for (int i = 0; i < 4; ++i) pages[i] = __builtin_amdgcn_readfirstlane(pages[i]);
    f32x4 raw[18];
#define DC_ISSUE(blk_) do { const int pg_ = (blk_) >> 3; const int page_ = pg_ == 0 ? pages[0] : pg_ == 1 ? pages[1] : pg_ == 2 ? pages[2] : pages[3]; \
        const float* kp_ = ckv + ((size_t)page_ * PAGE + ((blk_) & 7) * 16) * 256 + 4 * lane; const float* pp_ = cpe + ((size_t)page_ * PAGE + ((blk_) & 7) * 16) * 32 + 4 * lane; \
        _Pragma("unroll") for (int r = 0; r < 16; ++r) raw[r] = __builtin_nontemporal_load((const f32x4*)(kp_ + r * 256)); \
        raw[16] = __builtin_nontemporal_load((const f32x4*)pp_); raw[17] = __builtin_nontemporal_load((const f32x4*)(pp_ + 256)); } while (0)
    DC_ISSUE(0);
    for (int blk = 0; blk < 32; ++blk) {
#pragma unroll
        for (int r = 0; r < 16; ++r) { v2u w; w.x = pk2(raw[r].x, raw[r].y); w.y = pk2(raw[r].z, raw[r].w); *(LAS v2u*)(Vt + vwoff + r * 64) = w; }
        { v2u w; w.x = pk2(raw[16].x, raw[16].y); w.y = pk2(raw[16].z, raw[16].w); *(LAS v2u*)(Vt + 8192 + (lane >> 3) * 64 + (lane & 7) * 8) = w;
          w.x = pk2(raw[17].x, raw[17].y); w.y = pk2(raw[17].z, raw[17].w); *(LAS v2u*)(Vt + 8192 + 512 + (lane >> 3) * 64 + (lane & 7) * 8) = w; }
        asm volatile("" ::: "memory");
        if (blk + 1 < 32) DC_ISSUE(blk + 1);
        asm volatile("" ::: "memory");
        f32x4 st = (f32x4){0.f, 0.f, 0.f, 0.f};
#pragma unroll
        for (int ks = 0; ks < 9; ++ks) st = __builtin_amdgcn_mfma_f32_16x16x32_bf16(*(const LAS bf16x8*)(Vt + ks * 1024 + kroff), *(const LAS bf16x8*)(qfp + 32 * ks), st, 0, 0, 0);
        float bm = fmaxf(fmaxf(st[0], st[1]), fmaxf(st[2], st[3]));
        bm = fmaxf(bm, __shfl_xor(bm, 16)); bm = fmaxf(bm, __shfl_xor(bm, 32));
        const float m_new = fmaxf(m_run, bm);
        if (__any(m_new > m_run)) { const float al = __builtin_amdgcn_exp2f(m_run - m_new); l_run *= al;
#pragma unroll
            for (int nb = 0; nb < 16; ++nb) acc[nb] = acc[nb] * al;
            m_run = m_new; }
        f32x4 p; p.x = __builtin_amdgcn_exp2f(st[0] - m_run); p.y = __builtin_amdgcn_exp2f(st[1] - m_run); p.z = __builtin_amdgcn_exp2f(st[2] - m_run); p.w = __builtin_amdgcn_exp2f(st[3] - m_run);
        l_run += (p.x + p.y) + (p.z + p.w);
        v2u pw; pw.x = pk2(p.x, p.y); pw.y = pk2(p.z, p.w); const bf16x4 pf = __builtin_bit_cast(bf16x4, pw);
#pragma unroll
        for (int nb = 0; nb < 16; ++nb) { const bf16x4 vf = vtr(Vt + (nb >> 1) * 1024 + vroff + (nb & 1) * 32);
            acc[nb] = __builtin_amdgcn_mfma_f32_16x16x16bf16_1k(vf, pf, acc[nb], 0, 0, 0); }
        asm volatile("" ::: "memory");
    }
#undef DC_ISSUE
    l_run += __shfl_xor(l_run, 16); l_run += __shfl_xor(l_run, 32);
    LAS float* mw = (LAS float*)(X.lds + EXTRA_OFF); LAS float* lw = mw + 128;
    if (lane < 16) { mw[wave * 16 + lane] = m_run; lw[wave * 16 + lane] = l_run; }
    __syncthreads();
    float M = mw[kl];
#pragma unroll
    for (int w = 1; w < 8; ++w) M = fmaxf(M, mw[w * 16 + kl]);
    const float sc = __builtin_amdgcn_exp2f(m_run - M);
    LAS float* Ow = (LAS float*)L + wave * 4096;
#pragma unroll
    for (int nb = 0; nb < 16; ++nb)
#pragma unroll
        for (int r = 0; r < 4; ++r) Ow[(16 * nb + 4 * kq + r) * 16 + kl] = acc[nb][r] * sc;
    __syncthreads();
    float* P = (float*)(ws + WS_PART) + (size_t)(b * 2 + sp) * PART_STRIDE;
#pragma unroll
    for (int i = 0; i < 8; ++i) { const int e = tid + 512 * i; float s = 0.f;
#pragma unroll
        for (int w = 0; w < 8; ++w) s += ((LAS float*)L)[w * 4096 + e];
        P[32 + (e & 15) * 256 + (e >> 4)] = s; }
    if (tid < 16) { float Mh = mw[tid];
#pragma unroll
        for (int w = 1; w < 8; ++w) Mh = fmaxf(Mh, mw[w * 16 + tid]);
        float Ls = 0.f;
#pragma unroll
        for (int w = 0; w < 8; ++w) Ls += lw[w * 16 + tid] * __builtin_amdgcn_exp2f(mw[w * 16 + tid] - Mh);
        P[tid] = Mh; P[16 + tid] = Ls; }
    __syncthreads();
}

__device__ __forceinline__ void decode_combine(const Ctx& X, const Args& a, int unit) {
    unsigned char* ws = X.ws; const int lane = X.lane, tid = X.tid, wave = X.wave, b = unit >> 1, h = 8 * (unit & 1) + wave;
    const float* P0 = (const float*)(ws + WS_PART) + (size_t)(b * 2) * PART_STRIDE; const float* P1 = P0 + PART_STRIDE;
    const float* QL = (const float*)(ws + WS_QL) + (size_t)b * 16 * 288 + h * 288;
    const float* ck = X.out + O_KVS + (size_t)b * 256; const float* kr = X.out + O_KRS + (size_t)b * 32;
    LAS float* ol = (LAS float*)X.lds + wave * 256;
    float s = 0.f;
#pragma unroll
    for (int j = 0; j < 4; ++j) s += QL[lane + 64 * j] * ck[lane + 64 * j];
    if (lane < 32) s += QL[256 + lane] * kr[lane];
    s = wave_sum(s);
    const float m0 = P0[h], m1 = P1[h], M = fmaxf(fmaxf(m0, m1), s);
    const float e0 = __builtin_amdgcn_exp2f(m0 - M), e1 = __builtin_amdgcn_exp2f(m1 - M), en = __builtin_amdgcn_exp2f(s - M);
    const float inv = 1.0f / (P0[16 + h] * e0 + P1[16 + h] * e1 + en);
    const float w0 = e0 * inv, w1 = e1 * inv, wn = en * inv;
#pragma unroll
    for (int j = 0; j < 4; ++j) { const int r = lane + 64 * j; ol[r] = P0[32 + h * 256 + r] * w0 + P1[32 + h * 256 + r] * w1 + ck[r] * wn; }
    LDS_WAIT(); asm volatile("" ::: "memory");
    const float* wp = (const float*)a.in[I_WUV] + h * 64 + lane; float o = 0.f;
#pragma unroll 1
    for (int r0 = 0; r0 < 256; r0 += 32) { float wv[32];
#pragma unroll
        for (int r = 0; r < 32; ++r) wv[r] = wp[(size_t)(r0 + r) * 1024];
#pragma unroll
        for (int r = 0; r < 32; ++r) o += ol[r0 + r] * wv[r]; }
    ((bf16*)(ws + WS_OA))[(size_t)(MPR + b) * 1024 + h * 64 + lane] = (bf16)(pk2(o, 0.f) & 0xffffu);
    LDS_WAIT(); asm volatile("" ::: "memory");
}

__device__ __forceinline__ void smp_ssm_item(const Ctx& X, const Args& a, int item) {
    unsigned char* ws = X.ws; const int lane = X.lane, wave = X.wave, g = item & 7, b = item >> 3, row = MPR + b;
    const bf16* XBC = (const bf16*)(ws + WS_XBC) + (size_t)row * 4096; const bf16* PB = (const bf16*)(ws + WS_PB) + (size_t)row * NPB;
    const int hh = wave >> 1, ph = wave & 1, h = 4 * g + hh, n4 = 4 * (lane & 31), prow = lane >> 5;
    const float dt = ((const float*)(ws + WS_DT))[(size_t)row * 32 + h], dA = __expf(-__expf(((const float*)a.in[I_ALOG])[h]) * dt);
    const v2u bw = *(const v2u*)(XBC + 2048 + g * 128 + n4), cw = *(const v2u*)(XBC + 3072 + g * 128 + n4);
    const f32x4 Bv = (f32x4){bflo(bw.x), bfhi(bw.x), bflo(bw.y), bfhi(bw.y)}, Cv = (f32x4){bflo(cw.x), bfhi(cw.x), bflo(cw.y), bfhi(cw.y)};
    const float* sin_ = (const float*)a.in[I_SSM] + (size_t)((b * 32 + h) * 64) * 128 + n4; float* sout = X.out + O_SSS + (size_t)((b * 32 + h) * 64) * 128 + n4;
    LAS float* ys = (LAS float*)(X.lds + EXTRA_OFF);
    const float dsk = ((const float*)a.in[I_DSKIP])[4 * g + (lane >> 4)]; const f32x4 gs = *(const f32x4*)((const float*)a.in[I_GSSM] + g * 256 + 4 * lane);
    const v2u xw = *(const v2u*)(XBC + g * 256 + 4 * lane), zw = *(const v2u*)(PB + PB_Z + g * 256 + 4 * lane);
    f32x4 st[16]; bf16 xr[16];
#pragma unroll
    for (int i = 0; i < 16; ++i) { st[i] = __builtin_nontemporal_load((const f32x4*)(sin_ + (size_t)(32 * ph + 2 * i + prow) * 128)); xr[i] = XBC[h * 64 + 32 * ph + 2 * i + prow]; }
#pragma unroll
    for (int i = 0; i < 16; ++i) { const int p = 32 * ph + 2 * i + prow; const float xv = bf1(xr[i]) * dt;
        const f32x4 nw = st[i] * dA + Bv * xv; __builtin_nontemporal_store(nw, (f32x4*)(sout + (size_t)p * 128));
        float part = (nw.x * Cv.x + nw.y * Cv.y) + (nw.z * Cv.z + nw.w * Cv.w);
#pragma unroll
        for (int o = 1; o < 32; o <<= 1) part += __shfl_xor(part, o);
        if ((lane & 31) == 0) ys[hh * 64 + p] = part; }
    __syncthreads();
    if (wave == 0) {
        const f32x4 y = *(const LAS f32x4*)(ys + 4 * lane);
        f32x4 v;
        v.x = (y.x + dsk * bflo(xw.x)) * silu(bflo(zw.x)); v.y = (y.y + dsk * bfhi(xw.x)) * silu(bfhi(zw.x));
        v.z = (y.z + dsk * bflo(xw.y)) * silu(bflo(zw.y)); v.w = (y.w + dsk * bfhi(xw.y)) * silu(bfhi(zw.y));
        const float ss = wave_sum((v.x * v.x + v.y * v.y) + (v.z * v.z + v.w * v.w)); const float rs = rsqrtf(ss * (1.f / 256.f) + EPS);
        v2u o; o.x = pk2(v.x * rs * gs.x, v.y * rs * gs.y); o.y = pk2(v.z * rs * gs.z, v.w * rs * gs.w);
        *(v2u*)((bf16*)(ws + WS_OS) + (size_t)row * 2048 + g * 256 + 4 * lane) = o;
    }
    __syncthreads();
}

__device__ __forceinline__ void ph_norm1(const Ctx& X, const Args& a) {
    unsigned char* ws = X.ws; const bf16* MIX = (const bf16*)(ws + WS_MIX); bf16* X1 = (bf16*)(ws + WS_X1); bf16* XN = (bf16*)(ws + WS_XN);
    const GAS f32x4* g1p = (const GAS f32x4*)a.in[I_GPOSTMIX] + X.lane; const GAS f32x4* g2p = (const GAS f32x4*)a.in[I_GPREMLP] + X.lane; f32x4 g1[4], g2[4];
#pragma unroll
    for (int j = 0; j < 4; ++j) { g1[j] = g1p[64 * j]; g2[j] = g2p[64 * j]; }
    for (int m0 = X.gw; m0 < MR; m0 += 2 * X.NGW) {
        int mm[2]; mm[0] = m0; mm[1] = m0 + X.NGW < MR ? m0 + X.NGW : m0;
        f32x4 v[2][4], x[2][4];
#pragma unroll
        for (int q = 0; q < 2; ++q) { const int m = mm[q];
            const float* xrow = m < MPR ? (const float*)a.in[I_XP] + (size_t)m * DM : (const float*)a.in[I_XS] + (size_t)(m - MPR) * DM;
            const GAS f32x4* xr = (const GAS f32x4*)xrow + X.lane; const GAS v2u* mr = (const GAS v2u*)(MIX + (size_t)m * DM) + X.lane;
#pragma unroll
            for (int j = 0; j < 4; ++j) { const v2u mw = mr[64 * j]; v[q][j] = (f32x4){bflo(mw.x), bfhi(mw.x), bflo(mw.y), bfhi(mw.y)}; x[q][j] = xr[64 * j]; } }
#pragma unroll
        for (int q = 0; q < 2; ++q) { const int m = mm[q]; float s = 0.f;
#pragma unroll
            for (int j = 0; j < 4; ++j) s += (v[q][j].x * v[q][j].x + v[q][j].y * v[q][j].y) + (v[q][j].z * v[q][j].z + v[q][j].w * v[q][j].w);
            const float rs = rsqrtf(wave_sum(s) * (1.f / DM) + EPS); float s2 = 0.f;
#pragma unroll
            for (int j = 0; j < 4; ++j) { x[q][j] = x[q][j] + v[q][j] * rs * g1[j]; s2 += (x[q][j].x * x[q][j].x + x[q][j].y * x[q][j].y) + (x[q][j].z * x[q][j].z + x[q][j].w * x[q][j].w); }
            const float rs2 = rsqrtf(wave_sum(s2) * (1.f / DM) + EPS);
            GAS unsigned long long* o4 = (GAS unsigned long long*)(X1 + (size_t)m * DM) + X.lane; GAS unsigned long long* o8 = (GAS unsigned long long*)(XN + (size_t)m * DM) + X.lane;
#pragma unroll
            for (int j = 0; j < 4; ++j) { o4[64 * j] = (unsigned long long)pk2(x[q][j].x, x[q][j].y) | ((unsigned long long)pk2(x[q][j].z, x[q][j].w) << 32); const f32x4 t = x[q][j] * rs2 * g2[j]; o8[64 * j] = (unsigned long long)pk2(t.x, t.y) | ((unsigned long long)pk2(t.z, t.w) << 32); }
        }
    }
}
__device__ __forceinline__ void ph_norm2(const Ctx& X, const Args& a) {
    unsigned char* ws = X.ws; const bf16* Fb = (const bf16*)(ws + WS_F); const bf16* X1 = (const bf16*)(ws + WS_X1);
    const GAS f32x4* gp = (const GAS f32x4*)a.in[I_GPOSTMLP] + X.lane; f32x4 g[4];
#pragma unroll
    for (int j = 0; j < 4; ++j) g[j] = gp[64 * j];
    for (int m0 = X.gw; m0 < MR; m0 += 2 * X.NGW) {
        int mm[2]; mm[0] = m0; mm[1] = m0 + X.NGW < MR ? m0 + X.NGW : m0;
        f32x4 v[2][4], x[2][4];
#pragma unroll
        for (int q = 0; q < 2; ++q) { const int m = mm[q];
            const GAS v2u* fr = (const GAS v2u*)(Fb + (size_t)m * DM) + X.lane; const GAS v2u* xr = (const GAS v2u*)(X1 + (size_t)m * DM) + X.lane;
#pragma unroll
            for (int j = 0; j < 4; ++j) { const v2u fw = fr[64 * j]; v[q][j] = (f32x4){bflo(fw.x), bfhi(fw.x), bflo(fw.y), bfhi(fw.y)}; const v2u xw = xr[64 * j]; x[q][j] = (f32x4){bflo(xw.x), bfhi(xw.x), bflo(xw.y), bfhi(xw.y)}; } }
#pragma unroll
        for (int q = 0; q < 2; ++q) { const int m = mm[q]; float s = 0.f;
#pragma unroll
            for (int j = 0; j < 4; ++j) s += (v[q][j].x * v[q][j].x + v[q][j].y * v[q][j].y) + (v[q][j].z * v[q][j].z + v[q][j].w * v[q][j].w);
            const float rs = rsqrtf(wave_sum(s) * (1.f / DM) + EPS);
            float* orow = m < MPR ? X.out + O_YP + (size_t)m * DM : X.out + O_YS + (size_t)(m - MPR) * DM;
            GAS f32x4* o4 = (GAS f32x4*)orow + X.lane;
#pragma unroll
            for (int j = 0; j < 4; ++j) __builtin_nontemporal_store(x[q][j] + v[q][j] * rs * g[j], &o4[64 * j]);
        }
    }
}

#ifndef MK_N_LAUNCHES
#define MK_N_LAUNCHES 1
#endif
constexpr int N_PHASES = 12;
constexpr int N_LAUNCHES = MK_N_LAUNCHES;
static_assert(N_LAUNCHES == 1 || N_LAUNCHES == N_PHASES, "MK_N_LAUNCHES is 1 or 12");

__global__ void __launch_bounds__(NWAVES * 64, 2) fwd_kernel(Args args) {
    extern __shared__ __attribute__((aligned(16))) unsigned char lds[];
    Ctx X;
    X.lds = (LAS unsigned char*)lds; X.tid = threadIdx.x; X.lane = X.tid & 63; X.wave = __builtin_amdgcn_readfirstlane(X.tid >> 6);
    X.G = gridDim.x; { const int bx = blockIdx.x; X.vcu = (X.G % 8 == 0) ? (bx % 8) * (X.G / 8) + bx / 8 : bx; }
    X.gw = X.vcu * NWAVES + X.wave; X.NGW = X.G * NWAVES; X.ws = args.ws; X.out = args.out;
    unsigned char* ws = args.ws;
    gu32* ctl = (gu32*)(ws + WS_CTL);
    volatile LAS unsigned* MISC = (volatile LAS unsigned*)(X.lds + MISC_OFF);
    for (int u = X.tid; u < (LDS_BYTES - LDSCTL_OFF) / 4; u += NWAVES * 64) ((LAS unsigned*)(X.lds + LDSCTL_OFF))[u] = 0u;
    __syncthreads();
    XcdBarrier bar; bar.bar = (unsigned*)(ctl + CW_BAR); bar.x = 0; bar.st = nullptr;
    if (N_LAUNCHES == 1) bar = xcd_barrier_post((unsigned*)(ctl + CW_BAR), MISC + 8);
#define GRID_BAR() do { if (N_LAUNCHES == 1) xcd_barrier(bar); } while (0)
    const int lo = args.ph_lo, hi = args.ph_hi;
#ifndef PH_MASK
#define PH_MASK 0xFFF
#endif
#define IN(k) (((PH_MASK >> (k)) & 1) && lo <= (k) && (k) < hi)
#define BOTH(k) (IN(k) && IN((k) + 1))
    const pg8::bf16_t* XN = (const pg8::bf16_t*)(ws + WS_XN);
    const int cb = (int)blockIdx.x;

    if (IN(0)) { ph0_prologue(X, args, 0); if (BOTH(0)) GRID_BAR(); }

    if (IN(1)) {
        pg8::Gemm g{XN, (const pg8::bf16_t*)(ws + WS_WIN), MP, NIN, 1024, 1024, 1024}; pg8::StaticOrder S; S.init(MP, NIN, X.G, cb);
        pg8::Epi<pg8::EM_P1> E{(void*)(ws + WS_PF), NPF, (void*)(ws + WS_PB), NPB, nullptr, 0, nullptr};
        const int grpW = (X.vcu >> 1) & 1;
        if (grpW == 0) { ph0_prologue(X, args, 1); __syncthreads(); }
        pg8::gemm_phase<pg8::Epi<pg8::EM_P1>, pg8::StaticOrder, true, true>(X.lds + RING_OFF, g, S, E);
        if (grpW != 0) { ph0_prologue(X, args, 1); }
        if (BOTH(1)) GRID_BAR();
    }
    if (IN(2)) { ph2_token(X, args); if (BOTH(2)) GRID_BAR(); }

    if (IN(3)) {
        const int grp3 = (X.vcu >> 1) & 1;
        if (grp3 == 0) { for (int it = X.vcu; it < 1024; it += X.G) smp_ssm_item(X, args, it); }
        { pg8::Gemm g{(const pg8::bf16_t*)(ws + WS_CQ), (const pg8::bf16_t*)(ws + WS_WUQ), MP, QW, 384, 384, 384}; pg8::StaticOrder S; S.init(MP, QW, X.G, cb);
          pg8::Epi<pg8::EM_Q> E{(void*)(ws + WS_Q), QW, nullptr, 0, nullptr, 0, (const float*)(ws + WS_TAB)};
          pg8::gemm_phase<pg8::Epi<pg8::EM_Q>, pg8::StaticOrder, true, true>(X.lds + RING_OFF, g, S, E); }
        { pg8::Gemm g{(const pg8::bf16_t*)(ws + WS_CKV), (const pg8::bf16_t*)(ws + WS_WUKV), MPR, 2048, 256, 256, 256}; pg8::StaticOrder S; S.init(MPR, 2048, X.G, cb);
          pg8::Epi<pg8::EM_BF16> E{(void*)(ws + WS_KNV), 2048, nullptr, 0, nullptr, 0, nullptr};
          pg8::gemm_phase<pg8::Epi<pg8::EM_BF16>, pg8::StaticOrder, true, true>(X.lds + RING_OFF, g, S, E); }
        ssd_passA_all(X, args);
        if (grp3 != 0) { for (int it = X.vcu; it < 1024; it += X.G) smp_ssm_item(X, args, it); }
        if (BOTH(3)) GRID_BAR();
    }
    if (IN(4)) {
        const int grp = (X.vcu >> 1) & 1;
        if (grp == 0) { for (int u = X.vcu; u < 256; u += X.G) decode_unit(X, args, u); }
        for (int j = X.vcu; j < 256; j += X.G) {
            const int bh = j >> 1, b = bh >> 4, h = bh & 15;
            bf16x8 qn[6];
            if (j & 1) { attn_unit(X, b, h, 5, 4, qn, true); attn_unit(X, b, h, 4, 3, qn, false); attn_unit(X, b, h, 3, 2, qn, false); attn_unit(X, b, h, 2, -1, qn, false); }
            else       { attn_unit(X, b, h, 7, 6, qn, true); attn_unit(X, b, h, 6, 1, qn, false); attn_unit(X, b, h, 1, 0, qn, false); attn_unit(X, b, h, 0, -1, qn, false); }
        }
        ssd_passB(X);
        if (grp != 0) { for (int u = X.vcu; u < 256; u += X.G) decode_unit(X, args, u); }
        if (BOTH(4)) GRID_BAR();
    }
    if (IN(5)) {
        const int grp5 = (X.vcu >> 1) & 1;
        pg8::Epi<pg8::EM_G1> E1{(void*)(ws + WS_MG1), 1024, nullptr, 0, (const pg8::bf16_t*)(ws + WS_PB) + PB_GA, NPB, nullptr};
        if (grp5 == 0) {
            { pg8::Gemm g{(const pg8::bf16_t*)(ws + WS_OA), (const pg8::bf16_t*)(ws + WS_WBRA), MPR, 1024, 1024, 1024, 1024}; pg8::StaticOrder S; S.init(MPR, 1024, X.G, cb);
              pg8::gemm_phase<pg8::Epi<pg8::EM_G1>, pg8::StaticOrder, false, true>(X.lds + RING_OFF, g, S, E1); }
        }
        ssd_passC_all(X, args);
        if (grp5 != 0) {
            { pg8::Gemm g{(const pg8::bf16_t*)(ws + WS_OA), (const pg8::bf16_t*)(ws + WS_WBRA), MPR, 1024, 1024, 1024, 1024}; pg8::StaticOrder S; S.init(MPR, 1024, X.G, cb);
              pg8::gemm_phase<pg8::Epi<pg8::EM_G1>, pg8::StaticOrder, false, true>(X.lds + RING_OFF, g, S, E1); }
        }
        for (int u = X.vcu; u < 2 * NSB; u += X.G) decode_combine(X, args, u);
        __syncthreads();
        if (BOTH(5)) GRID_BAR();
    }
    if (IN(6)) {
        const pg8::bf16_t* PBh = (const pg8::bf16_t*)(ws + WS_PB);
        pg8::Epi<pg8::EM_G1> E1{(void*)(ws + WS_MG1), 1024, nullptr, 0, PBh + PB_GA, NPB, nullptr};
        pg8::Epi<pg8::EM_G2> E2{(void*)(ws + WS_MG), 1024, (void*)(ws + WS_MG1), 1024, PBh + PB_GB, NPB, nullptr};
        for (int u = X.vcu; u < 128; u += X.G) {
            pg8::skinny_unit<pg8::EM_G1>(X.lds, (const pg8::bf16_t*)(ws + WS_OA), 1024, (const pg8::bf16_t*)(ws + WS_WBRA), 1024, 1024, 32 * (u >> 2), E1, MPR + 32 * (u & 3));
            pg8::skinny_unit<pg8::EM_G2>(X.lds, (const pg8::bf16_t*)(ws + WS_OS), 2048, (const pg8::bf16_t*)(ws + WS_WBRS), 2048, 2048, 32 * (u >> 2), E2, MPR + 32 * (u & 3));
        }
        { pg8::Gemm g{(const pg8::bf16_t*)(ws + WS_OS), (const pg8::bf16_t*)(ws + WS_WBRS), MPR, 1024, 2048, 2048, 2048}; pg8::StaticOrder S; S.init(MPR, 1024, X.G, cb);
          pg8::gemm_phase<pg8::Epi<pg8::EM_G2>, pg8::StaticOrder, false, true>(X.lds + RING_OFF, g, S, E2); }
        if (BOTH(6)) GRID_BAR();
    }
    if (IN(7)) {
        pg8::Epi<pg8::EM_BF16> E{(void*)(ws + WS_MIX), 1024, nullptr, 0, nullptr, 0, nullptr};
        for (int u = X.vcu; u < 128; u += X.G) pg8::skinny_unit<pg8::EM_BF16>(X.lds, (const pg8::bf16_t*)(ws + WS_MG), 1024, (const pg8::bf16_t*)(ws + WS_WOUT), 1024, 1024, 32 * (u >> 2), E, MPR + 32 * (u & 3));
        { pg8::Gemm g{(const pg8::bf16_t*)(ws + WS_MG), (const pg8::bf16_t*)(ws + WS_WOUT), MPR, 1024, 1024, 1024, 1024}; pg8::StaticOrder S; S.init(MPR, 1024, X.G, cb);
          pg8::gemm_phase<pg8::Epi<pg8::EM_BF16>, pg8::StaticOrder, false, true>(X.lds + RING_OFF, g, S, E); }
        if (BOTH(7)) GRID_BAR();
    }
    if (IN(8)) { ph_norm1(X, args); if (BOTH(8)) GRID_BAR(); }
    if (IN(9)) {
        pg8::Epi<pg8::EM_UP> E{(void*)(ws + WS_U), 4096, nullptr, 0, nullptr, 0, nullptr};
        const int grp9 = (X.vcu >> 1) & 1;
        if (grp9 == 0) { for (int u = X.vcu; u < 512; u += X.G) pg8::skinny_unit<pg8::EM_UP>(X.lds, XN, 1024, (const pg8::bf16_t*)(ws + WS_WUP), 1024, 1024, 32 * (u >> 2), E, MPR + 32 * (u & 3)); }
        { pg8::Gemm g{XN, (const pg8::bf16_t*)(ws + WS_WUP), MPR, 4096, 1024, 1024, 1024}; pg8::StaticOrder S; S.init(MPR, 4096, X.G, cb);
          pg8::gemm_phase<pg8::Epi<pg8::EM_UP>, pg8::StaticOrder, true, true>(X.lds + RING_OFF, g, S, E); }
        if (grp9 != 0) { for (int u = X.vcu; u < 512; u += X.G) pg8::skinny_unit<pg8::EM_UP>(X.lds, XN, 1024, (const pg8::bf16_t*)(ws + WS_WUP), 1024, 1024, 32 * (u >> 2), E, MPR + 32 * (u & 3)); }
        if (BOTH(9)) GRID_BAR();
    }
    if (IN(10)) {
        pg8::Epi<pg8::EM_BF16> E{(void*)(ws + WS_F), 1024, nullptr, 0, nullptr, 0, nullptr};
        for (int u = X.vcu; u < 128; u += X.G) pg8::skinny_unit<pg8::EM_BF16>(X.lds, (const pg8::bf16_t*)(ws + WS_U), 4096, (const pg8::bf16_t*)(ws + WS_WDN), 4096, 4096, 32 * (u >> 2), E, MPR + 32 * (u & 3));
        { pg8::Gemm g{(const pg8::bf16_t*)(ws + WS_U), (const pg8::bf16_t*)(ws + WS_WDN), MPR, 1024, 4096, 4096, 4096}; pg8::StaticOrder S; S.init(MPR, 1024, X.G, cb);
          pg8::gemm_phase<pg8::Epi<pg8::EM_BF16>, pg8::StaticOrder, false, true>(X.lds + RING_OFF, g, S, E); }
        if (BOTH(10)) GRID_BAR();
    }
    if (IN(11)) { ph_norm2(X, args); }
#undef IN
#undef BOTH
#undef GRID_BAR
}

extern "C" void kernel_launch(void* const* d_in, const int* in_sizes, int n_in, void* d_out, int out_size, void* d_ws, size_t ws_size, hipStream_t stream) {
    static int grid = 0;
    if (grid == 0) {
        if (n_in != N_IN || (size_t)out_size != O_END || ws_size < WS_END) { fprintf(stderr, "kernel_launch: unexpected problem: n_in %d out %d ws %zu; nothing launched\n", n_in, out_size, ws_size); grid = -1; return; }
        int dev = 0, cus = 0, per_cu = 0;
        if (hipGetDevice(&dev) != hipSuccess || hipDeviceGetAttribute(&cus, hipDeviceAttributeMultiprocessorCount, dev) != hipSuccess) { fprintf(stderr, "kernel_launch: device query failed\n"); grid = -1; return; }
        if (hipFuncSetAttribute((const void*)fwd_kernel, hipFuncAttributeMaxDynamicSharedMemorySize, LDS_BYTES) != hipSuccess) { fprintf(stderr, "kernel_launch: hipFuncSetAttribute failed\n"); grid = -1; return; }
        if (hipOccupancyMaxActiveBlocksPerMultiprocessor(&per_cu, (const void*)fwd_kernel, NWAVES * 64, LDS_BYTES) != hipSuccess || per_cu < 1) { fprintf(stderr, "kernel_launch: occupancy query reports %d blocks per CU\n", per_cu); }
        (void)hipGetLastError();
        grid = cus;
    }
    if (grid < 0) return;
    if (hipMemsetAsync((char*)d_ws + WS_CTL, 0, CTL_ZERO_BYTES, stream) != hipSuccess) { fprintf(stderr, "kernel_launch: memset failed\n"); return; }
    Args a{};
    for (int i = 0; i < N_IN; ++i) a.in[i] = d_in[i];
    a.out = (float*)d_out; a.ws = (unsigned char*)d_ws;
    for (int li = 0; li < N_LAUNCHES; ++li) {
        a.ph_lo = (N_LAUNCHES == 1) ? 0 : li; a.ph_hi = (N_LAUNCHES == 1) ? N_PHASES : li + 1; a.li = li; a.pad = 0;
        hipLaunchKernelGGL(fwd_kernel, dim3(grid), dim3(NWAVES * 64), LDS_BYTES, stream, a);
        const hipError_t le = hipPeekAtLastError();
        if (le != hipSuccess) { fprintf(stderr, "kernel_launch: launch %d failed: %s\n", li, hipGetErrorName(le)); break; }
    }
}
```
